# Optimizing an MI355X kernel written in HIP

```python
import jax, jax.numpy as jnp
from jax import lax
import numpy as np

D_MODEL = 1024
BATCH = 8
SEQ = 4096
DEPTH = 2
DEC_BATCH = 8
DEC_SEQ = 16
PAST_LEN = 1024

CHUNK = 64
GROUP_W = D_MODEL // 4
HEAD_DIM = 64
N_HEADS_G = GROUP_W // HEAD_DIM
POOL_WINDOWS = (2, 4, 8, 16)
POOL_GW = GROUP_W // len(POOL_WINDOWS)
POOL_STATE = max(POOL_WINDOWS) - 1
CONV_W = 3
RWKV_DECAY_RANK = 32
RWKV_A_RANK = 32
RWKV_GATE_RANK = 64
RWKV_IN = 3 * GROUP_W + RWKV_DECAY_RANK + RWKV_A_RANK + RWKV_GATE_RANK
RWKV_SPLITS = (GROUP_W, 2 * GROUP_W, 3 * GROUP_W, 3 * GROUP_W + RWKV_DECAY_RANK,
               3 * GROUP_W + RWKV_DECAY_RANK + RWKV_A_RANK)
POOL_IN = GROUP_W
CONV_IN = 3 * GROUP_W
SB_IN = 3 * GROUP_W
PROJ_IN = POOL_IN + RWKV_IN + CONV_IN + SB_IN
PROJ_SPLITS = (POOL_IN, POOL_IN + RWKV_IN, POOL_IN + RWKV_IN + CONV_IN)
D_FF = 256 * ((8 * D_MODEL // 3 + 255) // 256)
Q_BLOCK = 128
RMS_EPS = 1e-6
GN_EPS = 64e-5

kernel_name = 'hybrid_stream_encoder_step'


def rmsnorm(x, g):
    xf = x.astype(jnp.float32)
    y = xf * lax.rsqrt(jnp.mean(xf * xf, axis=-1, keepdims=True) + RMS_EPS)
    return (y * g.astype(jnp.float32)).astype(x.dtype)


def swiglu(x, w_gate, w_up, w_down):
    return (jax.nn.silu(x @ w_gate) * (x @ w_up)) @ w_down


def pool_mixer(u, prefix, pos, w_grp, scale):
    T = u.shape[1]
    full = jnp.concatenate([prefix.astype(u.dtype), u], axis=1)
    ff = full.astype(jnp.float32)
    cs = jnp.concatenate([jnp.zeros_like(ff[:, :1]), jnp.cumsum(ff, axis=1)], axis=1)
    end = cs[:, POOL_STATE + 1:]
    outs = []
    for gi, w in enumerate(POOL_WINDOWS):
        sl = slice(gi * POOL_GW, (gi + 1) * POOL_GW)
        start = cs[:, POOL_STATE + 1 - w: POOL_STATE + 1 - w + T, sl]
        cnt = jnp.minimum(w, pos + 1).astype(jnp.float32)[None, :, None]
        d = (end[..., sl] - start) / cnt - u[..., sl].astype(jnp.float32)
        outs.append(d @ w_grp[gi])
    y = jnp.concatenate(outs, axis=-1) * scale
    return y.astype(u.dtype), full[:, -POOL_STATE:]


def rwkv7_mixer(u, shift_prev, wkv_prev, mu, w0, w2, a0, a2, g2, k_k, k_a, r_k, ln_w, ln_b):
    B, T, _ = u.shape
    f32 = jnp.float32
    prev = jnp.concatenate([shift_prev[:, None, :].astype(u.dtype), u[:, :-1]], axis=1)
    xs = u + (prev - u) * mu
    r, k, v, dw, da, dg = jnp.split(xs, RWKV_SPLITS, axis=-1)
    w = -jax.nn.softplus(-(w0 + jnp.tanh(dw) @ w2).astype(f32)) - 0.5
    decay = jnp.exp(-jnp.exp(w))
    a = jax.nn.sigmoid((a0 + da @ a2).astype(f32))
    g = jax.nn.sigmoid(dg) @ g2
    heads = lambda t: t.reshape(B, T, N_HEADS_G, HEAD_DIM)
    kk = heads((k * k_k).astype(f32))
    kk = kk / jnp.maximum(jnp.sqrt(jnp.sum(kk * kk, axis=-1, keepdims=True)), 1e-12)
    kh = heads(k.astype(f32) * (1.0 + (a - 1.0) * k_a.astype(f32)))
    rh, vh, ah, wh = heads(r.astype(f32)), heads(v.astype(f32)), heads(a), heads(decay)

    def step(S, inp):
        r_t, w_t, k_t, v_t, kk_t, a_t = inp
        s_kk = jnp.einsum('bhvk,bhk->bhv', S, kk_t)
        S = (S * w_t[:, :, None, :] - s_kk[..., None] * (kk_t * a_t)[:, :, None, :]
             + v_t[..., None] * k_t[:, :, None, :])
        return S, jnp.einsum('bhvk,bhk->bhv', S, r_t)

    seq = tuple(jnp.moveaxis(t, 1, 0) for t in (rh, wh, kh, vh, kk, ah))
    S_T, ys = lax.scan(step, wkv_prev.astype(f32), seq)
    y = jnp.moveaxis(ys, 0, 1)
    mean = jnp.mean(y, axis=-1, keepdims=True)
    var = jnp.mean(jnp.square(y - mean), axis=-1, keepdims=True)
    y = ((y - mean) * lax.rsqrt(var + GN_EPS)).reshape(B, T, GROUP_W) * ln_w + ln_b
    bonus = jnp.sum(rh * kh * r_k.astype(f32), axis=-1, keepdims=True) * vh
    y = (y + bonus.reshape(B, T, GROUP_W)) * g
    return y.astype(u.dtype), u[:, -1], S_T


def conv_mixer(u, prefix, conv_w):
    T = u.shape[1]
    b, c, xin = jnp.split(u, 3, axis=-1)
    zf = jnp.concatenate([prefix.astype(u.dtype), c * xin], axis=1)
    y = zf[:, 0:T] * conv_w[0]
    for tap in range(1, CONV_W):
        y = y + zf[:, tap:tap + T] * conv_w[tap]
    return b * y, zf[:, -(CONV_W - 1):]


def sb_attend(q, k, v, q_pos, k_pos):
    z = jnp.einsum('bqhd,bshd->bhqs', q, k).astype(jnp.float32) * (HEAD_DIM ** -0.5)
    visible = k_pos[None, :] < q_pos[:, None]
    log_keep = jnp.where(visible, jax.nn.log_sigmoid(-z), 0.0)
    log_after = lax.cumsum(log_keep, axis=3, reverse=True) - log_keep
    attn = jnp.where(visible, jnp.exp(jax.nn.log_sigmoid(z) + log_after), 0.0)
    return jnp.einsum('bhqs,bshd->bqhd', attn, v.astype(jnp.float32))


def stick_breaking(q, k, v, q_pos, k_pos):
    B, T = q.shape[0], q.shape[1]
    if T <= Q_BLOCK:
        return sb_attend(q, k, v, q_pos, k_pos)
    nb = T // Q_BLOCK
    qb = jnp.moveaxis(q.reshape(B, nb, Q_BLOCK, N_HEADS_G, HEAD_DIM), 1, 0)
    pb = q_pos.reshape(nb, Q_BLOCK)
    ob = lax.map(lambda qp: sb_attend(qp[0], k, v, qp[1], k_pos), (qb, pb))
    return jnp.moveaxis(ob, 0, 1).reshape(B, T, N_HEADS_G, HEAD_DIM)


def trunk(x, k_past, v_past, wkv0, shift0, conv0, pool0, prm):
    B, T, _ = x.shape
    past = k_past.shape[2]
    q_pos = past + jnp.arange(T, dtype=jnp.int32)
    k_pos = jnp.arange(past + T, dtype=jnp.int32)
    ks, vs, wkvs, shifts, convs, pools = [], [], [], [], [], []
    for l in range(DEPTH):
        g = prm['norm_g'][l]
        h = rmsnorm(x, g[0])
        x = x + 0.5 * rmsnorm(swiglu(h, prm['ffn_w_gate'][l, 0], prm['ffn_w_up'][l, 0],
                                     prm['ffn_w_down'][l, 0]), g[1])
        h = rmsnorm(x, g[2])
        u = h @ prm['w_in'][l]
        u_pool, u_rwkv, u_conv, u_sb = jnp.split(u, PROJ_SPLITS, axis=-1)
        y_pool, pool_new = pool_mixer(u_pool, pool0[l], q_pos, prm['pool_w'][l], prm['pool_scale'][l])
        y_rwkv, shift_new, wkv_new = rwkv7_mixer(
            u_rwkv, shift0[l], wkv0[l], prm['rwkv_mu'][l], prm['rwkv_w0'][l], prm['rwkv_w2'][l],
            prm['rwkv_a0'][l], prm['rwkv_a2'][l], prm['rwkv_g2'][l], prm['rwkv_k_k'][l],
            prm['rwkv_k_a'][l], prm['rwkv_r_k'][l], prm['rwkv_ln_w'][l], prm['rwkv_ln_b'][l])
        y_conv, conv_new = conv_mixer(u_conv, conv0[l], prm['conv_w'][l])
        q, k, v = [t.reshape(B, T, N_HEADS_G, HEAD_DIM) for t in jnp.split(u_sb, 3, axis=-1)]
        k_all = jnp.concatenate([k_past[l].astype(k.dtype), k], axis=1)
        v_all = jnp.concatenate([v_past[l].astype(v.dtype), v], axis=1)
        y_sb = stick_breaking(q, k_all, v_all, q_pos, k_pos).reshape(B, T, GROUP_W).astype(x.dtype)
        y = jnp.concatenate([y_pool, y_rwkv, y_conv, y_sb], axis=-1) @ prm['w_out'][l]
        x = x + rmsnorm(y, g[3])
        h = rmsnorm(x, g[4])
        x = x + 0.5 * rmsnorm(swiglu(h, prm['ffn_w_gate'][l, 1], prm['ffn_w_up'][l, 1],
                                     prm['ffn_w_down'][l, 1]), g[5])
        ks.append(k); vs.append(v); wkvs.append(wkv_new); shifts.append(shift_new)
        convs.append(conv_new); pools.append(pool_new)
    return (x, jnp.stack(ks), jnp.stack(vs), jnp.stack(wkvs), jnp.stack(shifts),
            jnp.stack(convs), jnp.stack(pools))


def setup_inputs(seed: int = 0) -> dict:
    key = jax.random.key(seed)
    kk = jax.random.split(key, 32)
    L, D, G, H, N = DEPTH, D_MODEL, GROUP_W, N_HEADS_G, HEAD_DIM

    def nrm(i, shape, s):
        return jax.random.normal(kk[i], shape, jnp.float32) * s

    return {
        'x_prompt': nrm(0, (BATCH, SEQ, D), 1.0),
        'x_sample': nrm(1, (DEC_BATCH, DEC_SEQ, D), 1.0),
        'cache_sb_k': nrm(2, (L, DEC_BATCH, PAST_LEN, H, N), 1.0),
        'cache_sb_v': nrm(3, (L, DEC_BATCH, PAST_LEN, H, N), 1.0),
        'state_wkv': nrm(4, (L, DEC_BATCH, H, N, N), 0.5),
        'state_shift': nrm(5, (L, DEC_BATCH, RWKV_IN), 1.0),
        'state_conv': nrm(6, (L, DEC_BATCH, CONV_W - 1, G), 1.0),
        'state_pool': nrm(7, (L, DEC_BATCH, POOL_STATE, G), 1.0),
        'norm_g': 1.0 + nrm(8, (L, 6, D), 0.05),
        'ffn_w_gate': nrm(9, (L, 2, D, D_FF), D ** -0.5),
        'ffn_w_up': nrm(10, (L, 2, D, D_FF), D ** -0.5),
        'ffn_w_down': nrm(11, (L, 2, D_FF, D), D_FF ** -0.5),
        'w_in': nrm(12, (L, D, PROJ_IN), D ** -0.5),
        'w_out': nrm(13, (L, D, D), D ** -0.5),
        'pool_w': nrm(14, (L, len(POOL_WINDOWS), POOL_GW, POOL_GW), POOL_GW ** -0.5),
        'pool_scale': 1.0 + nrm(15, (L, G), 0.1),
        'rwkv_mu': jax.random.uniform(kk[16], (L, RWKV_IN), jnp.float32),
        'rwkv_w0': jax.random.uniform(kk[17], (L, G), jnp.float32, -6.0, -1.0),
        'rwkv_w2': nrm(18, (L, RWKV_DECAY_RANK, G), 0.1),
        'rwkv_a0': nrm(19, (L, G), 0.1),
        'rwkv_a2': nrm(20, (L, RWKV_A_RANK, G), 0.1),
        'rwkv_g2': nrm(21, (L, RWKV_GATE_RANK, G), RWKV_GATE_RANK ** -0.5),
        'rwkv_k_k': 1.0 + nrm(22, (L, G), 0.1),
        'rwkv_k_a': 1.0 + nrm(23, (L, G), 0.1),
        'rwkv_r_k': nrm(24, (L, H, N), 0.1),
        'rwkv_ln_w': 1.0 + nrm(25, (L, G), 0.05),
        'rwkv_ln_b': nrm(26, (L, G), 0.02),
        'conv_w': nrm(27, (L, CONV_W, G), CONV_W ** -0.5),
    }


def reference(x_prompt, x_sample, cache_sb_k, cache_sb_v, state_wkv, state_shift, state_conv, state_pool,
              norm_g, ffn_w_gate, ffn_w_up, ffn_w_down, w_in, w_out, pool_w, pool_scale,
              rwkv_mu, rwkv_w0, rwkv_w2, rwkv_a0, rwkv_a2, rwkv_g2, rwkv_k_k, rwkv_k_a, rwkv_r_k,
              rwkv_ln_w, rwkv_ln_b, conv_w):
    prm = dict(norm_g=norm_g, ffn_w_gate=ffn_w_gate, ffn_w_up=ffn_w_up, ffn_w_down=ffn_w_down,
               w_in=w_in, w_out=w_out, pool_w=pool_w, pool_scale=pool_scale, rwkv_mu=rwkv_mu,
               rwkv_w0=rwkv_w0, rwkv_w2=rwkv_w2, rwkv_a0=rwkv_a0, rwkv_a2=rwkv_a2, rwkv_g2=rwkv_g2,
               rwkv_k_k=rwkv_k_k, rwkv_k_a=rwkv_k_a, rwkv_r_k=rwkv_r_k, rwkv_ln_w=rwkv_ln_w,
               rwkv_ln_b=rwkv_ln_b, conv_w=conv_w)
    B = x_prompt.shape[0]
    dt = x_prompt.dtype
    zk = jnp.zeros((DEPTH, B, 0, N_HEADS_G, HEAD_DIM), dt)
    z_wkv = jnp.zeros((DEPTH, B, N_HEADS_G, HEAD_DIM, HEAD_DIM), jnp.float32)
    z_shift = jnp.zeros((DEPTH, B, RWKV_IN), dt)
    z_conv = jnp.zeros((DEPTH, B, CONV_W - 1, GROUP_W), dt)
    z_pool = jnp.zeros((DEPTH, B, POOL_STATE, GROUP_W), dt)
    y_prompt, p_sb_k, p_sb_v, p_wkv, p_shift, p_conv, p_pool = trunk(
        x_prompt, zk, zk, z_wkv, z_shift, z_conv, z_pool, prm)
    y_sample, s_sb_k, s_sb_v, s_wkv, s_shift, s_conv, s_pool = trunk(
        x_sample, cache_sb_k, cache_sb_v, state_wkv, state_shift, state_conv, state_pool, prm)
    return (y_prompt, y_sample, p_sb_k, p_sb_v, p_wkv, p_shift, p_conv, p_pool,
            s_sb_k, s_sb_v, s_wkv, s_shift, s_conv, s_pool)
```

```cpp
#include <hip/hip_runtime.h>
#include <hip/hip_cooperative_groups.h>
#include <cstdio>
#include <cstdint>
namespace cg = cooperative_groups;
#ifndef MK_PER_PHASE
#define MK_PER_PHASE 0
#endif
#ifndef DIS
#define DIS 0
#endif
__device__ __forceinline__ int ltid() { int t = threadIdx.x; asm volatile("" : "+v"(t)); return t; }
#ifndef REP
#define REP 0
#endif
namespace pg8 {
#define PG8_LAS __attribute__((address_space(3)))
typedef unsigned short bf16_t;
typedef short bf16x8 __attribute__((ext_vector_type(8)));
typedef float f32x4 __attribute__((ext_vector_type(4)));
typedef unsigned u32x4 __attribute__((ext_vector_type(4)));
constexpr int BM = 256, BK = 64, HALF = 128, HTB = HALF * BK * 2  , STAGE_BYTES = 8 * HTB, NXCD = 8, WGM = 8;

__host__ __device__ __forceinline__ int lds_byte(int r, int c) { const int st = (r >> 4) * 2 + (c >> 5), rr = r & 15, cc = c & 31, ob = rr * 64 + cc * 2; return st * 1024 + (ob ^ (((ob >> 9) & 1) << 5)); }
__host__ __device__ __forceinline__ void stage_rc(int b, int& R, int& C) { const int st = b / 1024, sb = b % 1024, swz = sb ^ (((sb >> 9) & 1) << 5); R = (st >> 1) * 16 + swz / 64; C = (st & 1) * 32 + (swz % 64) / 2; }
__host__ __device__ __forceinline__ int perm32(int rho) { const int n = rho >> 4, i = rho & 15; return 8 * (i >> 2) + 4 * n + (i & 3); }

struct Unit { int pm, pn; };
struct Gemm { const bf16_t* A; const bf16_t* Bt; int M, N, K; };

struct StaticOrder {
    int nM, nN, nwg, G, c;
    __host__ __device__ void init(int M, int N, int G_, int c_) { nM = M / BM; nN = N / BM; nwg = nM * nN; G = G_; c = c_; }
    __host__ __device__ bool next(int i, Unit& u) const {
        const long L = (long)i * G + c; if (L >= nwg) return false;
        int wgid = (int)L; { const int q = nwg / NXCD, r = nwg % NXCD, xcd = wgid % NXCD, off = wgid / NXCD; wgid = (xcd < r ? xcd * (q + 1) : r * (q + 1) + (xcd - r) * q) + off; }
        const int nig = WGM * nN, gid = wgid / nig, fm = gid * WGM, gsz = (nM - fm) < WGM ? (nM - fm) : WGM;
        u.pm = fm + ((wgid % nig) % gsz); u.pn = (wgid % nig) / gsz; return true;
    }
    __device__ __forceinline__ void a_ready(const Unit&) const {}
    __device__ __forceinline__ void done(const Unit&) const {}
};

__device__ __forceinline__ unsigned cvt_pk_bf16(float lo, float hi) { unsigned r; asm volatile("v_cvt_pk_bf16_f32 %0, %1, %2" : "=v"(r) : "v"(lo), "v"(hi)); return r; }

__device__ __forceinline__ float silu_f(float x) { return x * __builtin_amdgcn_rcpf(1.0f + __builtin_amdgcn_exp2f(-1.44269504089f * x)); }
struct EpiSwiglu {
    static constexpr bool PERM = true, AFTER_DRAIN = false;
    bf16_t* O; int ldc;
    __device__ __forceinline__ void operator()(const f32x4 (&acc)[2][2][4][2], const Unit& u, int wr, int wc, int fr, int fq) const {
        const int row0 = u.pm * BM + wr * 64 + fr, col0 = u.pn * HALF + wc * 32 + 8 * fq;
#pragma unroll
        for (int ai = 0; ai < 2; ++ai)
#pragma unroll
            for (int m = 0; m < 4; ++m) {
                bf16_t* rowp = O + (size_t)(row0 + ai * HALF + m * 16) * ldc + col0;
                const f32x4 g0 = acc[ai][0][m][0], g1 = acc[ai][0][m][1], u0 = acc[ai][1][m][0], u1 = acc[ai][1][m][1];
                u32x4 w;
                w.x = cvt_pk_bf16(silu_f(g0[0]) * u0[0], silu_f(g0[1]) * u0[1]); w.y = cvt_pk_bf16(silu_f(g0[2]) * u0[2], silu_f(g0[3]) * u0[3]);
                w.z = cvt_pk_bf16(silu_f(g1[0]) * u1[0], silu_f(g1[1]) * u1[1]); w.w = cvt_pk_bf16(silu_f(g1[2]) * u1[2], silu_f(g1[3]) * u1[3]);
                *(u32x4*)rowp = w;
            }
    }
};
struct EpiF32 {
    static constexpr bool PERM = false, AFTER_DRAIN = false;
    float* O; int ldc;
    __device__ __forceinline__ void operator()(const f32x4 (&acc)[2][2][4][2], const Unit& u, int wr, int wc, int fr, int fq) const {
        const int row0 = u.pm * BM + wr * 64 + fr, col0 = u.pn * BM + wc * 32 + 4 * fq;
#pragma unroll
        for (int ai = 0; ai < 2; ++ai)
#pragma unroll
            for (int m = 0; m < 4; ++m) {
                float* rowp = O + (size_t)(row0 + ai * HALF + m * 16) * ldc + col0;
#pragma unroll
                for (int bj = 0; bj < 2; ++bj)
#pragma unroll
                    for (int n = 0; n < 2; ++n) *(f32x4*)(rowp + bj * HALF + n * 16) = acc[ai][bj][m][n];
            }
    }
};
struct EpiU {
    static constexpr bool PERM = true, AFTER_DRAIN = false;
    bf16_t* O; int ldc; float* pk; float* pv; float* sk; float* sv; int mp, mr;
    __device__ __forceinline__ void operator()(const f32x4 (&acc)[2][2][4][2], const Unit& u, int wr, int wc, int fr, int fq) const {
        const int row0 = u.pm * BM + wr * 64 + fr, colt = wc * 32 + 8 * fq;
        const bool kv = (u.pn == 1) || (u.pn == 2);
#pragma unroll
        for (int ai = 0; ai < 2; ++ai)
#pragma unroll
            for (int m = 0; m < 4; ++m) {
                const int row = row0 + ai * HALF + m * 16;
                bf16_t* rowp = O + (size_t)row * ldc + u.pn * BM + colt;
#pragma unroll
                for (int bj = 0; bj < 2; ++bj) {
                    const f32x4 v0 = acc[ai][bj][m][0], v1 = acc[ai][bj][m][1];
                    u32x4 w; w.x = cvt_pk_bf16(v0[0], v0[1]); w.y = cvt_pk_bf16(v0[2], v0[3]); w.z = cvt_pk_bf16(v1[0], v1[1]); w.w = cvt_pk_bf16(v1[2], v1[3]);
                    *(u32x4*)(rowp + bj * HALF) = w;
                    if (kv && row < mr) {
                        float* dst = (row < mp) ? ((u.pn == 1 ? pk : pv) + (size_t)row * 256) : ((u.pn == 1 ? sk : sv) + (size_t)(row - mp) * 256);
                        dst += bj * HALF + colt;
                        *(f32x4*)dst = v0; *(f32x4*)(dst + 4) = v1;
                    }
                }
            }
    }
};
struct EpiBf {
    static constexpr bool PERM = true, AFTER_DRAIN = false;
    bf16_t* O; int ldc;
    __device__ __forceinline__ void operator()(const f32x4 (&acc)[2][2][4][2], const Unit& u, int wr, int wc, int fr, int fq) const {
        const int row0 = u.pm * BM + wr * 64 + fr, col0 = u.pn * BM + wc * 32 + 8 * fq;
#pragma unroll
        for (int ai = 0; ai < 2; ++ai)
#pragma unroll
            for (int m = 0; m < 4; ++m) {
                bf16_t* rowp = O + (size_t)(row0 + ai * HALF + m * 16) * ldc + col0;
#pragma unroll
                for (int bj = 0; bj < 2; ++bj) {
                    const f32x4 v0 = acc[ai][bj][m][0], v1 = acc[ai][bj][m][1];
                    u32x4 w; w.x = cvt_pk_bf16(v0[0], v0[1]); w.y = cvt_pk_bf16(v0[2], v0[3]); w.z = cvt_pk_bf16(v1[0], v1[1]); w.w = cvt_pk_bf16(v1[2], v1[3]);
                    *(u32x4*)(rowp + bj * HALF) = w;
                }
            }
    }
};

template <class Epi, class Sched, bool ALIGN_EPI = false, bool SP2 = false>
__device__ __forceinline__ void gemm_phase(PG8_LAS unsigned char* lds, const Gemm g, const Sched& S, const Epi& E) {
    const int tid = ltid(), wid = __builtin_amdgcn_readfirstlane(tid >> 6), lane = tid & 63, wr = wid >> 2, wc = wid & 3, fr = lane & 15, fq = lane >> 4;
    const int K = g.K, nt = K / BK;
    unsigned voffA[2], voffB[2];
#pragma unroll
    for (int i = 0; i < 2; ++i) { int R, C; stage_rc(tid * 16 + i * 8192, R, C); const int Rb = Epi::PERM ? ((R & ~31) + perm32(R & 31)) : R;
        voffA[i] = (unsigned)(R * K + C) * 2u; voffB[i] = (unsigned)(Rb * K + C) * 2u; }
    const size_t kstep = (size_t)(BK * 2);
    const size_t hstep = (size_t)HALF * K * 2;
    const size_t tstep = 2 * hstep;
    const unsigned ldsw = (unsigned)wid * 1024u;
    const int aoff = lds_byte(wr * 64 + fr, fq * 8), boff = lds_byte(wc * 32 + fr, fq * 8);
#define PG8_SA(b, h) (((b) * 2 + (h)) * HTB)
#define PG8_SB(b, h) ((4 + (b) * 2 + (h)) * HTB)
#define PG8_STAGE(bufoff, gbase, voff) do { _Pragma("unroll") for (int _i = 0; _i < 2; ++_i) \
        __builtin_amdgcn_global_load_lds((const unsigned*)((const char*)(gbase) + (voff)[_i]), (PG8_LAS unsigned*)(lds + (bufoff) + ldsw + _i * 8192), 16, 0, 0); } while (0)
#define PG8_LDA(dst, b, h) do { _Pragma("unroll") for (int m = 0; m < 4; ++m) _Pragma("unroll") for (int k = 0; k < 2; ++k) dst[m][k] = *(const PG8_LAS bf16x8*)(lds + PG8_SA(b, h) + aoff + m * 2048 + k * 1024); } while (0)
#define PG8_LDB(dst, b, h) do { _Pragma("unroll") for (int n = 0; n < 2; ++n) _Pragma("unroll") for (int k = 0; k < 2; ++k) dst[n][k] = *(const PG8_LAS bf16x8*)(lds + PG8_SB(b, h) + boff + n * 2048 + k * 1024); } while (0)
#define PG8_MMA(ai, bj, At, Bt) do { __builtin_amdgcn_s_setprio(1); _Pragma("unroll") for (int m = 0; m < 4; ++m) _Pragma("unroll") for (int n = 0; n < 2; ++n) _Pragma("unroll") for (int k = 0; k < 2; ++k) \
        acc[ai][bj][m][n] = __builtin_amdgcn_mfma_f32_16x16x32_bf16(Bt[n][k], At[m][k], acc[ai][bj][m][n], 0, 0, 0); __builtin_amdgcn_s_setprio(0); } while (0)
#define PG8_WAIT_V(n) asm volatile("s_waitcnt vmcnt(" #n ")" ::: "memory")
#define PG8_WAIT_L(n) asm volatile("s_waitcnt lgkmcnt(" #n ")" ::: "memory")
#define PG8_BAR __builtin_amdgcn_s_barrier()
#define PG8_SCHED __builtin_amdgcn_sched_barrier(0)
    Unit cur, nxt; int ui = 0;
    if (!S.next(0, cur)) return;
    f32x4 acc[2][2][4][2];
#pragma unroll
    for (int a = 0; a < 2; ++a)
#pragma unroll
        for (int b = 0; b < 2; ++b)
#pragma unroll
            for (int m = 0; m < 4; ++m)
#pragma unroll
                for (int n = 0; n < 2; ++n) acc[a][b][m][n] = (f32x4){0.f, 0.f, 0.f, 0.f};
    bf16x8 At[4][2], B0[2][2], B1[2][2];
    const char* cA = (const char*)g.A + (size_t)cur.pm * tstep; const char* cB = (const char*)g.Bt + (size_t)cur.pn * tstep;
    S.a_ready(cur);
    if constexpr (SP2) {
        PG8_STAGE(PG8_SB(0, 0), cB, voffB); PG8_STAGE(PG8_SB(0, 1), cB + hstep, voffB); PG8_STAGE(PG8_SA(0, 0), cA, voffA); PG8_STAGE(PG8_SA(0, 1), cA + hstep, voffA);
        if (wr == 1) PG8_BAR;
        PG8_WAIT_V(2); PG8_BAR;
        PG8_STAGE(PG8_SB(1, 0), cB + kstep, voffB); PG8_STAGE(PG8_SA(1, 0), cA + kstep, voffA); PG8_STAGE(PG8_SB(1, 1), cB + hstep + kstep, voffB);
        PG8_WAIT_V(6); PG8_BAR;
    } else {
        PG8_STAGE(PG8_SB(0, 0), cB, voffB); PG8_STAGE(PG8_SA(0, 0), cA, voffA); PG8_STAGE(PG8_SB(0, 1), cB + hstep, voffB); PG8_STAGE(PG8_SA(0, 1), cA + hstep, voffA);
        if (wr == 1) PG8_BAR;
        PG8_WAIT_V(4); PG8_BAR;
        PG8_STAGE(PG8_SB(1, 0), cB + kstep, voffB); PG8_STAGE(PG8_SA(1, 0), cA + kstep, voffA); PG8_STAGE(PG8_SB(1, 1), cB + hstep + kstep, voffB);
        PG8_WAIT_V(6); PG8_BAR;
    }
    for (;;) {
        const bool has_next = S.next(ui + 1, nxt);
        const char* nA = has_next ? (const char*)g.A + (size_t)nxt.pm * tstep : cA; const char* nB = has_next ? (const char*)g.Bt + (size_t)nxt.pn * tstep : cB;
        for (int t = 0; t < nt; t += 2) {
            const bool last = (t == nt - 2);
            const char* a1 = cA + (size_t)(t + 1) * kstep;
            const char* a2 = last ? nA : cA + (size_t)(t + 2) * kstep; const char* b2 = last ? nB : cB + (size_t)(t + 2) * kstep;
            const char* a3 = a2 + kstep; const char* b3 = b2 + kstep;
            if (last && has_next) S.a_ready(nxt);
            if constexpr (SP2) {
            PG8_LDB(B0, 0, 0); PG8_LDB(B1, 0, 1); PG8_SCHED; PG8_LDA(At, 0, 0); PG8_STAGE(PG8_SA(1, 1), a1 + hstep, voffA);
            PG8_WAIT_V(8); PG8_WAIT_L(0); PG8_BAR; PG8_MMA(0, 0, At, B0); PG8_MMA(0, 1, At, B1); PG8_BAR; PG8_SCHED;
            PG8_LDA(At, 0, 1); PG8_STAGE(PG8_SB(0, 0), b2, voffB); PG8_STAGE(PG8_SB(0, 1), b2 + hstep, voffB); PG8_STAGE(PG8_SA(0, 0), a2, voffA);
            PG8_WAIT_V(8); PG8_WAIT_L(0); PG8_BAR; PG8_MMA(1, 0, At, B0); PG8_MMA(1, 1, At, B1); PG8_BAR; PG8_SCHED;
            PG8_LDB(B0, 1, 0); PG8_LDB(B1, 1, 1); PG8_SCHED; PG8_LDA(At, 1, 0); PG8_STAGE(PG8_SA(0, 1), a2 + hstep, voffA);
            PG8_WAIT_V(8); PG8_WAIT_L(0); PG8_BAR; PG8_MMA(0, 0, At, B0); PG8_MMA(0, 1, At, B1); PG8_BAR; PG8_SCHED;
            PG8_LDA(At, 1, 1); PG8_STAGE(PG8_SB(1, 0), b3, voffB); PG8_STAGE(PG8_SB(1, 1), b3 + hstep, voffB); PG8_STAGE(PG8_SA(1, 0), a3, voffA);
            PG8_WAIT_V(8); PG8_WAIT_L(0); PG8_BAR; PG8_MMA(1, 0, At, B0); PG8_MMA(1, 1, At, B1); PG8_BAR; PG8_SCHED;
            } else {
            PG8_LDB(B0, 0, 0); PG8_SCHED; PG8_LDA(At, 0, 0); PG8_STAGE(PG8_SA(1, 1), a1 + hstep, voffA);
            PG8_WAIT_L(8); PG8_BAR; PG8_WAIT_L(0); PG8_MMA(0, 0, At, B0); PG8_BAR; PG8_SCHED;
            PG8_LDB(B1, 0, 1); PG8_STAGE(PG8_SB(0, 0), b2, voffB);
            PG8_BAR; PG8_WAIT_L(0); PG8_MMA(0, 1, At, B1); PG8_BAR;
            PG8_LDA(At, 0, 1); PG8_STAGE(PG8_SA(0, 0), a2, voffA);
            PG8_BAR; PG8_WAIT_L(0); PG8_MMA(1, 0, At, B0); PG8_BAR; PG8_SCHED;
            PG8_STAGE(PG8_SB(0, 1), b2 + hstep, voffB);
            PG8_WAIT_V(6); PG8_BAR; PG8_MMA(1, 1, At, B1); PG8_BAR;
            PG8_LDB(B0, 1, 0); PG8_SCHED; PG8_LDA(At, 1, 0); PG8_STAGE(PG8_SA(0, 1), a2 + hstep, voffA);
            PG8_WAIT_L(8); PG8_BAR; PG8_WAIT_L(0); PG8_MMA(0, 0, At, B0); PG8_BAR; PG8_SCHED;
            PG8_LDB(B1, 1, 1); PG8_STAGE(PG8_SB(1, 0), b3, voffB);
            PG8_BAR; PG8_WAIT_L(0); PG8_MMA(0, 1, At, B1); PG8_BAR;
            PG8_LDA(At, 1, 1); PG8_STAGE(PG8_SA(1, 0), a3, voffA);
            PG8_BAR; PG8_WAIT_L(0); PG8_MMA(1, 0, At, B0); PG8_BAR; PG8_SCHED;
            PG8_STAGE(PG8_SB(1, 1), b3 + hstep, voffB);
            PG8_WAIT_V(6); PG8_BAR; PG8_MMA(1, 1, At, B1); PG8_BAR;
            }
        }
        if constexpr (ALIGN_EPI) { if (wr == 0) PG8_BAR; }
        if constexpr (!Epi::AFTER_DRAIN) { E(acc, cur, wr, wc, fr, fq); S.done(cur); }
        if (!has_next) break;
#pragma unroll
        for (int a = 0; a < 2; ++a)
#pragma unroll
            for (int b = 0; b < 2; ++b)
#pragma unroll
                for (int m = 0; m < 4; ++m)
#pragma unroll
                    for (int n = 0; n < 2; ++n) acc[a][b][m][n] = (f32x4){0.f, 0.f, 0.f, 0.f};
        cur = nxt; cA = nA; cB = nB; ++ui;
        if constexpr (ALIGN_EPI) { if (wr == 1) PG8_BAR; }
    }
    PG8_WAIT_V(0);
    if constexpr (!ALIGN_EPI) { if (wr == 0) PG8_BAR; }
    PG8_BAR;
    if constexpr (Epi::AFTER_DRAIN) { E.fused(acc, cur, wr, wc, fr, fq, lds, wid, lane); S.done(cur); }
#undef PG8_SA
#undef PG8_SB
#undef PG8_STAGE
#undef PG8_LDA
#undef PG8_LDB
#undef PG8_MMA
#undef PG8_WAIT_V
#undef PG8_WAIT_L
#undef PG8_BAR
#undef PG8_SCHED
}
}

typedef unsigned short bf16;
typedef short bf16x8 __attribute__((ext_vector_type(8)));
typedef float f32x4 __attribute__((ext_vector_type(4)));
typedef unsigned u32x4 __attribute__((ext_vector_type(4)));
typedef unsigned u32x2 __attribute__((ext_vector_type(2)));
#define LAS __attribute__((address_space(3)))
#define LAUNDER(p) asm volatile("" : "+s"(p))

constexpr int D = 1024, T = 4096, NB = 8, TS = 16, PAST = 1024, FF = 2816, RW = 896;
constexpr int MP = NB * T, MS = NB * TS, MR = MP + MS, M = 33024;
constexpr int NU = 2816;
constexpr int UQ = 0, UK = 256, UV = 512, UPOOL = 768, UCB = 1024, UCC = 1280, UCX = 1536, URW = 1792;
constexpr float RMS_EPS = 1e-6f, GN_EPS = 64e-5f;
constexpr int VTP = T + 64;
constexpr int SKEYS = PAST + TS, SKP = 1088;

constexpr size_t O_X = 0, O_PK = 33685504, O_PV = 50462720, O_PWKV = 67239936, O_PSHIFT = 67502080, O_PCONV = 67516416, O_PPOOL = 67524608,
                 O_SK = 67586048, O_SV = 67651584, O_SWKV = 67717120, O_SSHIFT = 67979264, O_SCONV = 67993600, O_SPOOL = 68001792, O_END = 68063232;
constexpr size_t LW = 21233664;
constexpr size_t W_GUA = 0, W_DA = 5767168, W_IN = 8650752, W_OUT = 11534336, W_GUB = 12582912, W_DB = 18350080;
constexpr size_t WS_W = 0, WS_H = 84934656, WS_U = 152567808, WS_Y = 338558976;
constexpr size_t WS_SIN = WS_Y, WS_G = 456458240, WS_RK = 473300992, WS_YS = 473827328, WS_SKV = 507512832, WS_VT = 511772672, WS_SVT = 528812032, WS_CTL = 533268480, WS_END = 533268480 + 16384;
constexpr size_t SKV_ELEMS = (size_t)NB * SKEYS * 256;
constexpr int REC = 896;
static_assert(WS_Y + (size_t)M * D * 4 <= WS_END && WS_SIN + (size_t)MR * 4 * REC == WS_G && WS_G + (size_t)MR * 512 == WS_RK && WS_RK + (size_t)MR * 16 == WS_YS && WS_YS + (size_t)MR * 1024 == WS_SKV && WS_SKV + SKV_ELEMS * 2 == WS_VT && WS_VT + (size_t)32 * 64 * VTP * 2 == WS_SVT && WS_SVT + (size_t)32 * 64 * SKP * 2 == WS_CTL && WS_END <= 536870912, "ws map");
static_assert(WS_U + (size_t)M * NU * 2 == WS_Y && WS_H + (size_t)M * D * 2 == WS_U && 2 * LW * 2 == WS_H, "ws map 2");

constexpr int LDS_BYTES = 147456;
constexpr int NTHR = 512, NWAVES = 8;

constexpr int PH_PRE = 0, PH_PER_LAYER = 12, NPH = 1 + 2 * PH_PER_LAYER;
enum { P_A1 = 0, P_A2, P_A3, P_B1, P_C1, P_C2, P_C3, P_D1, P_D2, P_E1, P_E2, P_E3 };

struct Args { const float* in[28]; float* out; unsigned char* ws; int ph_lo, ph_hi; };
enum { I_XP = 0, I_XS, I_CK, I_CV, I_SWKV, I_SSHIFT, I_SCONV, I_SPOOL, I_NG, I_WG, I_WU, I_WD, I_WIN, I_WOUT, I_POOLW, I_POOLS, I_MU, I_W0, I_W2, I_A0, I_A2, I_G2, I_KK, I_KA, I_RK, I_LNW, I_LNB, I_CONVW };
typedef const __attribute__((address_space(4))) Args* KArgP;
__device__ __forceinline__ KArgP kargs() { KArgP p = (KArgP)__builtin_amdgcn_kernarg_segment_ptr(); asm volatile("" : "+s"(p)); return p; }

__device__ __forceinline__ unsigned f2bf(float f) { return (unsigned)__builtin_bit_cast(unsigned short, (__bf16)f); }
typedef float f32x2_t __attribute__((ext_vector_type(2))); typedef __bf16 bf16x2_t __attribute__((ext_vector_type(2)));
__device__ __forceinline__ unsigned pk2(float lo, float hi) { f32x2_t v = {lo, hi}; bf16x2_t b = __builtin_convertvector(v, bf16x2_t); return __builtin_bit_cast(unsigned, b); }
__device__ __forceinline__ float bf2f(unsigned h) { return __builtin_bit_cast(float, h << 16); }
__device__ __forceinline__ float bflo(unsigned w) { return __builtin_bit_cast(float, w << 16); }
__device__ __forceinline__ float bfhi(unsigned w) { return __builtin_bit_cast(float, w & 0xffff0000u); }
__device__ __forceinline__ float ldbf(const bf16* p) { return bf2f((unsigned)*p); }
template <int CTRL> __device__ __forceinline__ float dppf(float x) { return __builtin_bit_cast(float, __builtin_amdgcn_update_dpp(0, __builtin_bit_cast(int, x), CTRL, 0xF, 0xF, true)); }
__device__ __forceinline__ float red16(float x) {
    x += dppf<0xB1>(x);
    x += dppf<0x4E>(x);
    x += dppf<0x141>(x);
    x += dppf<0x140>(x);
    return x;
}
__device__ __forceinline__ float wave_sum(float v) {
    v = red16(v);
    const int iv = __builtin_bit_cast(int, v);
    return (__builtin_bit_cast(float, __builtin_amdgcn_readlane(iv, 0)) + __builtin_bit_cast(float, __builtin_amdgcn_readlane(iv, 16))) +
           (__builtin_bit_cast(float, __builtin_amdgcn_readlane(iv, 32)) + __builtin_bit_cast(float, __builtin_amdgcn_readlane(iv, 48)));
}
__device__ __forceinline__ void red16_2(float& a, float& b) {
    a += dppf<0xB1>(a); b += dppf<0xB1>(b);
    a += dppf<0x4E>(a); b += dppf<0x4E>(b);
    a += dppf<0x141>(a); b += dppf<0x141>(b);
    a += dppf<0x140>(a); b += dppf<0x140>(b);
}
typedef float f32x2v __attribute__((ext_vector_type(2)));
typedef __bf16 bf2_t __attribute__((ext_vector_type(2)));
__device__ __forceinline__ float dot2bf(unsigned a, unsigned b, float c) { return __builtin_amdgcn_fdot2_f32_bf16(__builtin_bit_cast(bf2_t, a), __builtin_bit_cast(bf2_t, b), c, false); }
__device__ __forceinline__ float sigmoid_f(float x) { return __builtin_amdgcn_rcpf(1.0f + __expf(-x)); }
__device__ __forceinline__ float tanh_f(float x) { return 2.0f * sigmoid_f(2.0f * x) - 1.0f; }
__device__ __forceinline__ float softplus_f(float x) { return fmaxf(x, 0.f) + __logf(1.0f + __expf(-fabsf(x))); }

__device__ __forceinline__ void transpose_item(const float* __restrict__ W, int K, int N, bf16* WT, int dst_row0, float* scr, int kb, int n0, int lane) {
    const int k0 = 64 * kb;
    float wv[32];
#pragma unroll
    for (int i = 0; i < 32; ++i) wv[i] = W[(size_t)(k0 + 2 * i + (lane >> 5)) * N + n0 + (lane & 31)];
#pragma unroll
    for (int i = 0; i < 32; ++i) scr[(2 * i + (lane >> 5)) * 33 + (lane & 31)] = wv[i];
    asm volatile("s_waitcnt lgkmcnt(0)" ::: "memory");
    const int c = lane & 7;
#pragma unroll
    for (int j = 0; j < 4; ++j) { const int n = (lane >> 3) + 8 * j; const float* s = scr + (8 * c) * 33 + n;
        u32x4 o; o.x = pk2(s[0 * 33], s[1 * 33]); o.y = pk2(s[2 * 33], s[3 * 33]); o.z = pk2(s[4 * 33], s[5 * 33]); o.w = pk2(s[6 * 33], s[7 * 33]);
        *(u32x4*)(WT + (size_t)(dst_row0 + n) * K + k0 + 8 * c) = o; }
    asm volatile("s_waitcnt lgkmcnt(0)" ::: "memory");
}
__device__ __forceinline__ int win_rowmap(int n0) { return n0 < 256 ? UPOOL + n0 : (n0 < 1152 ? URW + (n0 - 256) : (n0 < 1920 ? UCB + (n0 - 1152) : n0 - 1920)); }

__device__ __forceinline__ void norm_row_to_bf16(const float* xrow, const float* g, bf16* hrow, int lane) {
    f32x4 v[4]; float s = 0.f;
#pragma unroll
    for (int j = 0; j < 4; ++j) { v[j] = *((const f32x4*)xrow + lane + 64 * j); s += (v[j].x * v[j].x + v[j].y * v[j].y) + (v[j].z * v[j].z + v[j].w * v[j].w); }
    const float rstd = rsqrtf(wave_sum(s) * (1.f / D) + RMS_EPS);
#pragma unroll
    for (int j = 0; j < 4; ++j) { const f32x4 gg = *((const f32x4*)g + lane + 64 * j); u32x2 o; o.x = pk2(v[j].x * rstd * gg.x, v[j].y * rstd * gg.y); o.y = pk2(v[j].z * rstd * gg.z, v[j].w * rstd * gg.w);
        *((u32x2*)hrow + lane + 64 * j) = o; }
}

__device__ __forceinline__ void phase_pre(const Args& a, unsigned char* lds) {
    KArgP ap = kargs(); unsigned char* ws_l = ap->ws; float* out_l = ap->out; (void)ws_l; (void)out_l;
    const float* in_I_NG = ap->in[I_NG];
    const float* in_I_WD = ap->in[I_WD];
    const float* in_I_WG = ap->in[I_WG];
    const float* in_I_WIN = ap->in[I_WIN];
    const float* in_I_WOUT = ap->in[I_WOUT];
    const float* in_I_WU = ap->in[I_WU];
    const float* in_I_XP = ap->in[I_XP];
    const float* in_I_XS = ap->in[I_XS];
    const int tid = ltid(), lane = tid & 63, wave = tid >> 6, G = gridDim.x;
    const int gw = blockIdx.x * NWAVES + wave, NGW = G * NWAVES;
    float* scr = (float*)(lds + wave * 16384);
    bf16* Wb = (bf16*)(ws_l + WS_W);
    constexpr int IT_L = 10304;
    for (int it = gw; it < 2 * IT_L; it += NGW) {
        const int l = it / IT_L; int r = it % IT_L; bf16* WL = Wb + (size_t)l * LW;
        const float* src; int K, N; bf16* dst; int mode;
        if (r < 1408)      { src = in_I_WG + (size_t)(l * 2 + 0) * D * FF; K = D; N = FF; dst = WL + W_GUA; mode = 1; }
        else if ((r -= 1408) < 1408) { src = in_I_WU + (size_t)(l * 2 + 0) * D * FF; K = D; N = FF; dst = WL + W_GUA; mode = 2; }
        else if ((r -= 1408) < 1408) { src = in_I_WD + (size_t)(l * 2 + 0) * FF * D; K = FF; N = D; dst = WL + W_DA; mode = 0; }
        else if ((r -= 1408) < 1344) { src = in_I_WIN + (size_t)l * D * 2688; K = D; N = 2688; dst = WL + W_IN; mode = 3; }
        else if ((r -= 1344) < 512)  { src = in_I_WOUT + (size_t)l * D * D; K = D; N = D; dst = WL + W_OUT; mode = 0; }
        else if ((r -= 512) < 1408)  { src = in_I_WG + (size_t)(l * 2 + 1) * D * FF; K = D; N = FF; dst = WL + W_GUB; mode = 1; }
        else if ((r -= 1408) < 1408) { src = in_I_WU + (size_t)(l * 2 + 1) * D * FF; K = D; N = FF; dst = WL + W_GUB; mode = 2; }
        else { r -= 1408;            src = in_I_WD + (size_t)(l * 2 + 1) * FF * D; K = FF; N = D; dst = WL + W_DB; mode = 0; }
        const int nblk = N / 32, kb = r / nblk, n0 = 32 * (r % nblk);
        int dr = n0;
        if (mode == 1) dr = 256 * (n0 >> 7) + (n0 & 127); else if (mode == 2) dr = 256 * (n0 >> 7) + 128 + (n0 & 127); else if (mode == 3) dr = win_rowmap(n0);
        transpose_item(src, K, N, dst, dr, scr, kb, n0, lane);
    }
    const int gt = blockIdx.x * NTHR + tid, NGT = G * NTHR;
    for (int i = gt; i < 2 * 16384 + 16384; i += NGT) {
        u32x4 z = {0u, 0u, 0u, 0u};
        if (i < 32768) { const int l = i >> 14, o = i & 16383; *((u32x4*)(Wb + (size_t)l * LW + W_IN + (size_t)2688 * D) + o) = z; }
        else { *((u32x4*)((bf16*)(ws_l + WS_H) + (size_t)MR * D) + (i - 32768)) = z; }
    }
    bf16* H = (bf16*)(ws_l + WS_H);
    for (int m = gw; m < MR; m += NGW) {
        const float* xr = m < MP ? in_I_XP + (size_t)m * D : in_I_XS + (size_t)(m - MP) * D;
        norm_row_to_bf16(xr, in_I_NG, H + (size_t)m * D, lane);
    }
}

template <bool SRC_F32, bool DST_F32, bool HAS_H>
__device__ __forceinline__ void phase_rowpass(const void* xp, const void* xs, const bf16* Y, float coef, const float* gpost, const float* gpre, void* xdst, bf16* H) {
    const int tid = ltid(), lane = tid & 63, wave = tid >> 6;
    const int gw = blockIdx.x * NWAVES + wave, NGW = gridDim.x * NWAVES;
    f32x4 y[4], x[4], nxf[2][4]; u32x2 ny[2][4], nxb[2][4];
#define RP_LOAD(q_, m_) do { const bf16* yr_ = Y + (size_t)(m_) * D; \
        _Pragma("unroll") for (int j = 0; j < 4; ++j) ny[q_][j] = *((const u32x2*)yr_ + lane + 64 * j); \
        if (SRC_F32) { const float* xr_ = (m_) < MP ? (const float*)xp + (size_t)(m_) * D : (const float*)xs + (size_t)((m_) - MP) * D; \
            _Pragma("unroll") for (int j = 0; j < 4; ++j) nxf[q_][j] = *((const f32x4*)xr_ + lane + 64 * j); } \
        else { const bf16* xr_ = (const bf16*)xp + (size_t)(m_) * D; \
            _Pragma("unroll") for (int j = 0; j < 4; ++j) nxb[q_][j] = *((const u32x2*)xr_ + lane + 64 * j); } } while (0)
    if (gw < MR) RP_LOAD(0, gw);
    if (gw + NGW < MR) RP_LOAD(1, gw + NGW);
    for (int m = gw; m < MR; m += NGW) {
#pragma unroll
        for (int j = 0; j < 4; ++j) { y[j] = (f32x4){bflo(ny[0][j].x), bfhi(ny[0][j].x), bflo(ny[0][j].y), bfhi(ny[0][j].y)};
            x[j] = SRC_F32 ? nxf[0][j] : (f32x4){bflo(nxb[0][j].x), bfhi(nxb[0][j].x), bflo(nxb[0][j].y), bfhi(nxb[0][j].y)};
            ny[0][j] = ny[1][j]; if (SRC_F32) nxf[0][j] = nxf[1][j]; else nxb[0][j] = nxb[1][j]; }
        if (m + 2 * NGW < MR) RP_LOAD(1, m + 2 * NGW);
        float s = 0.f;
#pragma unroll
        for (int j = 0; j < 4; ++j) s += (y[j].x * y[j].x + y[j].y * y[j].y) + (y[j].z * y[j].z + y[j].w * y[j].w);
        const float rstd = rsqrtf(wave_sum(s) * (1.f / D) + RMS_EPS) * coef;
        float s2 = 0.f;
#pragma unroll
        for (int j = 0; j < 4; ++j) { const f32x4 gg = *((const f32x4*)gpost + lane + 64 * j);
            x[j].x += y[j].x * rstd * gg.x; x[j].y += y[j].y * rstd * gg.y; x[j].z += y[j].z * rstd * gg.z; x[j].w += y[j].w * rstd * gg.w;
            s2 += (x[j].x * x[j].x + x[j].y * x[j].y) + (x[j].z * x[j].z + x[j].w * x[j].w);
            if (DST_F32) *((f32x4*)((float*)xdst + (size_t)m * D) + lane + 64 * j) = x[j];
            else { u32x2 o; o.x = pk2(x[j].x, x[j].y); o.y = pk2(x[j].z, x[j].w); *((u32x2*)((bf16*)xdst + (size_t)m * D) + lane + 64 * j) = o; } }
        if (HAS_H) {
            const float r2 = rsqrtf(wave_sum(s2) * (1.f / D) + RMS_EPS);
#pragma unroll
            for (int j = 0; j < 4; ++j) { const f32x4 gg = *((const f32x4*)gpre + lane + 64 * j); u32x2 o; o.x = pk2(x[j].x * r2 * gg.x, x[j].y * r2 * gg.y); o.y = pk2(x[j].z * r2 * gg.z, x[j].w * r2 * gg.w);
                *((u32x2*)(H + (size_t)m * D) + lane + 64 * j) = o; }
        }
    }
#undef RP_LOAD
}

__device__ __forceinline__ void ld8(const bf16* p, float (&f)[8]) {
    const u32x4 w = *(const u32x4*)p;
    f[0] = bflo(w.x); f[1] = bfhi(w.x); f[2] = bflo(w.y); f[3] = bfhi(w.y); f[4] = bflo(w.z); f[5] = bfhi(w.z); f[6] = bflo(w.w); f[7] = bfhi(w.w);
}
__device__ __forceinline__ void conv_part(const Args& a, int l, int bid, int nblk) {
    const int tid = ltid();
    KArgP ap = kargs(); unsigned char* ws_l = ap->ws; float* out_l = ap->out; (void)ws_l; (void)out_l;
    const float* in_I_CONVW = ap->in[I_CONVW];
    const float* in_I_SCONV = ap->in[I_SCONV];
    const bf16* U = (const bf16*)(ws_l + WS_U); bf16* YC = (bf16*)(ws_l + WS_H);
    const float* cw = in_I_CONVW + (size_t)l * 3 * 256;
    const int gt = bid * NTHR + tid, NGT = nblk * NTHR;
    for (int it = gt; it < MR * 32; it += NGT) {
        const int row = it >> 5, c8 = (it & 31) * 8;
        int b, t, Tn; const float* prefix; float* sout;
        if (row < MP) { b = row >> 12; t = row & 4095; Tn = T; prefix = nullptr; sout = out_l + O_PCONV + (size_t)(l * NB + b) * 2 * 256; }
        else { const int rr = row - MP; b = rr >> 4; t = rr & 15; Tn = TS; prefix = in_I_SCONV + (size_t)(l * NB + b) * 2 * 256; sout = out_l + O_SCONV + (size_t)(l * NB + b) * 2 * 256; }
        const bf16* ur = U + (size_t)row * NU;
        float bg[8], z0[8], z1[8], z2[8], cc[8], xx[8];
        ld8(ur + UCB + c8, bg); ld8(ur + UCC + c8, cc); ld8(ur + UCX + c8, xx);
#pragma unroll
        for (int i = 0; i < 8; ++i) z2[i] = cc[i] * xx[i];
        if (t >= 1) { ld8(ur - NU + UCC + c8, cc); ld8(ur - NU + UCX + c8, xx);
#pragma unroll
            for (int i = 0; i < 8; ++i) z1[i] = cc[i] * xx[i]; }
        else {
#pragma unroll
            for (int i = 0; i < 8; ++i) z1[i] = prefix ? prefix[256 + c8 + i] : 0.f; }
        if (t >= 2) { ld8(ur - 2 * NU + UCC + c8, cc); ld8(ur - 2 * NU + UCX + c8, xx);
#pragma unroll
            for (int i = 0; i < 8; ++i) z0[i] = cc[i] * xx[i]; }
        else {
#pragma unroll
            for (int i = 0; i < 8; ++i) z0[i] = prefix ? prefix[(t + 0) * 256 + c8 + i] : 0.f; }
        float y[8];
#pragma unroll
        for (int i = 0; i < 8; ++i) y[i] = bg[i] * (z0[i] * cw[c8 + i] + z1[i] * cw[256 + c8 + i] + z2[i] * cw[512 + c8 + i]);
        u32x4 o; o.x = pk2(y[0], y[1]); o.y = pk2(y[2], y[3]); o.z = pk2(y[4], y[5]); o.w = pk2(y[6], y[7]);
        *(u32x4*)(YC + (size_t)row * D + 512 + c8) = o;
        if (t >= Tn - 2) { float* so = sout + (size_t)(t - (Tn - 2)) * 256 + c8;
            *(f32x4*)so = (f32x4){z2[0], z2[1], z2[2], z2[3]}; *(f32x4*)(so + 4) = (f32x4){z2[4], z2[5], z2[6], z2[7]}; }
    }
}

template <int W>
__device__ __forceinline__ void pool_window(const float (&vals)[31], int pos0, float (&d)[16]) {
#pragma unroll
    for (int i = 0; i < 16; ++i) {
        float s = 0.f;
#pragma unroll
        for (int k = 0; k < W; ++k) s += vals[15 + i - k];
        const int cnt = (pos0 + i + 1) < W ? (pos0 + i + 1) : W;
        d[i] = s / (float)cnt - vals[15 + i];
    }
}
__device__ __forceinline__ void pool_part(const Args& a, int l, unsigned char* lds, int bid, int nblk) {
    KArgP ap = kargs(); unsigned char* ws_l = ap->ws; float* out_l = ap->out; (void)ws_l; (void)out_l;
    const float* in_I_POOLS = ap->in[I_POOLS];
    const float* in_I_POOLW = ap->in[I_POOLW];
    const float* in_I_SPOOL = ap->in[I_SPOOL];
    const bf16* U = (const bf16*)(ws_l + WS_U); bf16* YC = (bf16*)(ws_l + WS_H);
    bf16* dl = (bf16*)lds;
    const int tid = ltid(), c = tid & 255, th = tid >> 8, gi = c >> 6;
    const float* pw = in_I_POOLW + (size_t)(l * 4 + gi) * 64 * 64 + (c & 63);
    const float scale = in_I_POOLS[l * 256 + c];
    for (int item = bid; item < MR / 32; item += nblk) {
        const int row0 = item * 32 + th * 16;
        int b, t0, pos0, Tn; const float* prefix; float* sout;
        if (row0 < MP) { b = row0 >> 12; t0 = row0 & 4095; pos0 = t0; Tn = T; prefix = nullptr; sout = out_l + O_PPOOL + (size_t)(l * NB + b) * 15 * 256; }
        else { const int rr = row0 - MP; b = rr >> 4; t0 = 0; pos0 = PAST; Tn = TS; prefix = in_I_SPOOL + (size_t)(l * NB + b) * 15 * 256; sout = out_l + O_SPOOL + (size_t)(l * NB + b) * 15 * 256; }
        float vals[31];
#pragma unroll
        for (int i = 0; i < 31; ++i) {
            const int tt = t0 - 15 + i;
            vals[i] = (tt >= 0) ? ldbf(U + (size_t)(row0 - 15 + i) * NU + UPOOL + c) : (prefix ? prefix[(size_t)(i + t0) * 256 + c] : 0.f);
        }
        float d[16];
        if (gi == 0) pool_window<2>(vals, pos0, d); else if (gi == 1) pool_window<4>(vals, pos0, d); else if (gi == 2) pool_window<8>(vals, pos0, d); else pool_window<16>(vals, pos0, d);
#pragma unroll
        for (int i = 0; i < 16; ++i) {
            dl[(th * 16 + i) * 256 + c] = (bf16)f2bf(d[i]);
            const int t = t0 + i; if (t >= Tn - 15) sout[(size_t)(t - (Tn - 15)) * 256 + c] = vals[15 + i];
        }
        __syncthreads();
        float acc[16];
#pragma unroll
        for (int i = 0; i < 16; ++i) acc[i] = 0.f;
        for (int j8 = 0; j8 < 8; ++j8) {
            const unsigned w01 = pk2(pw[(8 * j8 + 0) * 64], pw[(8 * j8 + 1) * 64]), w23 = pk2(pw[(8 * j8 + 2) * 64], pw[(8 * j8 + 3) * 64]);
            const unsigned w45 = pk2(pw[(8 * j8 + 4) * 64], pw[(8 * j8 + 5) * 64]), w67 = pk2(pw[(8 * j8 + 6) * 64], pw[(8 * j8 + 7) * 64]);
#pragma unroll
            for (int i = 0; i < 16; ++i) { const u32x4 dv = *(const u32x4*)(dl + (th * 16 + i) * 256 + gi * 64 + 8 * j8);
                acc[i] = dot2bf(dv.w, w67, dot2bf(dv.z, w45, dot2bf(dv.y, w23, dot2bf(dv.x, w01, acc[i])))); }
        }
#pragma unroll
        for (int i = 0; i < 16; ++i) YC[(size_t)(row0 + i) * D + c] = (bf16)f2bf(acc[i] * scale);
        __syncthreads();
    }
}

__device__ __forceinline__ size_t rec_index(int row, int h) {
    if (row < MP) { const int b = row >> 12, t = row & 4095; return ((size_t)b * T) * 4 + (size_t)h * T + t; }
    const int rr = row - MP, b = rr >> 4, t = rr & 15; return ((size_t)MP + (size_t)b * TS) * 4 + (size_t)h * TS + t;
}
__device__ __forceinline__ void rwkv_prep_part(const Args& a, int l, unsigned char* lds) {
    const int tid = ltid();
    KArgP ap = kargs(); unsigned char* ws_l = ap->ws; float* out_l = ap->out;
    const float* in_I_A0 = ap->in[I_A0]; const float* in_I_A2 = ap->in[I_A2]; const float* in_I_G2 = ap->in[I_G2]; const float* in_I_KA = ap->in[I_KA]; const float* in_I_KK = ap->in[I_KK];
    const float* in_I_MU = ap->in[I_MU]; const float* in_I_RK = ap->in[I_RK]; const float* in_I_SSHIFT = ap->in[I_SSHIFT]; const float* in_I_W0 = ap->in[I_W0]; const float* in_I_W2 = ap->in[I_W2];
    const bf16* U = (const bf16*)(ws_l + WS_U);
    unsigned char* SIN = ws_l + WS_SIN; bf16* Gb = (bf16*)(ws_l + WS_G); float* RKb = (float*)(ws_l + WS_RK);
    bf16* lrb = (bf16*)lds;
    const int lane = tid & 63, c = tid & 255, half = tid >> 8, h = c >> 6, cc = c & 63;
    const float* mu = in_I_MU + (size_t)l * RW;
    const float mur = mu[c], muk = mu[256 + c], muv = mu[512 + c];
    const float w0c = in_I_W0[l * 256 + c], a0c = in_I_A0[l * 256 + c], kkc = in_I_KK[l * 256 + c], kac = in_I_KA[l * 256 + c], rkc = in_I_RK[l * 256 + c];
    unsigned w2p[16], a2p[16], g2p[32];
#pragma unroll
    for (int i = 0; i < 16; ++i) { w2p[i] = pk2(in_I_W2[(size_t)(l * 32 + 2 * i) * 256 + c], in_I_W2[(size_t)(l * 32 + 2 * i + 1) * 256 + c]);
                                   a2p[i] = pk2(in_I_A2[(size_t)(l * 32 + 2 * i) * 256 + c], in_I_A2[(size_t)(l * 32 + 2 * i + 1) * 256 + c]); }
#pragma unroll
    for (int i = 0; i < 32; ++i) g2p[i] = pk2(in_I_G2[(size_t)(l * 64 + 2 * i) * 256 + c], in_I_G2[(size_t)(l * 64 + 2 * i + 1) * 256 + c]);
    constexpr int TPI = 32, TPH = 16;
    for (int item = blockIdx.x; item < MR / TPI; item += gridDim.x) {
        const int row0 = item * TPI;
#pragma unroll
        for (int k = 0; k < 8; ++k) {
            const int idx = tid + NTHR * k, tok = idx >> 7, col = idx & 127, row = row0 + tok;
            int t, Tn; const float* shift; float* sout;
            if (row < MP) { t = row & 4095; Tn = T; shift = nullptr; sout = out_l + O_PSHIFT + (size_t)(l * NB + (row >> 12)) * RW; }
            else { const int rr = row - MP; t = rr & 15; Tn = TS; shift = in_I_SSHIFT + (size_t)(l * NB + (rr >> 4)) * RW; sout = out_l + O_SSHIFT + (size_t)(l * NB + (rr >> 4)) * RW; }
            const float cur = ldbf(U + (size_t)row * NU + URW + 768 + col);
            const float prev = (t > 0) ? ldbf(U + (size_t)(row - 1) * NU + URW + 768 + col) : (shift ? shift[768 + col] : 0.f);
            const float xs = cur + (prev - cur) * mu[768 + col];
            lrb[tok * 128 + col] = (bf16)f2bf(col < 32 ? tanh_f(xs) : (col < 64 ? xs : sigmoid_f(xs)));
            if (t == Tn - 1) sout[768 + col] = cur;
        }
        __syncthreads();
        const int rowh = row0 + half * TPH;
        int t0, Tn; const float* shift; float* sout;
        if (rowh < MP) { t0 = rowh & 4095; Tn = T; shift = nullptr; sout = out_l + O_PSHIFT + (size_t)(l * NB + (rowh >> 12)) * RW; }
        else { const int rr = rowh - MP; t0 = rr & 15; Tn = TS; shift = in_I_SSHIFT + (size_t)(l * NB + (rr >> 4)) * RW; sout = out_l + O_SSHIFT + (size_t)(l * NB + (rr >> 4)) * RW; }
        const bf16* ur = U + (size_t)rowh * NU + URW;
        float rp, kp, vp;
        if (t0 > 0) { rp = ldbf(ur - NU + c); kp = ldbf(ur - NU + 256 + c); vp = ldbf(ur - NU + 512 + c); }
        else if (shift) { rp = shift[c]; kp = shift[256 + c]; vp = shift[512 + c]; }
        else { rp = 0.f; kp = 0.f; vp = 0.f; }
        float rua[TPH], kua[TPH], vua[TPH];
#pragma unroll
        for (int i = 0; i < TPH; ++i) { rua[i] = ldbf(ur + (size_t)i * NU + c); kua[i] = ldbf(ur + (size_t)i * NU + 256 + c); vua[i] = ldbf(ur + (size_t)i * NU + 512 + c); }
#pragma unroll
        for (int i = 0; i < TPH; ++i) {
            const int tok = half * TPH + i, row = rowh + i, t = t0 + i;
            const float ru = rua[i], ku = kua[i], vu = vua[i];
            const float r = ru + (rp - ru) * mur, k = ku + (kp - ku) * muk, v = vu + (vp - vu) * muv;
            rp = ru; kp = ku; vp = vu;
            if (t == Tn - 1) { sout[c] = ru; sout[256 + c] = ku; sout[512 + c] = vu; }
            const u32x4* lt = (const u32x4*)(lrb + tok * 128);
            float wp = w0c, ap2 = a0c, gg = 0.f;
#pragma unroll
            for (int j = 0; j < 4; ++j) { const u32x4 x = lt[j]; wp = dot2bf(x.x, w2p[4 * j], wp); wp = dot2bf(x.y, w2p[4 * j + 1], wp); wp = dot2bf(x.z, w2p[4 * j + 2], wp); wp = dot2bf(x.w, w2p[4 * j + 3], wp); }
#pragma unroll
            for (int j = 0; j < 4; ++j) { const u32x4 x = lt[4 + j]; ap2 = dot2bf(x.x, a2p[4 * j], ap2); ap2 = dot2bf(x.y, a2p[4 * j + 1], ap2); ap2 = dot2bf(x.z, a2p[4 * j + 2], ap2); ap2 = dot2bf(x.w, a2p[4 * j + 3], ap2); }
#pragma unroll
            for (int j = 0; j < 8; ++j) { const u32x4 x = lt[8 + j]; gg = dot2bf(x.x, g2p[4 * j], gg); gg = dot2bf(x.y, g2p[4 * j + 1], gg); gg = dot2bf(x.z, g2p[4 * j + 2], gg); gg = dot2bf(x.w, g2p[4 * j + 3], gg); }
            const float w = -softplus_f(-wp) - 0.5f;
            const float decay = __expf(-__expf(w));
            const float aa = sigmoid_f(ap2);
            const float kkr = k * kkc;
            const float nrm = sqrtf(wave_sum(kkr * kkr));
            const float kk = kkr / fmaxf(nrm, 1e-12f);
            const float kh = k * (1.0f + (aa - 1.0f) * kac);
            const float rks = wave_sum(r * kh * rkc);
            unsigned char* rec = SIN + rec_index(row, h) * REC;
            ((bf16*)rec)[cc] = (bf16)f2bf(r); ((bf16*)rec)[64 + cc] = (bf16)f2bf(kh); ((bf16*)rec)[128 + cc] = (bf16)f2bf(v); ((bf16*)rec)[192 + cc] = (bf16)f2bf(kk); ((bf16*)rec)[256 + cc] = (bf16)f2bf(aa);
            ((float*)(rec + 640))[cc] = decay;
            Gb[(size_t)row * 256 + c] = (bf16)f2bf(gg);
            if (lane == 0) RKb[(size_t)row * 4 + h] = rks;
        }
        __syncthreads();
    }
}
__device__ __forceinline__ void skv_part(const Args& a, int l) {
    const int tid = ltid();
    KArgP ap = kargs(); unsigned char* ws_l = ap->ws;
    const float* in_I_CK = ap->in[I_CK];
    const bf16* U = (const bf16*)(ws_l + WS_U); bf16* SK = (bf16*)(ws_l + WS_SKV);
    const int gt = blockIdx.x * NTHR + tid, NGT = gridDim.x * NTHR;
    for (int it = gt; it < NB * SKEYS * 32; it += NGT) {
        const int c8 = (it & 31) * 8, kr = it >> 5, b = kr / SKEYS, key = kr % SKEYS;
        bf16* dst = SK + ((size_t)b * SKEYS + key) * 256 + c8;
        if (key < PAST) {
            const float* src = in_I_CK + (((size_t)(l * NB + b) * PAST + key) * 256 + c8);
            const f32x4 x0 = *(const f32x4*)src, x1 = *(const f32x4*)(src + 4);
            u32x4 o; o.x = pk2(x0.x, x0.y); o.y = pk2(x0.z, x0.w); o.z = pk2(x1.x, x1.y); o.w = pk2(x1.z, x1.w);
            *(u32x4*)dst = o;
        } else {
            *(u32x4*)dst = *(const u32x4*)(U + (size_t)(MP + b * TS + (key - PAST)) * NU + UK + c8);
        }
    }
}
__device__ __forceinline__ void vt_part(const Args& a, int l) {
    const int tid = ltid();
    KArgP ap = kargs(); unsigned char* ws_l = ap->ws;
    const float* in_I_CV = ap->in[I_CV];
    const bf16* U = (const bf16*)(ws_l + WS_U); bf16* VT = (bf16*)(ws_l + WS_VT); bf16* SVT = (bf16*)(ws_l + WS_SVT);
    const int lane = tid & 63, gw = blockIdx.x * NWAVES + (tid >> 6), NGW = gridDim.x * NWAVES;
    constexpr int NPI = 32 * (T / 64), NSI = 32 * (SKP / 64);
    for (int it = gw; it < NPI + NSI; it += NGW) {
        float v[64];
        bf16* dst;
        int pitch;
        if (it < NPI) {
            const int bh = it / (T / 64), tb = it % (T / 64), b = bh >> 2, h = bh & 3, t = tb * 64 + lane;
            const bf16* src = U + (size_t)(b * T + t) * NU + UV + h * 64;
#pragma unroll
            for (int q = 0; q < 8; ++q) { float f[8]; ld8(src + 8 * q, f);
#pragma unroll
                for (int i = 0; i < 8; ++i) v[8 * q + i] = f[i]; }
            dst = VT + (size_t)bh * 64 * VTP + t; pitch = VTP;
        } else {
            const int r = it - NPI, bh = r / (SKP / 64), kb = r % (SKP / 64), b = bh >> 2, h = bh & 3, key = kb * 64 + lane;
            if (key < PAST) { const float* src = in_I_CV + (((size_t)(l * NB + b) * PAST + key) * 256 + h * 64);
#pragma unroll
                for (int q = 0; q < 16; ++q) { const f32x4 x = *(const f32x4*)(src + 4 * q); v[4 * q] = x.x; v[4 * q + 1] = x.y; v[4 * q + 2] = x.z; v[4 * q + 3] = x.w; } }
            else if (key < SKEYS) { const bf16* src = U + (size_t)(MP + b * TS + (key - PAST)) * NU + UV + h * 64;
#pragma unroll
                for (int q = 0; q < 8; ++q) { float f[8]; ld8(src + 8 * q, f);
#pragma unroll
                    for (int i = 0; i < 8; ++i) v[8 * q + i] = f[i]; } }
            else {
#pragma unroll
                for (int i = 0; i < 64; ++i) v[i] = 0.f; }
            dst = SVT + (size_t)bh * 64 * SKP + key; pitch = SKP;
        }
#pragma unroll
        for (int d = 0; d < 64; ++d) dst[(size_t)d * pitch] = (bf16)f2bf(v[d]);
    }
}

constexpr int STEP_B = 1344;
template <int CH>
__device__ __forceinline__ void scan_unit(const Args& a, int l, int unit, unsigned char* lds) {
    constexpr int NP = CH / 16, CHUNK_B = CH * STEP_B;
    struct LdSet { u32x2 r[NP], kh[NP], kk[NP], aa[NP], v[NP]; f32x4 w[NP]; };
    const int tid = ltid();
    KArgP ap = kargs(); unsigned char* ws_l = ap->ws; float* out_l = ap->out;
    const float* in_I_SWKV = ap->in[I_SWKV];
    const int lane = tid & 63, wave = tid >> 6;
    const bool sample = unit >= 128; const int bh = (unit & 127) >> 2, rg = unit & 3, b = bh >> 2, h = bh & 3;
    const int Tn = sample ? TS : T, rowbase = sample ? MP + b * TS : b * T, nch = Tn / CH;
    const unsigned char* rec0 = ws_l + WS_SIN + ((size_t)rowbase * 4 + (size_t)h * Tn) * REC;
    float* YS = (float*)(ws_l + WS_YS);
    const bool loader = wave >= 4;
    const int lt = tid - 256, lstep = lt >> 4, ljq = lt & 15;
    const int rowl = lane >> 4, jq = lane & 15, vrow = rg * 16 + wave * 4 + rowl;
    f32x2v S01 = {0.f, 0.f}, S23 = {0.f, 0.f};
    if (!loader && sample) { const f32x4 s = *(const f32x4*)(in_I_SWKV + ((size_t)((l * NB + b) * 4 + h) * 64 + vrow) * 64 + 4 * jq); S01 = s.lo; S23 = s.hi; }
#define SC_LD(set, chunk) do { if ((chunk) < nch) { _Pragma("unroll") for (int q = 0; q < NP; ++q) { const unsigned char* rp = rec0 + (size_t)((chunk) * CH + 16 * q + lstep) * REC; \
        set.r[q] = *(const u32x2*)(rp + 8 * ljq); set.kh[q] = *(const u32x2*)(rp + 128 + 8 * ljq); set.kk[q] = *(const u32x2*)(rp + 384 + 8 * ljq); set.aa[q] = *(const u32x2*)(rp + 512 + 8 * ljq); \
        set.w[q] = *(const f32x4*)(rp + 640 + 16 * ljq); set.v[q] = *(const u32x2*)(rp + 256 + 2 * (rg * 16) + 8 * (ljq & 3)); } } } while (0)
#define SC_ST(set, bufi) do { _Pragma("unroll") for (int q = 0; q < NP; ++q) { unsigned char* sp = lds + (bufi) * CHUNK_B + (16 * q + lstep) * STEP_B; \
        const f32x4 kkf = {bflo(set.kk[q].x), bfhi(set.kk[q].x), bflo(set.kk[q].y), bfhi(set.kk[q].y)}; const f32x4 af = {bflo(set.aa[q].x), bfhi(set.aa[q].x), bflo(set.aa[q].y), bfhi(set.aa[q].y)}; \
        *(f32x4*)(sp + 16 * ljq) = (f32x4){bflo(set.r[q].x), bfhi(set.r[q].x), bflo(set.r[q].y), bfhi(set.r[q].y)}; \
        *(f32x4*)(sp + 256 + 16 * ljq) = set.w[q]; \
        *(f32x4*)(sp + 512 + 16 * ljq) = (f32x4){bflo(set.kh[q].x), bfhi(set.kh[q].x), bflo(set.kh[q].y), bfhi(set.kh[q].y)}; \
        *(f32x4*)(sp + 768 + 16 * ljq) = kkf; *(f32x4*)(sp + 1024 + 16 * ljq) = kkf * af; \
        if (ljq < 4) *(f32x4*)(sp + 1280 + 16 * ljq) = (f32x4){bflo(set.v[q].x), bfhi(set.v[q].x), bflo(set.v[q].y), bfhi(set.v[q].y)}; } } while (0)
#define SC_RD(slot, s_) do { const unsigned char* sp = cp + (s_) * STEP_B; rr[slot] = *(const f32x4*)(sp + 16 * jq); ww[slot] = *(const f32x4*)(sp + 256 + 16 * jq); kh[slot] = *(const f32x4*)(sp + 512 + 16 * jq); \
        kk[slot] = *(const f32x4*)(sp + 768 + 16 * jq); ka[slot] = *(const f32x4*)(sp + 1024 + 16 * jq); vv[slot] = *(const float*)(sp + 1280 + 4 * (wave * 4 + rowl)); } while (0)
#define SC_SCAN(bufi, chunk) do { const unsigned char* cp = lds + (bufi) * CHUNK_B; float* yp = YS + (size_t)(rowbase + (chunk) * CH + jq) * 256 + h * 64 + vrow; \
        f32x4 rr[3], ww[3], kh[3], kk[3], ka[3]; float vv[3]; float ysel = 0.f; f32x4 rprev = {0.f, 0.f, 0.f, 0.f}; \
        SC_RD(0, 0); SC_RD(1, 1); \
        _Pragma("unroll") for (int s = 0; s < CH; ++s) { const int c_ = s % 3; if (s > 0) rprev = rr[(s + 2) % 3]; if (s + 2 < CH) SC_RD((s + 2) % 3, s + 2); \
            const f32x2v p2 = S01 * kk[c_].lo + S23 * kk[c_].hi; float sa = p2.x + p2.y; \
            if (s > 0) { const f32x2v q2 = S01 * rprev.lo + S23 * rprev.hi; float yq = q2.x + q2.y; red16_2(sa, yq); ysel = (((s - 1) & 15) == jq) ? yq : ysel; if (((s - 1) & 15) == 15) yp[(size_t)(s - 16) * 256] = ysel; } \
            else sa = red16(sa); \
            const f32x2v vk01 = vv[c_] * kh[c_].lo, vk23 = vv[c_] * kh[c_].hi; \
            S01 = S01 * ww[c_].lo + (vk01 - sa * ka[c_].lo); S23 = S23 * ww[c_].hi + (vk23 - sa * ka[c_].hi); } \
        { const int p_ = (CH - 1) % 3; const f32x2v q2 = S01 * rr[p_].lo + S23 * rr[p_].hi; const float yq = red16(q2.x + q2.y); ysel = (15 == jq) ? yq : ysel; yp[(size_t)(CH - 16) * 256] = ysel; } } while (0)
    if (loader) {
        __builtin_amdgcn_s_setprio(2);
        LdSet A, B;
        SC_LD(A, 0); SC_ST(A, 0); SC_LD(A, 1); SC_LD(B, 2);
        __syncthreads();
        for (int ch = 0; ch < nch; ch += 2) {
            if (ch + 1 < nch) SC_ST(A, 1);
            SC_LD(A, ch + 3);
            __syncthreads();
            if (ch + 1 < nch) { if (ch + 2 < nch) SC_ST(B, 0); SC_LD(B, ch + 4); __syncthreads(); }
        }
        __builtin_amdgcn_s_setprio(0);
    } else {
        __syncthreads();
        for (int ch = 0; ch < nch; ch += 2) {
            SC_SCAN(0, ch);
            __syncthreads();
            if (ch + 1 < nch) { SC_SCAN(1, ch + 1); __syncthreads(); }
        }
    }
#undef SC_LD
#undef SC_ST
#undef SC_RD
#undef SC_SCAN
    if (!loader) {
        float* so = out_l + (sample ? O_SWKV : O_PWKV) + ((size_t)((l * NB + b) * 4 + h) * 64 + vrow) * 64 + 4 * jq;
        *(f32x4*)so = (f32x4){S01.x, S01.y, S23.x, S23.y};
    }
}

__device__ __forceinline__ f32x4 mfma16(bf16x8 A, bf16x8 B, f32x4 C) { return __builtin_amdgcn_mfma_f32_16x16x32_bf16(A, B, C, 0, 0, 0); }
__device__ __forceinline__ bf16x8 pack8(const f32x4 lo, const f32x4 hi) {
    u32x4 w; w.x = pk2(lo.x, lo.y); w.y = pk2(lo.z, lo.w); w.z = pk2(hi.x, hi.y); w.w = pk2(hi.z, hi.w); return __builtin_bit_cast(bf16x8, w);
}
__device__ __forceinline__ void attn_unit(const bf16* Q, int qp, const bf16* K, int kp, const bf16* VT, int vp, int qpos0, int kmax, bf16* O, int op, int lane) {
    const int fr = lane & 15, g = lane >> 4;
    bf16x8 qf[2];
#pragma unroll
    for (int ds = 0; ds < 2; ++ds) qf[ds] = *(const bf16x8*)(Q + (size_t)fr * qp + 32 * ds + 8 * g);
    f32x4 o[4];
#pragma unroll
    for (int i = 0; i < 4; ++i) o[i] = (f32x4){0.f, 0.f, 0.f, 0.f};
    float R = 0.f;
    const int qpos = qpos0 + fr;
    u32x4 onesw = {0x3F803F80u, 0x3F803F80u, 0x3F803F80u, 0x3F803F80u};
    const bf16x8 ones = __builtin_bit_cast(bf16x8, onesw);
    bf16x8 kf[4][2];
#define AT_LDK(kt_) do { _Pragma("unroll") for (int kb = 0; kb < 4; ++kb) { int kr = (kt_) * 64 + 16 * kb + fr; kr = kr > kmax ? kmax : kr; const bf16* krow = K + (size_t)kr * kp + 8 * g; \
        kf[kb][0] = *(const bf16x8*)krow; kf[kb][1] = *(const bf16x8*)(krow + 32); } } while (0)
    AT_LDK((qpos0 + 14) >> 6);
    for (int kt = (qpos0 + 14) >> 6; kt >= 0; --kt) {
        const int key0 = kt * 64;
        u32x2 vf[2][4][2];
#pragma unroll
        for (int ks = 0; ks < 2; ++ks)
#pragma unroll
            for (int db = 0; db < 4; ++db) { const bf16* vrow = VT + (size_t)(16 * db + fr) * vp + key0 + 32 * ks + 4 * g; vf[ks][db][0] = *(const u32x2*)vrow; vf[ks][db][1] = *(const u32x2*)(vrow + 16); }
        f32x4 z[4];
#pragma unroll
        for (int kb = 0; kb < 4; ++kb) {
            f32x4 acc = {0.f, 0.f, 0.f, 0.f};
            acc = mfma16(kf[kb][0], qf[0], acc);
            acc = mfma16(kf[kb][1], qf[1], acc);
            z[kb] = acc;
        }
        if (kt > 0) AT_LDK(kt - 1);
        f32x4 lk[4], ls[4]; bool vis[4][4];
#pragma unroll
        for (int kb = 0; kb < 4; ++kb)
#pragma unroll
            for (int r = 0; r < 4; ++r) {
                const int key = key0 + 16 * kb + 4 * g + r;
                const float zz = z[kb][r] * 0.125f, sp = softplus_f(zz);
                vis[kb][r] = key < qpos;
                lk[kb][r] = vis[kb][r] ? -sp : 0.f;
                ls[kb][r] = zz - sp;
            }
        bf16x8 Bhi[2], Blo[2];
#pragma unroll
        for (int ks = 0; ks < 2; ++ks) {
            u32x4 hw, lw;
            { const f32x4 x = lk[2 * ks]; const unsigned h01 = pk2(x.x, x.y), h23 = pk2(x.z, x.w); hw.x = h01; hw.y = h23; lw.x = pk2(x.x - bflo(h01), x.y - bfhi(h01)); lw.y = pk2(x.z - bflo(h23), x.w - bfhi(h23)); }
            { const f32x4 x = lk[2 * ks + 1]; const unsigned h01 = pk2(x.x, x.y), h23 = pk2(x.z, x.w); hw.z = h01; hw.w = h23; lw.z = pk2(x.x - bflo(h01), x.y - bfhi(h01)); lw.w = pk2(x.z - bflo(h23), x.w - bfhi(h23)); }
            Bhi[ks] = __builtin_bit_cast(bf16x8, hw); Blo[ks] = __builtin_bit_cast(bf16x8, lw);
        }
        f32x4 tot = {0.f, 0.f, 0.f, 0.f};
#pragma unroll
        for (int ks = 0; ks < 2; ++ks) { tot = mfma16(ones, Bhi[ks], tot); tot = mfma16(ones, Blo[ks], tot); }
        f32x4 p[4];
#pragma unroll
        for (int kb = 0; kb < 4; ++kb) {
            f32x4 la = {0.f, 0.f, 0.f, 0.f};
            const int s = 16 * kb + fr;
#pragma unroll
            for (int ks = 0; ks < 2; ++ks) {
                if (32 * ks + 31 > 16 * kb) {
                    u32x4 tw;
                    unsigned e[8];
#pragma unroll
                    for (int j = 0; j < 8; ++j) { const int jp = 32 * ks + 16 * (j >> 2) + 4 * g + (j & 3); e[j] = jp > s ? 0x3F80u : 0u; }
                    tw.x = e[0] | (e[1] << 16); tw.y = e[2] | (e[3] << 16); tw.z = e[4] | (e[5] << 16); tw.w = e[6] | (e[7] << 16);
                    const bf16x8 tri = __builtin_bit_cast(bf16x8, tw);
                    la = mfma16(tri, Bhi[ks], la); la = mfma16(tri, Blo[ks], la);
                }
            }
#pragma unroll
            for (int r = 0; r < 4; ++r) p[kb][r] = vis[kb][r] ? __expf(ls[kb][r] + la[r] + R) : 0.f;
        }
        R += tot[0];
#pragma unroll
        for (int ks = 0; ks < 2; ++ks) {
            const bf16x8 pf = pack8(p[2 * ks], p[2 * ks + 1]);
#pragma unroll
            for (int db = 0; db < 4; ++db) {
                u32x4 vw; vw.x = vf[ks][db][0].x; vw.y = vf[ks][db][0].y; vw.z = vf[ks][db][1].x; vw.w = vf[ks][db][1].y;
                o[db] = mfma16(__builtin_bit_cast(bf16x8, vw), pf, o[db]);
            }
        }
        if (__all(R < -110.f)) break;
    }
#undef AT_LDK
#pragma unroll
    for (int db = 0; db < 4; ++db) { u32x2 w; w.x = pk2(o[db][0], o[db][1]); w.y = pk2(o[db][2], o[db][3]); *(u32x2*)(O + (size_t)fr * op + 16 * db + 4 * g) = w; }
}
__device__ __forceinline__ void attn_part(const Args& a, int l, int aw, int naw) {
    const int tid = ltid();
    KArgP ap = kargs(); unsigned char* ws_l = ap->ws; float* out_l = ap->out; (void)ws_l; (void)out_l;
    const bf16* U = (const bf16*)(ws_l + WS_U); bf16* YC = (bf16*)(ws_l + WS_H);
    const bf16* SK = (const bf16*)(ws_l + WS_SKV); const bf16* VT = (const bf16*)(ws_l + WS_VT); const bf16* SVT = (const bf16*)(ws_l + WS_SVT);
    const int lane = tid & 63;
    constexpr int NUNIT = 32 + NB * 4 * (T / 16);
    for (int u = aw; u < NUNIT; u += naw) {
        if (u < 32) { const int b = u >> 2, h = u & 3; const int row0 = MP + b * TS;
            attn_unit(U + (size_t)row0 * NU + UQ + h * 64, NU, SK + (size_t)b * SKEYS * 256 + h * 64, 256, SVT + (size_t)u * 64 * SKP, SKP, PAST, SKEYS - 1, YC + (size_t)row0 * D + 768 + h * 64, D, lane);
        } else { const int v = u - 32, qb = v & 255, bh = v >> 8, b = bh >> 2, h = bh & 3; const int row0 = b * T + qb * 16;
            attn_unit(U + (size_t)row0 * NU + UQ + h * 64, NU, U + (size_t)(b * T) * NU + UK + h * 64, NU, VT + (size_t)bh * 64 * VTP, VTP, qb * 16, T - 1, YC + (size_t)row0 * D + 768 + h * 64, D, lane);
        }
    }
}

__device__ __forceinline__ void rwkv_post(const Args& a, int l) {
    const int tid = ltid();
    KArgP ap = kargs(); unsigned char* ws_l = ap->ws;
    const float* in_I_LNB = ap->in[I_LNB]; const float* in_I_LNW = ap->in[I_LNW];
    const float* YS = (const float*)(ws_l + WS_YS); const bf16* Gb = (const bf16*)(ws_l + WS_G); const float* RKb = (const float*)(ws_l + WS_RK);
    bf16* YC = (bf16*)(ws_l + WS_H);
    const int lane = tid & 63, wave = tid >> 6, h = lane >> 4, c4 = 4 * lane, cc = 4 * (lane & 15);
    const f32x4 lnw = *(const f32x4*)(in_I_LNW + l * 256 + c4), lnb = *(const f32x4*)(in_I_LNB + l * 256 + c4);
    const int gw = blockIdx.x * NWAVES + wave, NGW = gridDim.x * NWAVES;
#define PO_BODY(row_, y_, gq_, vq_, rk_) do { \
        const float mean = red16((y_.x + y_.y) + (y_.z + y_.w)) * (1.f / 64.f); const f32x4 dv = y_ - mean; \
        const float var = red16((dv.x * dv.x + dv.y * dv.y) + (dv.z * dv.z + dv.w * dv.w)) * (1.f / 64.f); const float rs = rsqrtf(var + GN_EPS); \
        const float o0 = (dv.x * rs * lnw.x + lnb.x + rk_ * bflo(vq_.x)) * bflo(gq_.x), o1 = (dv.y * rs * lnw.y + lnb.y + rk_ * bfhi(vq_.x)) * bfhi(gq_.x); \
        const float o2 = (dv.z * rs * lnw.z + lnb.z + rk_ * bflo(vq_.y)) * bflo(gq_.y), o3 = (dv.w * rs * lnw.w + lnb.w + rk_ * bfhi(vq_.y)) * bfhi(gq_.y); \
        u32x2 o; o.x = pk2(o0, o1); o.y = pk2(o2, o3); *(u32x2*)(YC + (size_t)(row_) * D + 256 + c4) = o; } while (0)
#define PO_LOAD(r_, y_, g_, v_, k_) do { y_ = *(const f32x4*)(YS + (size_t)(r_) * 256 + c4); g_ = *(const u32x2*)(Gb + (size_t)(r_) * 256 + c4); \
        v_ = *(const u32x2*)(ws_l + WS_SIN + rec_index((r_), h) * REC + 256 + 2 * cc); k_ = RKb[(size_t)(r_) * 4 + h]; } while (0)
    for (int row = gw; row < MR; row += 4 * NGW) {
        f32x4 y0, y1, y2, y3; u32x2 g0, g1, g2, g3, v0, v1, v2, v3; float k0, k1, k2, k3;
        const int r1 = row + NGW, r2 = row + 2 * NGW, r3 = row + 3 * NGW;
        PO_LOAD(row, y0, g0, v0, k0);
        if (r1 < MR) PO_LOAD(r1, y1, g1, v1, k1);
        if (r2 < MR) PO_LOAD(r2, y2, g2, v2, k2);
        if (r3 < MR) PO_LOAD(r3, y3, g3, v3, k3);
        PO_BODY(row, y0, g0, v0, k0);
        if (r1 < MR) PO_BODY(r1, y1, g1, v1, k1);
        if (r2 < MR) PO_BODY(r2, y2, g2, v2, k2);
        if (r3 < MR) PO_BODY(r3, y3, g3, v3, k3);
    }
#undef PO_BODY
#undef PO_LOAD
}

template <int MODE, int K>
__device__ __forceinline__ void small_gemm(const bf16* A, const bf16* Bt, int ncol16, bf16* Ob, float* Of, int ldc, float* sk, float* sv, unsigned char* lds, int bid, int G) {
    constexpr int KW = K / 8, NKS = KW / 32, NB_ = (MODE == 1) ? 4 : 2;
    static_assert(KW % 32 == 0, "K split");
    const int tid = ltid(), lane = tid & 63, wave = tid >> 6, fr = lane & 15, g = lane >> 4;
    float* part = (float*)lds;
    const int ntile = 8 * (ncol16 / 2);
    bf16x8 af[NKS], b0[NKS], b1[NKS], b2[NKS], b3[NKS];
    int tile = bid;
#define SG_ROW(c_) ((MODE == 1) ? (256 * ((c_) >> 7) + ((c_) & 127)) : (c_))
#define SG_LOAD(tl) do { const int mt_ = (tl) & 7, c0_ = ((tl) >> 3) * 32; \
        const bf16* ap_ = A + (size_t)(mt_ * 16 + fr) * K + wave * KW + 8 * g; const bf16* bp_ = Bt + (size_t)(SG_ROW(c0_) + fr) * K + wave * KW + 8 * g; const bf16* bq_ = bp_ + (size_t)16 * K; \
        _Pragma("unroll") for (int q = 0; q < NKS; ++q) { af[q] = *(const bf16x8*)(ap_ + 32 * q); b0[q] = *(const bf16x8*)(bp_ + 32 * q); b1[q] = *(const bf16x8*)(bq_ + 32 * q); \
            if (MODE == 1) { b2[q] = *(const bf16x8*)(bp_ + (size_t)128 * K + 32 * q); b3[q] = *(const bf16x8*)(bq_ + (size_t)128 * K + 32 * q); } } } while (0)
    if (tile < ntile) SG_LOAD(tile);
    for (int it = 0; tile < ntile; ++it, tile += G) {
        f32x4 acc0 = {0.f, 0.f, 0.f, 0.f}, acc1 = acc0, acc2 = acc0, acc3 = acc0;
#pragma unroll
        for (int q = 0; q < NKS; ++q) { acc0 = mfma16(b0[q], af[q], acc0); acc1 = mfma16(b1[q], af[q], acc1); if (MODE == 1) { acc2 = mfma16(b2[q], af[q], acc2); acc3 = mfma16(b3[q], af[q], acc3); } }
        if (tile + G < ntile) SG_LOAD(tile + G);
        float* pb = part + (it & 1) * (8 * NB_ * 256);
        *(f32x4*)(pb + (wave * NB_ + 0) * 256 + lane * 4) = acc0; *(f32x4*)(pb + (wave * NB_ + 1) * 256 + lane * 4) = acc1;
        if (MODE == 1) { *(f32x4*)(pb + (wave * NB_ + 2) * 256 + lane * 4) = acc2; *(f32x4*)(pb + (wave * NB_ + 3) * 256 + lane * 4) = acc3; }
        __syncthreads();
        {
            const int sub = tid >> 8, e = tid & 255;
            float s0 = 0.f, s1 = 0.f;
#pragma unroll
            for (int w = 0; w < 8; ++w) { s0 += pb[(w * NB_ + sub) * 256 + e]; if (MODE == 1) s1 += pb[(w * NB_ + 2 + sub) * 256 + e]; }
            const int ln = e >> 2, r = e & 3, mt = tile & 7, c0 = (tile >> 3) * 32 + 16 * sub;
            const int m = mt * 16 + (ln & 15), n = c0 + 4 * (ln >> 4) + r;
            if (MODE == 0) Ob[(size_t)m * ldc + n] = (bf16)f2bf(s0);
            else if (MODE == 1) Ob[(size_t)m * ldc + n] = (bf16)f2bf(pg8::silu_f(s0) * s1);
            else { Ob[(size_t)m * ldc + n] = (bf16)f2bf(s0); if (n >= UK && n < UK + 512) ((n < UV ? sk : sv) + (size_t)m * 256)[n & 255] = s0; }
        }
    }
#undef SG_LOAD
#undef SG_ROW
    __syncthreads();
}

#define XB_TMO      128
#define XB_XCNT(j)  (256  + 64 * (j))
#define XB_XSUB(j)  (1280 + 64 * (j))
#define XB_XGEN(j)  (2304 + 64 * (j))
#define XB_TOP      3328
#define XB_TOPGEN   3392
#define XCD_BAR_WORDS 3456
#define XB_SPIN_CAP (1u << 18)

__device__ __forceinline__ unsigned xb_ld(unsigned* p)              { return __hip_atomic_load(p, __ATOMIC_RELAXED, __HIP_MEMORY_SCOPE_AGENT); }
__device__ __forceinline__ unsigned xb_add(unsigned* p, unsigned v) { return __hip_atomic_fetch_add(p, v, __ATOMIC_RELAXED, __HIP_MEMORY_SCOPE_AGENT); }
__device__ __forceinline__ unsigned xb_xcc_id() { return (unsigned)__builtin_amdgcn_s_getreg((3 << 11) | 20) & 0xFu; }
#define XB_SPIN(cond, bar) do { unsigned _sp = 0; while (cond) { __builtin_amdgcn_s_sleep(1); \
    if ((++_sp & 255u) == 0u) { if (xb_ld(&(bar)[XB_TMO])) break; if (_sp > XB_SPIN_CAP) { atomicAdd(&(bar)[XB_TMO], 1u); break; } } } } while (0)

struct XcdBarrier {
    unsigned* bar; unsigned x;
    volatile LAS unsigned* st;
};

__device__ __forceinline__ XcdBarrier xcd_barrier_post(unsigned* bar, volatile LAS unsigned* st) {
    XcdBarrier b; b.bar = bar; b.x = xb_xcc_id(); b.st = st;
    if (threadIdx.x == 0) (void)xb_add(&bar[XB_XCNT(b.x)], 1u);
    return b;
}
__device__ __forceinline__ void xcd_barrier_complete(unsigned* bar, unsigned x, unsigned& nloc, unsigned& nx) {
    const unsigned G = gridDim.x * gridDim.y * gridDim.z;
    unsigned sum, cnt, mine, sp = 0u;
    for (;;) {
        sum = 0u; cnt = 0u; mine = 0u;
#pragma unroll
        for (unsigned j = 0; j < 16; ++j) { const unsigned c = xb_ld(&bar[XB_XCNT(j)]); sum += c; cnt += (c > 0u) ? 1u : 0u; mine = (j == x) ? c : mine; }
        if (sum == G) break;
        __builtin_amdgcn_s_sleep(1);
        if ((++sp & 255u) == 0u) { if (xb_ld(&bar[XB_TMO])) break; if (sp > XB_SPIN_CAP) { atomicAdd(&bar[XB_TMO], 1u); break; } }
    }
    nloc = mine > 0u ? mine : 1u; nx = cnt > 0u ? cnt : 1u;
}

__device__ __forceinline__ void xcd_barrier(const XcdBarrier& b) {
    asm volatile("s_waitcnt vmcnt(0)" ::: "memory");
    __syncthreads();
    if (threadIdx.x == 0) {
        unsigned* bar = b.bar;
        __builtin_amdgcn_s_waitcnt(0);
        unsigned nloc = b.st[0], nx = b.st[1];
        if (nloc == 0u) { xcd_barrier_complete(bar, b.x, nloc, nx); b.st[0] = nloc; b.st[1] = nx; }
        const unsigned old = xb_add(&bar[XB_XSUB(b.x)], 1u);
        const unsigned gen = old / nloc;
        if (old + 1u == (gen + 1u) * nloc) {
            __builtin_amdgcn_fence(__ATOMIC_RELEASE, "agent");
            asm volatile("s_waitcnt vmcnt(0)" ::: "memory");
            const unsigned og = xb_add(&bar[XB_TOP], 1u);
            const unsigned tg = og / nx;
            if (og + 1u == (tg + 1u) * nx) xb_add(&bar[XB_TOPGEN], 1u);
            else XB_SPIN(xb_ld(&bar[XB_TOPGEN]) == tg, bar);
            __builtin_amdgcn_fence(__ATOMIC_ACQUIRE, "agent");
            xb_add(&bar[XB_XGEN(b.x)], 1u);
            asm volatile("s_waitcnt vmcnt(0)" ::: "memory");
        } else {
            XB_SPIN(xb_ld(&bar[XB_XGEN(b.x)]) == gen, bar);
            __builtin_amdgcn_fence(__ATOMIC_ACQUIRE, "agent");
            asm volatile("s_waitcnt vmcnt(0)" ::: "memory");
        }
    }
    __syncthreads();
}

__global__ void __launch_bounds__(NTHR, 2) mk_fwd(Args a) {
    extern __shared__ __attribute__((aligned(16))) unsigned char lds[];
    cg::grid_group grid = cg::this_grid();
    const int lo = MK_PER_PHASE ? a.ph_lo : 0, hi = MK_PER_PHASE ? a.ph_hi : NPH, G = gridDim.x;
#define IN(k) (lo <= (k) && (k) < hi)
    for (int u_ = ltid(); u_ < 64; u_ += NTHR) ((LAS unsigned*)((LAS unsigned char*)lds + 131072))[u_] = 0u;
    __syncthreads();
    (void)xcd_barrier_post((unsigned*)(a.ws + WS_CTL), (volatile LAS unsigned*)((LAS unsigned char*)lds + 131072 + 64));
#define XBAR_NOW() do { XcdBarrier xb_; xb_.bar = (unsigned*)(kargs()->ws + WS_CTL); xb_.x = xb_xcc_id(); xb_.st = (volatile LAS unsigned*)((LAS unsigned char*)lds + 131072 + 64); xcd_barrier(xb_); } while (0)
#define SEAM(k) do { if (IN(k) && IN((k) + 1)) { if ((k) == PH_PRE) grid.sync(); else XBAR_NOW(); } } while (0)
    PG8_LAS unsigned char* ring = (PG8_LAS unsigned char*)lds;
#define PHASE_PTRS KArgP ap = kargs(); unsigned char* ws_ = ap->ws; float* out_ = ap->out; \
    bf16* Wb = (bf16*)(ws_ + WS_W); bf16* H = (bf16*)(ws_ + WS_H); bf16* ACT = (bf16*)(ws_ + WS_U); bf16* Y = (bf16*)(ws_ + WS_Y); float* X = out_ + O_X; bf16* XB = (bf16*)(out_ + O_X); bf16* XALT = (bf16*)(ws_ + WS_Y + (size_t)M * D * 2); \
    const bf16* WL = Wb + (size_t)l * LW; const float* ng = ap->in[I_NG] + (size_t)l * 6 * D; (void)H; (void)ACT; (void)Y; (void)X; (void)XB; (void)XALT; (void)WL; (void)ng;

#define REPEAT(bit) _Pragma("nounroll") for (int rep_ = 0; rep_ < ((REP & (bit)) ? 2 : 1); ++rep_)
#define RSYNC if (rep_) XBAR_NOW();
#define GEMM_MAIN(EPI, Aptr, Wptr, NN, KK, EOBJ) { pg8::Gemm g{Aptr, Wptr, MP, NN, KK}; pg8::StaticOrder S; S.init(MP, NN, G, (int)blockIdx.x); pg8::gemm_phase<EPI, pg8::StaticOrder, true, true>(ring, g, S, EOBJ); }
#define SMALL_IDS const int tid_ = ltid(); const int gw_ = (int)blockIdx.x * NWAVES + (tid_ >> 6), ngw_ = G * NWAVES, lane_ = tid_ & 63;
    if (REP & 16384) { for (int i = 0; i < 20; ++i) XBAR_NOW(); }
    if (IN(PH_PRE)) REPEAT(128) { RSYNC phase_pre(a, lds); }
    SEAM(PH_PRE);
    for (int l = 0; l < 2; ++l) {
        const int p0 = 1 + l * PH_PER_LAYER;
        if (IN(p0 + P_A1)) REPEAT(1) { RSYNC PHASE_PTRS
            { pg8::EpiSwiglu E{ACT, FF}; GEMM_MAIN(pg8::EpiSwiglu, H, WL + W_GUA, 2 * FF, D, E) }
            small_gemm<1, D>(H + (size_t)MP * D, WL + W_GUA, FF / 16, ACT + (size_t)MP * FF, nullptr, FF, nullptr, nullptr, lds, (int)blockIdx.x, G); }
        SEAM(p0 + P_A1);
        if (IN(p0 + P_A2)) REPEAT(2) { RSYNC PHASE_PTRS
            { pg8::EpiBf E{Y, D}; GEMM_MAIN(pg8::EpiBf, ACT, WL + W_DA, D, FF, E) }
            small_gemm<0, FF>(ACT + (size_t)MP * FF, WL + W_DA, D / 16, Y + (size_t)MP * D, nullptr, D, nullptr, nullptr, lds, (int)blockIdx.x, G); }
        SEAM(p0 + P_A2);
        if (IN(p0 + P_A3)) { PHASE_PTRS
            if (l == 0) phase_rowpass<true, false, true>(ap->in[I_XP], ap->in[I_XS], Y, 0.5f, ng + 1 * D, ng + 2 * D, XB, H);
            else        phase_rowpass<false, false, true>(XB, XB, Y, 0.5f, ng + 1 * D, ng + 2 * D, XB, H);
        }
        SEAM(p0 + P_A3);
        if (IN(p0 + P_B1)) REPEAT(4) { RSYNC PHASE_PTRS
            { pg8::EpiU E{ACT, NU, out_ + O_PK + (size_t)l * MP * 256, out_ + O_PV + (size_t)l * MP * 256, out_ + O_SK + (size_t)l * MS * 256, out_ + O_SV + (size_t)l * MS * 256, MP, MR};
              GEMM_MAIN(pg8::EpiU, H, WL + W_IN, NU, D, E) }
            if (G == 256) { if ((int)blockIdx.x >= 128) small_gemm<2, D>(H + (size_t)MP * D, WL + W_IN, NU / 16, ACT + (size_t)MP * NU, nullptr, NU, out_ + O_SK + (size_t)l * MS * 256, out_ + O_SV + (size_t)l * MS * 256, lds, (int)blockIdx.x - 128, 128); }
              else small_gemm<2, D>(H + (size_t)MP * D, WL + W_IN, NU / 16, ACT + (size_t)MP * NU, nullptr, NU, out_ + O_SK + (size_t)l * MS * 256, out_ + O_SV + (size_t)l * MS * 256, lds, (int)blockIdx.x, G); }
        SEAM(p0 + P_B1);
        if (IN(p0 + P_C1)) REPEAT(16) { RSYNC
            skv_part(a, l); vt_part(a, l);
            for (int r4_ = 0; r4_ < ((REP & 4096) ? 2 : 1); ++r4_) rwkv_prep_part(a, l, lds);
        }
        SEAM(p0 + P_C1);
        if (IN(p0 + P_C2)) REPEAT(32) { RSYNC
            _Pragma("nounroll") for (int r2_ = 0; r2_ < ((REP & 256) ? 2 : 1); ++r2_)
            for (int u = blockIdx.x; u < 256; u += G) { if (u < 128) scan_unit<32>(a, l, u, lds); else scan_unit<16>(a, l, u, lds); }
            const int ab0 = G / 2;
            if ((int)blockIdx.x >= ab0) { _Pragma("nounroll") for (int r3_ = 0; r3_ < ((REP & 512) ? 2 : 1); ++r3_) attn_part(a, l, ((int)blockIdx.x - ab0) * NWAVES + (int)(ltid() >> 6), (G - ab0) * NWAVES);
                for (int r4_ = 0; r4_ < ((REP & 1024) ? 2 : 1); ++r4_) conv_part(a, l, (int)blockIdx.x - ab0, G - ab0);
                for (int r4_ = 0; r4_ < ((REP & 2048) ? 2 : 1); ++r4_) pool_part(a, l, lds, (int)blockIdx.x - ab0, G - ab0); }
        }
        SEAM(p0 + P_C2);
        if (IN(p0 + P_C3)) REPEAT(64) { RSYNC rwkv_post(a, l); }
        SEAM(p0 + P_C3);
        if (IN(p0 + P_D1)) REPEAT(8) { RSYNC PHASE_PTRS
            { pg8::EpiBf E{Y, D}; GEMM_MAIN(pg8::EpiBf, H, WL + W_OUT, D, D, E) }
            small_gemm<0, D>(H + (size_t)MP * D, WL + W_OUT, D / 16, Y + (size_t)MP * D, nullptr, D, nullptr, nullptr, lds, (int)blockIdx.x, G); }
        SEAM(p0 + P_D1);
        if (IN(p0 + P_D2)) { PHASE_PTRS if (l == 0) phase_rowpass<false, false, true>(XB, XB, Y, 1.0f, ng + 3 * D, ng + 4 * D, XB, H);
            else        phase_rowpass<false, false, true>(XB, XB, Y, 1.0f, ng + 3 * D, ng + 4 * D, XALT, H); }
        SEAM(p0 + P_D2);
        if (IN(p0 + P_E1)) REPEAT(1) { RSYNC PHASE_PTRS
            { pg8::EpiSwiglu E{ACT, FF}; GEMM_MAIN(pg8::EpiSwiglu, H, WL + W_GUB, 2 * FF, D, E) }
            small_gemm<1, D>(H + (size_t)MP * D, WL + W_GUB, FF / 16, ACT + (size_t)MP * FF, nullptr, FF, nullptr, nullptr, lds, (int)blockIdx.x, G); }
        SEAM(p0 + P_E1);
        if (IN(p0 + P_E2)) REPEAT(2) { RSYNC PHASE_PTRS
            { pg8::EpiBf E{Y, D}; GEMM_MAIN(pg8::EpiBf, ACT, WL + W_DB, D, FF, E) }
            small_gemm<0, FF>(ACT + (size_t)MP * FF, WL + W_DB, D / 16, Y + (size_t)MP * D, nullptr, D, nullptr, nullptr, lds, (int)blockIdx.x, G); }
        SEAM(p0 + P_E2);
        if (IN(p0 + P_E3)) { PHASE_PTRS
            if (l == 0) phase_rowpass<false, false, true>(XB, XB, Y, 0.5f, ng + 5 * D, ng + 6 * D, XB, H);
            else        phase_rowpass<false, true, false>(XALT, XALT, Y, 0.5f, ng + 5 * D, ng, X, H);
        }
        SEAM(p0 + P_E3);
    }
#undef IN
#undef SEAM
}

extern "C" void kernel_launch(void* const* d_in, const int* in_sizes, int n_in, void* d_out, int out_size, void* d_ws, size_t ws_size, hipStream_t stream) {
    static int grid = 0;
    if (grid == 0) {
        if (n_in != 28 || (size_t)out_size != O_END || ws_size < WS_END) { fprintf(stderr, "kernel_launch: unexpected shapes: n_in %d out %d ws %zu (need %zu)\n", n_in, out_size, ws_size, (size_t)WS_END); grid = -1; return; }
        int dev = 0, cus = 0, per_cu = 0;
        if (hipGetDevice(&dev) != hipSuccess || hipDeviceGetAttribute(&cus, hipDeviceAttributeMultiprocessorCount, dev) != hipSuccess) { grid = -1; return; }
        if (hipFuncSetAttribute((const void*)mk_fwd, hipFuncAttributeMaxDynamicSharedMemorySize, LDS_BYTES) != hipSuccess) { fprintf(stderr, "kernel_launch: hipFuncSetAttribute failed\n"); grid = -1; return; }
        if (hipOccupancyMaxActiveBlocksPerMultiprocessor(&per_cu, (const void*)mk_fwd, NTHR, LDS_BYTES) != hipSuccess || per_cu < 1) { fprintf(stderr, "kernel_launch: occupancy query says %d\n", per_cu); per_cu = 1; }
        (void)hipGetLastError();
        grid = cus * 1;
    }
    if (grid < 0) return;
    if (hipMemsetAsync((char*)d_ws + WS_CTL, 0, 16384, stream) != hipSuccess) { fprintf(stderr, "kernel_launch: hipMemsetAsync failed\n"); return; }
    Args a{};
    for (int i = 0; i < 28; ++i) a.in[i] = (const float*)d_in[i];
    a.out = (float*)d_out; a.ws = (unsigned char*)d_ws;
#if MK_PER_PHASE
    for (int ph = 0; ph < NPH; ++ph) { a.ph_lo = ph; a.ph_hi = ph + 1; hipLaunchKernelGGL(mk_fwd, dim3(grid), dim3(NTHR), LDS_BYTES, stream, a); }
#else
    a.ph_lo = 0; a.ph_hi = NPH;
    void* args[] = {&a};
    hipError_t e = hipLaunchCooperativeKernel((const void*)mk_fwd, dim3(grid), dim3(NTHR), args, LDS_BYTES, stream);
    if (e != hipSuccess) fprintf(stderr, "kernel_launch: cooperative launch failed: %s (grid %d)\n", hipGetErrorString(e), grid);
#endif
}
```

```cpp
#include <hip/hip_runtime.h>
#include <hip/hip_cooperative_groups.h>
#include <cstdio>
#include <cstdint>
namespace cg = cooperative_groups;
#ifndef MK_PER_PHASE
#define MK_PER_PHASE 0
#endif
#ifndef DIS
#define DIS 0
#endif
__device__ __forceinline__ int ltid() { int t = threadIdx.x; asm volatile("" : "+v"(t)); return t; }
#ifndef REP
#define REP 0
#endif
namespace pg8 {
#define PG8_LAS __attribute__((address_space(3)))
typedef unsigned short bf16_t;
typedef short bf16x8 __attribute__((ext_vector_type(8)));
typedef float f32x4 __attribute__((ext_vector_type(4)));
typedef unsigned u32x4 __attribute__((ext_vector_type(4)));
constexpr int BM = 256, BK = 64, HALF = 128, HTB = HALF * BK * 2  , STAGE_BYTES = 8 * HTB, NXCD = 8, WGM = 8;

__host__ __device__ __forceinline__ int lds_byte(int r, int c) { const int st = (r >> 4) * 2 + (c >> 5), rr = r & 15, cc = c & 31, ob = rr * 64 + cc * 2; return st * 1024 + (ob ^ (((ob >> 9) & 1) << 5)); }
__host__ __device__ __forceinline__ void stage_rc(int b, int& R, int& C) { const int st = b / 1024, sb = b % 1024, swz = sb ^ (((sb >> 9) & 1) << 5); R = (st >> 1) * 16 + swz / 64; C = (st & 1) * 32 + (swz % 64) / 2; }
__host__ __device__ __forceinline__ int perm32(int rho) { const int n = rho >> 4, i = rho & 15; return 8 * (i >> 2) + 4 * n + (i & 3); }

struct Unit { int pm, pn; };
struct Gemm { const bf16_t* A; const bf16_t* Bt; int M, N, K; };

struct StaticOrder {
    int nM, nN, nwg, G, c;
    __host__ __device__ void init(int M, int N, int G_, int c_) { nM = M / BM; nN = N / BM; nwg = nM * nN; G = G_; c = c_; }
    __host__ __device__ bool next(int i, Unit& u) const {
        const long L = (long)i * G + c; if (L >= nwg) return false;
        int wgid = (int)L; { const int q = nwg / NXCD, r = nwg % NXCD, xcd = wgid % NXCD, off = wgid / NXCD; wgid = (xcd < r ? xcd * (q + 1) : r * (q + 1) + (xcd - r) * q) + off; }
        const int nig = WGM * nN, gid = wgid / nig, fm = gid * WGM, gsz = (nM - fm) < WGM ? (nM - fm) : WGM;
        u.pm = fm + ((wgid % nig) % gsz); u.pn = (wgid % nig) / gsz; return true;
    }
    __device__ __forceinline__ void a_ready(const Unit&) const {}
    __device__ __forceinline__ void done(const Unit&) const {}
};

__device__ __forceinline__ unsigned cvt_pk_bf16(float lo, float hi) { unsigned r; asm volatile("v_cvt_pk_bf16_f32 %0, %1, %2" : "=v"(r) : "v"(lo), "v"(hi)); return r; }

__device__ __forceinline__ float silu_f(float x) { return x * __builtin_amdgcn_rcpf(1.0f + __builtin_amdgcn_exp2f(-1.44269504089f * x)); }
struct EpiSwiglu {
    static constexpr bool PERM = true, AFTER_DRAIN = false;
    bf16_t* O; int ldc;
    __device__ __forceinline__ void operator()(const f32x4 (&acc)[2][2][4][2], const Unit& u, int wr, int wc, int fr, int fq) const {
        const int row0 = u.pm * BM + wr * 64 + fr, col0 = u.pn * HALF + wc * 32 + 8 * fq;
#pragma unroll
        for (int ai = 0; ai < 2; ++ai)
#pragma unroll
            for (int m = 0; m < 4; ++m) {
                bf16_t* rowp = O + (size_t)(row0 + ai * HALF + m * 16) * ldc + col0;
                const f32x4 g0 = acc[ai][0][m][0], g1 = acc[ai][0][m][1], u0 = acc[ai][1][m][0], u1 = acc[ai][1][m][1];
                u32x4 w;
                w.x = cvt_pk_bf16(silu_f(g0[0]) * u0[0], silu_f(g0[1]) * u0[1]); w.y = cvt_pk_bf16(silu_f(g0[2]) * u0[2], silu_f(g0[3]) * u0[3]);
                w.z = cvt_pk_bf16(silu_f(g1[0]) * u1[0], silu_f(g1[1]) * u1[1]); w.w = cvt_pk_bf16(silu_f(g1[2]) * u1[2], silu_f(g1[3]) * u1[3]);
                *(u32x4*)rowp = w;
            }
    }
};
struct EpiF32 {
    static constexpr bool PERM = false, AFTER_DRAIN = false;
    float* O; int ldc;
    __device__ __forceinline__ void operator()(const f32x4 (&acc)[2][2][4][2], const Unit& u, int wr, int wc, int fr, int fq) const {
        const int row0 = u.pm * BM + wr * 64 + fr, col0 = u.pn * BM + wc * 32 + 4 * fq;
#pragma unroll
        for (int ai = 0; ai < 2; ++ai)
#pragma unroll
            for (int m = 0; m < 4; ++m) {
                float* rowp = O + (size_t)(row0 + ai * HALF + m * 16) * ldc + col0;
#pragma unroll
                for (int bj = 0; bj < 2; ++bj)
#pragma unroll
                    for (int n = 0; n < 2; ++n) *(f32x4*)(rowp + bj * HALF + n * 16) = acc[ai][bj][m][n];
            }
    }
};
struct EpiU {
    static constexpr bool PERM = true, AFTER_DRAIN = false;
    bf16_t* O; int ldc; float* pk; float* pv; float* sk; float* sv; int mp, mr;
    __device__ __forceinline__ void operator()(const f32x4 (&acc)[2][2][4][2], const Unit& u, int wr, int wc, int fr, int fq) const {
        const int row0 = u.pm * BM + wr * 64 + fr, colt = wc * 32 + 8 * fq;
        const bool kv = (u.pn == 1) || (u.pn == 2);
#pragma unroll
        for (int ai = 0; ai < 2; ++ai)
#pragma unroll
            for (int m = 0; m < 4; ++m) {
                const int row = row0 + ai * HALF + m * 16;
                bf16_t* rowp = O + (size_t)row * ldc + u.pn * BM + colt;
#pragma unroll
                for (int bj = 0; bj < 2; ++bj) {
                    const f32x4 v0 = acc[ai][bj][m][0], v1 = acc[ai][bj][m][1];
                    u32x4 w; w.x = cvt_pk_bf16(v0[0], v0[1]); w.y = cvt_pk_bf16(v0[2], v0[3]); w.z = cvt_pk_bf16(v1[0], v1[1]); w.w = cvt_pk_bf16(v1[2], v1[3]);
                    *(u32x4*)(rowp + bj * HALF) = w;
                    if (kv && row < mr) {
                        float* dst = (row < mp) ? ((u.pn == 1 ? pk : pv) + (size_t)row * 256) : ((u.pn == 1 ? sk : sv) + (size_t)(row - mp) * 256);
                        dst += bj * HALF + colt;
                        *(f32x4*)dst = v0; *(f32x4*)(dst + 4) = v1;
                    }
                }
            }
    }
};
struct EpiBf {
    static constexpr bool PERM = true, AFTER_DRAIN = false;
    bf16_t* O; int ldc;
    __device__ __forceinline__ void operator()(const f32x4 (&acc)[2][2][4][2], const Unit& u, int wr, int wc, int fr, int fq) const {
        const int row0 = u.pm * BM + wr * 64 + fr, col0 = u.pn * BM + wc * 32 + 8 * fq;
#pragma unroll
        for (int ai = 0; ai < 2; ++ai)
#pragma unroll
            for (int m = 0; m < 4; ++m) {
                bf16_t* rowp = O + (size_t)(row0 + ai * HALF + m * 16) * ldc + col0;
#pragma unroll
                for (int bj = 0; bj < 2; ++bj) {
                    const f32x4 v0 = acc[ai][bj][m][0], v1 = acc[ai][bj][m][1];
                    u32x4 w; w.x = cvt_pk_bf16(v0[0], v0[1]); w.y = cvt_pk_bf16(v0[2], v0[3]); w.z = cvt_pk_bf16(v1[0], v1[1]); w.w = cvt_pk_bf16(v1[2], v1[3]);
                    *(u32x4*)(rowp + bj * HALF) = w;
                }
            }
    }
};

template <class Epi, class Sched, bool ALIGN_EPI = false, bool SP2 = false>
__device__ __forceinline__ void gemm_phase(PG8_LAS unsigned char* lds, const Gemm g, const Sched& S, const Epi& E) {
    const int tid = ltid(), wid = __builtin_amdgcn_readfirstlane(tid >> 6), lane = tid & 63, wr = wid >> 2, wc = wid & 3, fr = lane & 15, fq = lane >> 4;
    const int K = g.K, nt = K / BK;
    unsigned voffA[2], voffB[2];
#pragma unroll
    for (int i = 0; i < 2; ++i) { int R, C; stage_rc(tid * 16 + i * 8192, R, C); const int Rb = Epi::PERM ? ((R & ~31) + perm32(R & 31)) : R;
        voffA[i] = (unsigned)(R * K + C) * 2u; voffB[i] = (unsigned)(Rb * K + C) * 2u; }
    const size_t kstep = (size_t)(BK * 2);
    const size_t hstep = (size_t)HALF * K * 2;
    const size_t tstep = 2 * hstep;
    const unsigned ldsw = (unsigned)wid * 1024u;
    const int aoff = lds_byte(wr * 64 + fr, fq * 8), boff = lds_byte(wc * 32 + fr, fq * 8);
#define PG8_SA(b, h) (((b) * 2 + (h)) * HTB)
#define PG8_SB(b, h) ((4 + (b) * 2 + (h)) * HTB)
#define PG8_STAGE(bufoff, gbase, voff) do { _Pragma("unroll") for (int _i = 0; _i < 2; ++_i) \
        __builtin_amdgcn_global_load_lds((const unsigned*)((const char*)(gbase) + (voff)[_i]), (PG8_LAS unsigned*)(lds + (bufoff) + ldsw + _i * 8192), 16, 0, 0); } while (0)
#define PG8_LDA(dst, b, h) do { _Pragma("unroll") for (int m = 0; m < 4; ++m) _Pragma("unroll") for (int k = 0; k < 2; ++k) dst[m][k] = *(const PG8_LAS bf16x8*)(lds + PG8_SA(b, h) + aoff + m * 2048 + k * 1024); } while (0)
#define PG8_LDB(dst, b, h) do { _Pragma("unroll") for (int n = 0; n < 2; ++n) _Pragma("unroll") for (int k = 0; k < 2; ++k) dst[n][k] = *(const PG8_LAS bf16x8*)(lds + PG8_SB(b, h) + boff + n * 2048 + k * 1024); } while (0)
#define PG8_MMA(ai, bj, At, Bt) do { __builtin_amdgcn_s_setprio(1); _Pragma("unroll") for (int m = 0; m < 4; ++m) _Pragma("unroll") for (int n = 0; n < 2; ++n) _Pragma("unroll") for (int k = 0; k < 2; ++k) \
        acc[ai][bj][m][n] = __builtin_amdgcn_mfma_f32_16x16x32_bf16(Bt[n][k], At[m][k], acc[ai][bj][m][n], 0, 0, 0); __builtin_amdgcn_s_setprio(0); } while (0)
#define PG8_WAIT_V(n) asm volatile("s_waitcnt vmcnt(" #n ")" ::: "memory")
#define PG8_WAIT_L(n) asm volatile("s_waitcnt lgkmcnt(" #n ")" ::: "memory")
#define PG8_BAR __builtin_amdgcn_s_barrier()
#define PG8_SCHED __builtin_amdgcn_sched_barrier(0)
    Unit cur, nxt; int ui = 0;
    if (!S.next(0, cur)) return;
    f32x4 acc[2][2][4][2];
#pragma unroll
    for (int a = 0; a < 2; ++a)
#pragma unroll
        for (int b = 0; b < 2; ++b)
#pragma unroll
            for (int m = 0; m < 4; ++m)
#pragma unroll
                for (int n = 0; n < 2; ++n) acc[a][b][m][n] = (f32x4){0.f, 0.f, 0.f, 0.f};
    bf16x8 At[4][2], B0[2][2], B1[2][2];
    const char* cA = (const char*)g.A + (size_t)cur.pm * tstep; const char* cB = (const char*)g.Bt + (size_t)cur.pn * tstep;
    S.a_ready(cur);
    if constexpr (SP2) {
        PG8_STAGE(PG8_SB(0, 0), cB, voffB); PG8_STAGE(PG8_SB(0, 1), cB + hstep, voffB); PG8_STAGE(PG8_SA(0, 0), cA, voffA); PG8_STAGE(PG8_SA(0, 1), cA + hstep, voffA);
        if (wr == 1) PG8_BAR;
        PG8_WAIT_V(2); PG8_BAR;
        PG8_STAGE(PG8_SB(1, 0), cB + kstep, voffB); PG8_STAGE(PG8_SA(1, 0), cA + kstep, voffA); PG8_STAGE(PG8_SB(1, 1), cB + hstep + kstep, voffB);
        PG8_WAIT_V(6); PG8_BAR;
    } else {
        PG8_STAGE(PG8_SB(0, 0), cB, voffB); PG8_STAGE(PG8_SA(0, 0), cA, voffA); PG8_STAGE(PG8_SB(0, 1), cB + hstep, voffB); PG8_STAGE(PG8_SA(0, 1), cA + hstep, voffA);
        if (wr == 1) PG8_BAR;
        PG8_WAIT_V(4); PG8_BAR;
        PG8_STAGE(PG8_SB(1, 0), cB + kstep, voffB); PG8_STAGE(PG8_SA(1, 0), cA + kstep, voffA); PG8_STAGE(PG8_SB(1, 1), cB + hstep + kstep, voffB);
        PG8_WAIT_V(6); PG8_BAR;
    }
    for (;;) {
        const bool has_next = S.next(ui + 1, nxt);
        const char* nA = has_next ? (const char*)g.A + (size_t)nxt.pm * tstep : cA; const char* nB = has_next ? (const char*)g.Bt + (size_t)nxt.pn * tstep : cB;
        for (int t = 0; t < nt; t += 2) {
            const bool last = (t == nt - 2);
            const char* a1 = cA + (size_t)(t + 1) * kstep;
            const char* a2 = last ? nA : cA + (size_t)(t + 2) * kstep; const char* b2 = last ? nB : cB + (size_t)(t + 2) * kstep;
            const char* a3 = a2 + kstep; const char* b3 = b2 + kstep;
            if (last && has_next) S.a_ready(nxt);
            if constexpr (SP2) {
            PG8_LDB(B0, 0, 0); PG8_LDB(B1, 0, 1); PG8_SCHED; PG8_LDA(At, 0, 0); PG8_STAGE(PG8_SA(1, 1), a1 + hstep, voffA);
            PG8_WAIT_V(8); PG8_WAIT_L(0); PG8_BAR; PG8_MMA(0, 0, At, B0); PG8_MMA(0, 1, At, B1); PG8_BAR; PG8_SCHED;
            PG8_LDA(At, 0, 1); PG8_STAGE(PG8_SB(0, 0), b2, voffB); PG8_STAGE(PG8_SB(0, 1), b2 + hstep, voffB); PG8_STAGE(PG8_SA(0, 0), a2, voffA);
            PG8_WAIT_V(8); PG8_WAIT_L(0); PG8_BAR; PG8_MMA(1, 0, At, B0); PG8_MMA(1, 1, At, B1); PG8_BAR; PG8_SCHED;
            PG8_LDB(B0, 1, 0); PG8_LDB(B1, 1, 1); PG8_SCHED; PG8_LDA(At, 1, 0); PG8_STAGE(PG8_SA(0, 1), a2 + hstep, voffA);
            PG8_WAIT_V(8); PG8_WAIT_L(0); PG8_BAR; PG8_MMA(0, 0, At, B0); PG8_MMA(0, 1, At, B1); PG8_BAR; PG8_SCHED;
            PG8_LDA(At, 1, 1); PG8_STAGE(PG8_SB(1, 0), b3, voffB); PG8_STAGE(PG8_SB(1, 1), b3 + hstep, voffB); PG8_STAGE(PG8_SA(1, 0), a3, voffA);
            PG8_WAIT_V(8); PG8_WAIT_L(0); PG8_BAR; PG8_MMA(1, 0, At, B0); PG8_MMA(1, 1, At, B1); PG8_BAR; PG8_SCHED;
            } else {
            PG8_LDB(B0, 0, 0); PG8_SCHED; PG8_LDA(At, 0, 0); PG8_STAGE(PG8_SA(1, 1), a1 + hstep, voffA);
            PG8_WAIT_L(8); PG8_BAR; PG8_WAIT_L(0); PG8_MMA(0, 0, At, B0); PG8_BAR; PG8_SCHED;
            PG8_LDB(B1, 0, 1); PG8_STAGE(PG8_SB(0, 0), b2, voffB);
            PG8_BAR; PG8_WAIT_L(0); PG8_MMA(0, 1, At, B1); PG8_BAR;
            PG8_LDA(At, 0, 1); PG8_STAGE(PG8_SA(0, 0), a2, voffA);
            PG8_BAR; PG8_WAIT_L(0); PG8_MMA(1, 0, At, B0); PG8_BAR; PG8_SCHED;
            PG8_STAGE(PG8_SB(0, 1), b2 + hstep, voffB);
            PG8_WAIT_V(6); PG8_BAR; PG8_MMA(1, 1, At, B1); PG8_BAR;
            PG8_LDB(B0, 1, 0); PG8_SCHED; PG8_LDA(At, 1, 0); PG8_STAGE(PG8_SA(0, 1), a2 + hstep, voffA);
            PG8_WAIT_L(8); PG8_BAR; PG8_WAIT_L(0); PG8_MMA(0, 0, At, B0); PG8_BAR; PG8_SCHED;
            PG8_LDB(B1, 1, 1); PG8_STAGE(PG8_SB(1, 0), b3, voffB);
            PG8_BAR; PG8_WAIT_L(0); PG8_MMA(0, 1, At, B1); PG8_BAR;
            PG8_LDA(At, 1, 1); PG8_STAGE(PG8_SA(1, 0), a3, voffA);
            PG8_BAR; PG8_WAIT_L(0); PG8_MMA(1, 0, At, B0); PG8_BAR; PG8_SCHED;
            PG8_STAGE(PG8_SB(1, 1), b3 + hstep, voffB);
            PG8_WAIT_V(6); PG8_BAR; PG8_MMA(1, 1, At, B1); PG8_BAR;
            }
        }
        if constexpr (ALIGN_EPI) { if (wr == 0) PG8_BAR; }
        if constexpr (!Epi::AFTER_DRAIN) { E(acc, cur, wr, wc, fr, fq); S.done(cur); }
        if (!has_next) break;
#pragma unroll
        for (int a = 0; a < 2; ++a)
#pragma unroll
            for (int b = 0; b < 2; ++b)
#pragma unroll
                for (int m = 0; m < 4; ++m)
#pragma unroll
                    for (int n = 0; n < 2; ++n) acc[a][b][m][n] = (f32x4){0.f, 0.f, 0.f, 0.f};
        cur = nxt; cA = nA; cB = nB; ++ui;
        if constexpr (ALIGN_EPI) { if (wr == 1) PG8_BAR; }
    }
    PG8_WAIT_V(0);
    if constexpr (!ALIGN_EPI) { if (wr == 0) PG8_BAR; }
    PG8_BAR;
    if constexpr (Epi::AFTER_DRAIN) { E.fused(acc, cur, wr, wc, fr, fq, lds, wid, lane); S.done(cur); }
#undef PG8_SA
#undef PG8_SB
#undef PG8_STAGE
#undef PG8_LDA
#undef PG8_LDB
#undef PG8_MMA
#undef PG8_WAIT_V
#undef PG8_WAIT_L
#undef PG8_BAR
#undef PG8_SCHED
}
}

typedef unsigned short bf16;
typedef short bf16x8 __attribute__((ext_vector_type(8)));
typedef float f32x4 __attribute__((ext_vector_type(4)));
typedef unsigned u32x4 __attribute__((ext_vector_type(4)));
typedef unsigned u32x2 __attribute__((ext_vector_type(2)));
#define LAS __attribute__((address_space(3)))
#define LAUNDER(p) asm volatile("" : "+s"(p))

constexpr int D = 1024, T = 4096, NB = 8, TS = 16, PAST = 1024, FF = 2816, RW = 896;
constexpr int MP = NB * T, MS = NB * TS, MR = MP + MS, M = 33024;
constexpr int NU = 2816;
constexpr int UQ = 0, UK = 256, UV = 512, UPOOL = 768, UCB = 1024, UCC = 1280, UCX = 1536, URW = 1792;
constexpr float RMS_EPS = 1e-6f, GN_EPS = 64e-5f;
constexpr int VTP = T + 64;
constexpr int SKEYS = PAST + TS, SKP = 1088;

constexpr size_t O_X = 0, O_PK = 33685504, O_PV = 50462720, O_PWKV = 67239936, O_PSHIFT = 67502080, O_PCONV = 67516416, O_PPOOL = 67524608,
                 O_SK = 67586048, O_SV = 67651584, O_SWKV = 67717120, O_SSHIFT = 67979264, O_SCONV = 67993600, O_SPOOL = 68001792, O_END = 68063232;
constexpr size_t LW = 21233664;
constexpr size_t W_GUA = 0, W_DA = 5767168, W_IN = 8650752, W_OUT = 11534336, W_GUB = 12582912, W_DB = 18350080;
constexpr size_t WS_W = 0, WS_H = 84934656, WS_U = 152567808, WS_Y = 338558976;
constexpr size_t WS_SIN = WS_Y, WS_G = 456458240, WS_RK = 473300992, WS_YS = 473827328, WS_SKV = 507512832, WS_VT = 511772672, WS_SVT = 528812032, WS_CTL = 533268480, WS_END = 533268480 + 16384;
constexpr size_t SKV_ELEMS = (size_t)NB * SKEYS * 256;
constexpr int REC = 896;
static_assert(WS_Y + (size_t)M * D * 4 <= WS_END && WS_SIN + (size_t)MR * 4 * REC == WS_G && WS_G + (size_t)MR * 512 == WS_RK && WS_RK + (size_t)MR * 16 == WS_YS && WS_YS + (size_t)MR * 1024 == WS_SKV && WS_SKV + SKV_ELEMS * 2 == WS_VT && WS_VT + (size_t)32 * 64 * VTP * 2 == WS_SVT && WS_SVT + (size_t)32 * 64 * SKP * 2 == WS_CTL && WS_END <= 536870912, "ws map");
static_assert(WS_U + (size_t)M * NU * 2 == WS_Y && WS_H + (size_t)M * D * 2 == WS_U && 2 * LW * 2 == WS_H, "ws map 2");

constexpr int LDS_BYTES = 147456;
constexpr int NTHR = 512, NWAVES = 8;

constexpr int PH_PRE = 0, PH_PER_LAYER = 12, NPH = 1 + 2 * PH_PER_LAYER;
enum { P_A1 = 0, P_A2, P_A3, P_B1, P_C1, P_C2, P_C3, P_D1, P_D2, P_E1, P_E2, P_E3 };

struct Args { const float* in[28]; float* out; unsigned char* ws; int ph_lo, ph_hi; };
enum { I_XP = 0, I_XS, I_CK, I_CV, I_SWKV, I_SSHIFT, I_SCONV, I_SPOOL, I_NG, I_WG, I_WU, I_WD, I_WIN, I_WOUT, I_POOLW, I_POOLS, I_MU, I_W0, I_W2, I_A0, I_A2, I_G2, I_KK, I_KA, I_RK, I_LNW, I_LNB, I_CONVW };
typedef const __attribute__((address_space(4))) Args* KArgP;
__device__ __forceinline__ KArgP kargs() { KArgP p = (KArgP)__builtin_amdgcn_kernarg_segment_ptr(); asm volatile("" : "+s"(p)); return p; }

__device__ __forceinline__ unsigned f2bf(float f) { return (unsigned)__builtin_bit_cast(unsigned short, (__bf16)f); }
typedef float f32x2_t __attribute__((ext_vector_type(2))); typedef __bf16 bf16x2_t __attribute__((ext_vector_type(2)));
__device__ __forceinline__ unsigned pk2(float lo, float hi) { f32x2_t v = {lo, hi}; bf16x2_t b = __builtin_convertvector(v, bf16x2_t); return __builtin_bit_cast(unsigned, b); }
__device__ __forceinline__ float bf2f(unsigned h) { return __builtin_bit_cast(float, h << 16); }
__device__ __forceinline__ float bflo(unsigned w) { return __builtin_bit_cast(float, w << 16); }
__device__ __forceinline__ float bfhi(unsigned w) { return __builtin_bit_cast(float, w & 0xffff0000u); }
__device__ __forceinline__ float ldbf(const bf16* p) { return bf2f((unsigned)*p); }
template <int CTRL> __device__ __forceinline__ float dppf(float x) { return __builtin_bit_cast(float, __builtin_amdgcn_update_dpp(0, __builtin_bit_cast(int, x), CTRL, 0xF, 0xF, true)); }
__device__ __forceinline__ float red16(float x) {
    x += dppf<0xB1>(x);
    x += dppf<0x4E>(x);
    x += dppf<0x141>(x);
    x += dppf<0x140>(x);
    return x;
}
__device__ __forceinline__ float wave_sum(float v) {
    v = red16(v);
    const int iv = __builtin_bit_cast(int, v);
    return (__builtin_bit_cast(float, __builtin_amdgcn_readlane(iv, 0)) + __builtin_bit_cast(float, __builtin_amdgcn_readlane(iv, 16))) +
           (__builtin_bit_cast(float, __builtin_amdgcn_readlane(iv, 32)) + __builtin_bit_cast(float, __builtin_amdgcn_readlane(iv, 48)));
}
__device__ __forceinline__ void red16_2(float& a, float& b) {
    a += dppf<0xB1>(a); b += dppf<0xB1>(b);
    a += dppf<0x4E>(a); b += dppf<0x4E>(b);
    a += dppf<0x141>(a); b += dppf<0x141>(b);
    a += dppf<0x140>(a); b += dppf<0x140>(b);
}
typedef float f32x2v __attribute__((ext_vector_type(2)));
typedef __bf16 bf2_t __attribute__((ext_vector_type(2)));
__device__ __forceinline__ float dot2bf(unsigned a, unsigned b, float c) { return __builtin_amdgcn_fdot2_f32_bf16(__builtin_bit_cast(bf2_t, a), __builtin_bit_cast(bf2_t, b), c, false); }
__device__ __forceinline__ float sigmoid_f(float x) { return __builtin_amdgcn_rcpf(1.0f + __expf(-x)); }
__device__ __forceinline__ float tanh_f(float x) { return 2.0f * sigmoid_f(2.0f * x) - 1.0f; }
__device__ __forceinline__ float softplus_f(float x) { return fmaxf(x, 0.f) + __logf(1.0f + __expf(-fabsf(x))); }

__device__ __forceinline__ void transpose_item(const float* __restrict__ W, int K, int N, bf16* WT, int dst_row0, float* scr, int kb, int n0, int lane) {
    const int k0 = 64 * kb;
    float wv[32];
#pragma unroll
    for (int i = 0; i < 32; ++i) wv[i] = W[(size_t)(k0 + 2 * i + (lane >> 5)) * N + n0 + (lane & 31)];
#pragma unroll
    for (int i = 0; i < 32; ++i) scr[(2 * i + (lane >> 5)) * 33 + (lane & 31)] = wv[i];
    asm volatile("s_waitcnt lgkmcnt(0)" ::: "memory");
    const int c = lane & 7;
#pragma unroll
    for (int j = 0; j < 4; ++j) { const int n = (lane >> 3) + 8 * j; const float* s = scr + (8 * c) * 33 + n;
        u32x4 o; o.x = pk2(s[0 * 33], s[1 * 33]); o.y = pk2(s[2 * 33], s[3 * 33]); o.z = pk2(s[4 * 33], s[5 * 33]); o.w = pk2(s[6 * 33], s[7 * 33]);
        *(u32x4*)(WT + (size_t)(dst_row0 + n) * K + k0 + 8 * c) = o; }
    asm volatile("s_waitcnt lgkmcnt(0)" ::: "memory");
}
__device__ __forceinline__ int win_rowmap(int n0) { return n0 < 256 ? UPOOL + n0 : (n0 < 1152 ? URW + (n0 - 256) : (n0 < 1920 ? UCB + (n0 - 1152) : n0 - 1920)); }

__device__ __forceinline__ void norm_row_to_bf16(const float* xrow, const float* g, bf16* hrow, int lane) {
    f32x4 v[4]; float s = 0.f;
#pragma unroll
    for (int j = 0; j < 4; ++j) { v[j] = *((const f32x4*)xrow + lane + 64 * j); s += (v[j].x * v[j].x + v[j].y * v[j].y) + (v[j].z * v[j].z + v[j].w * v[j].w); }
    const float rstd = rsqrtf(wave_sum(s) * (1.f / D) + RMS_EPS);
#pragma unroll
    for (int j = 0; j < 4; ++j) { const f32x4 gg = *((const f32x4*)g + lane + 64 * j); u32x2 o; o.x = pk2(v[j].x * rstd * gg.x, v[j].y * rstd * gg.y); o.y = pk2(v[j].z * rstd * gg.z, v[j].w * rstd * gg.w);
        *((u32x2*)hrow + lane + 64 * j) = o; }
}

__device__ __forceinline__ void phase_pre(const Args& a, unsigned char* lds) {
    KArgP ap = kargs(); unsigned char* ws_l = ap->ws; float* out_l = ap->out; (void)ws_l; (void)out_l;
    const float* in_I_NG = ap->in[I_NG];
    const float* in_I_WD = ap->in[I_WD];
    const float* in_I_WG = ap->in[I_WG];
    const float* in_I_WIN = ap->in[I_WIN];
    const float* in_I_WOUT = ap->in[I_WOUT];
    const float* in_I_WU = ap->in[I_WU];
    const float* in_I_XP = ap->in[I_XP];
    const float* in_I_XS = ap->in[I_XS];
    const int tid = ltid(), lane = tid & 63, wave = tid >> 6, G = gridDim.x;
    const int gw = blockIdx.x * NWAVES + wave, NGW = G * NWAVES;
    float* scr = (float*)(lds + wave * 16384);
    bf16* Wb = (bf16*)(ws_l + WS_W);
    constexpr int IT_L = 10304;
    for (int it = gw; it < 2 * IT_L; it += NGW) {
        const int l = it / IT_L; int r = it % IT_L; bf16* WL = Wb + (size_t)l * LW;
        const float* src; int K, N; bf16* dst; int mode;
        if (r < 1408)      { src = in_I_WG + (size_t)(l * 2 + 0) * D * FF; K = D; N = FF; dst = WL + W_GUA; mode = 1; }
        else if ((r -= 1408) < 1408) { src = in_I_WU + (size_t)(l * 2 + 0) * D * FF; K = D; N = FF; dst = WL + W_GUA; mode = 2; }
        else if ((r -= 1408) < 1408) { src = in_I_WD + (size_t)(l * 2 + 0) * FF * D; K = FF; N = D; dst = WL + W_DA; mode = 0; }
        else if ((r -= 1408) < 1344) { src = in_I_WIN + (size_t)l * D * 2688; K = D; N = 2688; dst = WL + W_IN; mode = 3; }
        else if ((r -= 1344) < 512)  { src = in_I_WOUT + (size_t)l * D * D; K = D; N = D; dst = WL + W_OUT; mode = 0; }
        else if ((r -= 512) < 1408)  { src = in_I_WG + (size_t)(l * 2 + 1) * D * FF; K = D; N = FF; dst = WL + W_GUB; mode = 1; }
        else if ((r -= 1408) < 1408) { src = in_I_WU + (size_t)(l * 2 + 1) * D * FF; K = D; N = FF; dst = WL + W_GUB; mode = 2; }
        else { r -= 1408;            src = in_I_WD + (size_t)(l * 2 + 1) * FF * D; K = FF; N = D; dst = WL + W_DB; mode = 0; }
        const int nblk = N / 32, kb = r / nblk, n0 = 32 * (r % nblk);
        int dr = n0;
        if (mode == 1) dr = 256 * (n0 >> 7) + (n0 & 127); else if (mode == 2) dr = 256 * (n0 >> 7) + 128 + (n0 & 127); else if (mode == 3) dr = win_rowmap(n0);
        transpose_item(src, K, N, dst, dr, scr, kb, n0, lane);
    }
    const int gt = blockIdx.x * NTHR + tid, NGT = G * NTHR;
    for (int i = gt; i < 2 * 16384 + 16384; i += NGT) {
        u32x4 z = {0u, 0u, 0u, 0u};
        if (i < 32768) { const int l = i >> 14, o = i & 16383; *((u32x4*)(Wb + (size_t)l * LW + W_IN + (size_t)2688 * D) + o) = z; }
        else { *((u32x4*)((bf16*)(ws_l + WS_H) + (size_t)MR * D) + (i - 32768)) = z; }
    }
    bf16* H = (bf16*)(ws_l + WS_H);
    for (int m = gw; m < MR; m += NGW) {
        const float* xr = m < MP ? in_I_XP + (size_t)m * D : in_I_XS + (size_t)(m - MP) * D;
        norm_row_to_bf16(xr, in_I_NG, H + (size_t)m * D, lane);
    }
}

template <bool SRC_F32, bool DST_F32, bool HAS_H>
__device__ __forceinline__ void phase_rowpass(const void* xp, const void* xs, const bf16* Y, float coef, const float* gpost, const float* gpre, void* xdst, bf16* H) {
    const int tid = ltid(), lane = tid & 63, wave = tid >> 6;
    const int gw = blockIdx.x * NWAVES + wave, NGW = gridDim.x * NWAVES;
    f32x4 y[4], x[4], nxf[4]; u32x2 ny[4], nxb[4];
#define RP_LOAD(m_) do { const bf16* yr_ = Y + (size_t)(m_) * D; \
        _Pragma("unroll") for (int j = 0; j < 4; ++j) ny[j] = *((const u32x2*)yr_ + lane + 64 * j); \
        if (SRC_F32) { const float* xr_ = (m_) < MP ? (const float*)xp + (size_t)(m_) * D : (const float*)xs + (size_t)((m_) - MP) * D; \
            _Pragma("unroll") for (int j = 0; j < 4; ++j) nxf[j] = *((const f32x4*)xr_ + lane + 64 * j); } \
        else { const bf16* xr_ = (const bf16*)xp + (size_t)(m_) * D; \
            _Pragma("unroll") for (int j = 0; j < 4; ++j) nxb[j] = *((const u32x2*)xr_ + lane + 64 * j); } } while (0)
    if (gw < MR) RP_LOAD(gw);
    for (int m = gw; m < MR; m += NGW) {
#pragma unroll
        for (int j = 0; j < 4; ++j) { y[j] = (f32x4){bflo(ny[j].x), bfhi(ny[j].x), bflo(ny[j].y), bfhi(ny[j].y)};
            x[j] = SRC_F32 ? nxf[j] : (f32x4){bflo(nxb[j].x), bfhi(nxb[j].x), bflo(nxb[j].y), bfhi(nxb[j].y)}; }
        if (m + NGW < MR) RP_LOAD(m + NGW);
        float s = 0.f;
#pragma unroll
        for (int j = 0; j < 4; ++j) s += (y[j].x * y[j].x + y[j].y * y[j].y) + (y[j].z * y[j].z + y[j].w * y[j].w);
        const float rstd = rsqrtf(wave_sum(s) * (1.f / D) + RMS_EPS) * coef;
        float s2 = 0.f;
#pragma unroll
        for (int j = 0; j < 4; ++j) { const f32x4 gg = *((const f32x4*)gpost + lane + 64 * j);
            x[j].x += y[j].x * rstd * gg.x; x[j].y += y[j].y * rstd * gg.y; x[j].z += y[j].z * rstd * gg.z; x[j].w += y[j].w * rstd * gg.w;
            s2 += (x[j].x * x[j].x + x[j].y * x[j].y) + (x[j].z * x[j].z + x[j].w * x[j].w);
            if (DST_F32) *((f32x4*)((float*)xdst + (size_t)m * D) + lane + 64 * j) = x[j];
            else { u32x2 o; o.x = pk2(x[j].x, x[j].y); o.y = pk2(x[j].z, x[j].w); *((u32x2*)((bf16*)xdst + (size_t)m * D) + lane + 64 * j) = o; } }
        if (HAS_H) {
            const float r2 = rsqrtf(wave_sum(s2) * (1.f / D) + RMS_EPS);
#pragma unroll
            for (int j = 0; j < 4; ++j) { const f32x4 gg = *((const f32x4*)gpre + lane + 64 * j); u32x2 o; o.x = pk2(x[j].x * r2 * gg.x, x[j].y * r2 * gg.y); o.y = pk2(x[j].z * r2 * gg.z, x[j].w * r2 * gg.w);
                *((u32x2*)(H + (size_t)m * D) + lane + 64 * j) = o; }
        }
    }
#undef RP_LOAD
}

__device__ __forceinline__ void ld8(const bf16* p, float (&f)[8]) {
    const u32x4 w = *(const u32x4*)p;
    f[0] = bflo(w.x); f[1] = bfhi(w.x); f[2] = bflo(w.y); f[3] = bfhi(w.y); f[4] = bflo(w.z); f[5] = bfhi(w.z); f[6] = bflo(w.w); f[7] = bfhi(w.w);
}
__device__ __forceinline__ void conv_part(const Args& a, int l, int bid, int nblk) {
    const int tid = ltid();
    KArgP ap = kargs(); unsigned char* ws_l = ap->ws; float* out_l = ap->out; (void)ws_l; (void)out_l;
    const float* in_I_CONVW = ap->in[I_CONVW];
    const float* in_I_SCONV = ap->in[I_SCONV];
    const bf16* U = (const bf16*)(ws_l + WS_U); bf16* YC = (bf16*)(ws_l + WS_H);
    const float* cw = in_I_CONVW + (size_t)l * 3 * 256;
    const int gt = bid * NTHR + tid, NGT = nblk * NTHR;
    for (int it = gt; it < MR * 32; it += NGT) {
        const int row = it >> 5, c8 = (it & 31) * 8;
        int b, t, Tn; const float* prefix; float* sout;
        if (row < MP) { b = row >> 12; t = row & 4095; Tn = T; prefix = nullptr; sout = out_l + O_PCONV + (size_t)(l * NB + b) * 2 * 256; }
        else { const int rr = row - MP; b = rr >> 4; t = rr & 15; Tn = TS; prefix = in_I_SCONV + (size_t)(l * NB + b) * 2 * 256; sout = out_l + O_SCONV + (size_t)(l * NB + b) * 2 * 256; }
        const bf16* ur = U + (size_t)row * NU;
        float bg[8], z0[8], z1[8], z2[8], cc[8], xx[8];
        ld8(ur + UCB + c8, bg); ld8(ur + UCC + c8, cc); ld8(ur + UCX + c8, xx);
#pragma unroll
        for (int i = 0; i < 8; ++i) z2[i] = cc[i] * xx[i];
        if (t >= 1) { ld8(ur - NU + UCC + c8, cc); ld8(ur - NU + UCX + c8, xx);
#pragma unroll
            for (int i = 0; i < 8; ++i) z1[i] = cc[i] * xx[i]; }
        else {
#pragma unroll
            for (int i = 0; i < 8; ++i) z1[i] = prefix ? prefix[256 + c8 + i] : 0.f; }
        if (t >= 2) { ld8(ur - 2 * NU + UCC + c8, cc); ld8(ur - 2 * NU + UCX + c8, xx);
#pragma unroll
            for (int i = 0; i < 8; ++i) z0[i] = cc[i] * xx[i]; }
        else {
#pragma unroll
            for (int i = 0; i < 8; ++i) z0[i] = prefix ? prefix[(t + 0) * 256 + c8 + i] : 0.f; }
        float y[8];
#pragma unroll
        for (int i = 0; i < 8; ++i) y[i] = bg[i] * (z0[i] * cw[c8 + i] + z1[i] * cw[256 + c8 + i] + z2[i] * cw[512 + c8 + i]);
        u32x4 o; o.x = pk2(y[0], y[1]); o.y = pk2(y[2], y[3]); o.z = pk2(y[4], y[5]); o.w = pk2(y[6], y[7]);
        *(u32x4*)(YC + (size_t)row * D + 512 + c8) = o;
        if (t >= Tn - 2) { float* so = sout + (size_t)(t - (Tn - 2)) * 256 + c8;
            *(f32x4*)so = (f32x4){z2[0], z2[1], z2[2], z2[3]}; *(f32x4*)(so + 4) = (f32x4){z2[4], z2[5], z2[6], z2[7]}; }
    }
}

template <int W>
__device__ __forceinline__ void pool_window(const float (&vals)[31], int pos0, float (&d)[16]) {
#pragma unroll
    for (int i = 0; i < 16; ++i) {
        float s = 0.f;
#pragma unroll
        for (int k = 0; k < W; ++k) s += vals[15 + i - k];
        const int cnt = (pos0 + i + 1) < W ? (pos0 + i + 1) : W;
        d[i] = s / (float)cnt - vals[15 + i];
    }
}
__device__ __forceinline__ void pool_part(const Args& a, int l, unsigned char* lds, int bid, int nblk) {
    KArgP ap = kargs(); unsigned char* ws_l = ap->ws; float* out_l = ap->out; (void)ws_l; (void)out_l;
    const float* in_I_POOLS = ap->in[I_POOLS];
    const float* in_I_POOLW = ap->in[I_POOLW];
    const float* in_I_SPOOL = ap->in[I_SPOOL];
    const bf16* U = (const bf16*)(ws_l + WS_U); bf16* YC = (bf16*)(ws_l + WS_H);
    bf16* dl = (bf16*)lds;
    const int tid = ltid(), c = tid & 255, th = tid >> 8, gi = c >> 6;
    const float* pw = in_I_POOLW + (size_t)(l * 4 + gi) * 64 * 64 + (c & 63);
    const float scale = in_I_POOLS[l * 256 + c];
    for (int item = bid; item < MR / 32; item += nblk) {
        const int row0 = item * 32 + th * 16;
        int b, t0, pos0, Tn; const float* prefix; float* sout;
        if (row0 < MP) { b = row0 >> 12; t0 = row0 & 4095; pos0 = t0; Tn = T; prefix = nullptr; sout = out_l + O_PPOOL + (size_t)(l * NB + b) * 15 * 256; }
        else { const int rr = row0 - MP; b = rr >> 4; t0 = 0; pos0 = PAST; Tn = TS; prefix = in_I_SPOOL + (size_t)(l * NB + b) * 15 * 256; sout = out_l + O_SPOOL + (size_t)(l * NB + b) * 15 * 256; }
        float vals[31];
#pragma unroll
        for (int i = 0; i < 31; ++i) {
            const int tt = t0 - 15 + i;
            vals[i] = (tt >= 0) ? ldbf(U + (size_t)(row0 - 15 + i) * NU + UPOOL + c) : (prefix ? prefix[(size_t)(i + t0) * 256 + c] : 0.f);
        }
        float d[16];
        if (gi == 0) pool_window<2>(vals, pos0, d); else if (gi == 1) pool_window<4>(vals, pos0, d); else if (gi == 2) pool_window<8>(vals, pos0, d); else pool_window<16>(vals, pos0, d);
#pragma unroll
        for (int i = 0; i < 16; ++i) {
            dl[(th * 16 + i) * 256 + c] = (bf16)f2bf(d[i]);
            const int t = t0 + i; if (t >= Tn - 15) sout[(size_t)(t - (Tn - 15)) * 256 + c] = vals[15 + i];
        }
        __syncthreads();
        float acc[16];
#pragma unroll
        for (int i = 0; i < 16; ++i) acc[i] = 0.f;
        for (int j8 = 0; j8 < 8; ++j8) {
            const unsigned w01 = pk2(pw[(8 * j8 + 0) * 64], pw[(8 * j8 + 1) * 64]), w23 = pk2(pw[(8 * j8 + 2) * 64], pw[(8 * j8 + 3) * 64]);
            const unsigned w45 = pk2(pw[(8 * j8 + 4) * 64], pw[(8 * j8 + 5) * 64]), w67 = pk2(pw[(8 * j8 + 6) * 64], pw[(8 * j8 + 7) * 64]);
#pragma unroll
            for (int i = 0; i < 16; ++i) { const u32x4 dv = *(const u32x4*)(dl + (th * 16 + i) * 256 + gi * 64 + 8 * j8);
                acc[i] = dot2bf(dv.w, w67, dot2bf(dv.z, w45, dot2bf(dv.y, w23, dot2bf(dv.x, w01, acc[i])))); }
        }
#pragma unroll
        for (int i = 0; i < 16; ++i) YC[(size_t)(row0 + i) * D + c] = (bf16)f2bf(acc[i] * scale);
        __syncthreads();
    }
}

__device__ __forceinline__ size_t rec_index(int row, int h) {
    if (row < MP) { const int b = row >> 12, t = row & 4095; return ((size_t)b * T) * 4 + (size_t)h * T + t; }
    const int rr = row - MP, b = rr >> 4, t = rr & 15; return ((size_t)MP + (size_t)b * TS) * 4 + (size_t)h * TS + t;
}
__device__ __forceinline__ void rwkv_prep_part(const Args& a, int l, unsigned char* lds) {
    const int tid = ltid();
    KArgP ap = kargs(); unsigned char* ws_l = ap->ws; float* out_l = ap->out;
    const float* in_I_A0 = ap->in[I_A0]; const float* in_I_A2 = ap->in[I_A2]; const float* in_I_G2 = ap->in[I_G2]; const float* in_I_KA = ap->in[I_KA]; const float* in_I_KK = ap->in[I_KK];
    const float* in_I_MU = ap->in[I_MU]; const float* in_I_RK = ap->in[I_RK]; const float* in_I_SSHIFT = ap->in[I_SSHIFT]; const float* in_I_W0 = ap->in[I_W0]; const float* in_I_W2 = ap->in[I_W2];
    const bf16* U = (const bf16*)(ws_l + WS_U);
    unsigned char* SIN = ws_l + WS_SIN; bf16* Gb = (bf16*)(ws_l + WS_G); float* RKb = (float*)(ws_l + WS_RK);
    bf16* lrb = (bf16*)lds;
    const int lane = tid & 63, c = tid & 255, half = tid >> 8, h = c >> 6, cc = c & 63;
    const float* mu = in_I_MU + (size_t)l * RW;
    const float mur = mu[c], muk = mu[256 + c], muv = mu[512 + c];
    const float w0c = in_I_W0[l * 256 + c], a0c = in_I_A0[l * 256 + c], kkc = in_I_KK[l * 256 + c], kac = in_I_KA[l * 256 + c], rkc = in_I_RK[l * 256 + c];
    unsigned w2p[16], a2p[16], g2p[32];
#pragma unroll
    for (int i = 0; i < 16; ++i) { w2p[i] = pk2(in_I_W2[(size_t)(l * 32 + 2 * i) * 256 + c], in_I_W2[(size_t)(l * 32 + 2 * i + 1) * 256 + c]);
                                   a2p[i] = pk2(in_I_A2[(size_t)(l * 32 + 2 * i) * 256 + c], in_I_A2[(size_t)(l * 32 + 2 * i + 1) * 256 + c]); }
#pragma unroll
    for (int i = 0; i < 32; ++i) g2p[i] = pk2(in_I_G2[(size_t)(l * 64 + 2 * i) * 256 + c], in_I_G2[(size_t)(l * 64 + 2 * i + 1) * 256 + c]);
    constexpr int TPI = 16, TPH = 8;
    for (int item = blockIdx.x; item < MR / TPI; item += gridDim.x) {
        const int row0 = item * TPI;
#pragma unroll
        for (int k = 0; k < TPI / 4; ++k) {
            const int idx = tid + NTHR * k, tok = idx >> 7, col = idx & 127, row = row0 + tok;
            int t, Tn; const float* shift; float* sout;
            if (row < MP) { t = row & 4095; Tn = T; shift = nullptr; sout = out_l + O_PSHIFT + (size_t)(l * NB + (row >> 12)) * RW; }
            else { const int rr = row - MP; t = rr & 15; Tn = TS; shift = in_I_SSHIFT + (size_t)(l * NB + (rr >> 4)) * RW; sout = out_l + O_SSHIFT + (size_t)(l * NB + (rr >> 4)) * RW; }
            const float cur = ldbf(U + (size_t)row * NU + URW + 768 + col);
            const float prev = (t > 0) ? ldbf(U + (size_t)(row - 1) * NU + URW + 768 + col) : (shift ? shift[768 + col] : 0.f);
            const float xs = cur + (prev - cur) * mu[768 + col];
            lrb[tok * 128 + col] = (bf16)f2bf(col < 32 ? tanh_f(xs) : (col < 64 ? xs : sigmoid_f(xs)));
            if (t == Tn - 1) sout[768 + col] = cur;
        }
        __syncthreads();
        const int rowh = row0 + half * TPH;
        int t0, Tn; const float* shift; float* sout;
        if (rowh < MP) { t0 = rowh & 4095; Tn = T; shift = nullptr; sout = out_l + O_PSHIFT + (size_t)(l * NB + (rowh >> 12)) * RW; }
        else { const int rr = rowh - MP; t0 = rr & 15; Tn = TS; shift = in_I_SSHIFT + (size_t)(l * NB + (rr >> 4)) * RW; sout = out_l + O_SSHIFT + (size_t)(l * NB + (rr >> 4)) * RW; }
        const bf16* ur = U + (size_t)rowh * NU + URW;
        float rp, kp, vp;
        if (t0 > 0) { rp = ldbf(ur - NU + c); kp = ldbf(ur - NU + 256 + c); vp = ldbf(ur - NU + 512 + c); }
        else if (shift) { rp = shift[c]; kp = shift[256 + c]; vp = shift[512 + c]; }
        else { rp = 0.f; kp = 0.f; vp = 0.f; }
        float rua[TPH], kua[TPH], vua[TPH];
#pragma unroll
        for (int i = 0; i < TPH; ++i) { rua[i] = ldbf(ur + (size_t)i * NU + c); kua[i] = ldbf(ur + (size_t)i * NU + 256 + c); vua[i] = ldbf(ur + (size_t)i * NU + 512 + c); }
#pragma unroll
        for (int i = 0; i < TPH; ++i) {
            const int tok = half * TPH + i, row = rowh + i, t = t0 + i;
            const float ru = rua[i], ku = kua[i], vu = vua[i];
            const float r = ru + (rp - ru) * mur, k = ku + (kp - ku) * muk, v = vu + (vp - vu) * muv;
            rp = ru; kp = ku; vp = vu;
            if (t == Tn - 1) { sout[c] = ru; sout[256 + c] = ku; sout[512 + c] = vu; }
            const u32x4* lt = (const u32x4*)(lrb + tok * 128);
            float wp = w0c, ap2 = a0c, gg = 0.f;
#pragma unroll
            for (int j = 0; j < 4; ++j) { const u32x4 x = lt[j]; wp = dot2bf(x.x, w2p[4 * j], wp); wp = dot2bf(x.y, w2p[4 * j + 1], wp); wp = dot2bf(x.z, w2p[4 * j + 2], wp); wp = dot2bf(x.w, w2p[4 * j + 3], wp); }
#pragma unroll
            for (int j = 0; j < 4; ++j) { const u32x4 x = lt[4 + j]; ap2 = dot2bf(x.x, a2p[4 * j], ap2); ap2 = dot2bf(x.y, a2p[4 * j + 1], ap2); ap2 = dot2bf(x.z, a2p[4 * j + 2], ap2); ap2 = dot2bf(x.w, a2p[4 * j + 3], ap2); }
#pragma unroll
            for (int j = 0; j < 8; ++j) { const u32x4 x = lt[8 + j]; gg = dot2bf(x.x, g2p[4 * j], gg); gg = dot2bf(x.y, g2p[4 * j + 1], gg); gg = dot2bf(x.z, g2p[4 * j + 2], gg); gg = dot2bf(x.w, g2p[4 * j + 3], gg); }
            const float w = -softplus_f(-wp) - 0.5f;
            const float decay = __expf(-__expf(w));
            const float aa = sigmoid_f(ap2);
            const float kkr = k * kkc;
            const float nrm = sqrtf(wave_sum(kkr * kkr));
            const float kk = kkr / fmaxf(nrm, 1e-12f);
            const float kh = k * (1.0f + (aa - 1.0f) * kac);
            const float rks = wave_sum(r * kh * rkc);
            unsigned char* rec = SIN + rec_index(row, h) * REC;
            ((bf16*)rec)[cc] = (bf16)f2bf(r); ((bf16*)rec)[64 + cc] = (bf16)f2bf(kh); ((bf16*)rec)[128 + cc] = (bf16)f2bf(v); ((bf16*)rec)[192 + cc] = (bf16)f2bf(kk); ((bf16*)rec)[256 + cc] = (bf16)f2bf(aa);
            ((float*)(rec + 640))[cc] = decay;
            Gb[(size_t)row * 256 + c] = (bf16)f2bf(gg);
            if (lane == 0) RKb[(size_t)row * 4 + h] = rks;
        }
        __syncthreads();
    }
}
__device__ __forceinline__ void skv_part(const Args& a, int l) {
    const int tid = ltid();
    KArgP ap = kargs(); unsigned char* ws_l = ap->ws;
    const float* in_I_CK = ap->in[I_CK];
    const bf16* U = (const bf16*)(ws_l + WS_U); bf16* SK = (bf16*)(ws_l + WS_SKV);
    const int gt = blockIdx.x * NTHR + tid, NGT = gridDim.x * NTHR;
    for (int it = gt; it < NB * SKEYS * 32; it += NGT) {
        const int c8 = (it & 31) * 8, kr = it >> 5, b = kr / SKEYS, key = kr % SKEYS;
        bf16* dst = SK + ((size_t)b * SKEYS + key) * 256 + c8;
        if (key < PAST) {
            const float* src = in_I_CK + (((size_t)(l * NB + b) * PAST + key) * 256 + c8);
            const f32x4 x0 = *(const f32x4*)src, x1 = *(const f32x4*)(src + 4);
            u32x4 o; o.x = pk2(x0.x, x0.y); o.y = pk2(x0.z, x0.w); o.z = pk2(x1.x, x1.y); o.w = pk2(x1.z, x1.w);
            *(u32x4*)dst = o;
        } else {
            *(u32x4*)dst = *(const u32x4*)(U + (size_t)(MP + b * TS + (key - PAST)) * NU + UK + c8);
        }
    }
}
__device__ __forceinline__ void vt_part(const Args& a, int l) {
    const int tid = ltid();
    KArgP ap = kargs(); unsigned char* ws_l = ap->ws;
    const float* in_I_CV = ap->in[I_CV];
    const bf16* U = (const bf16*)(ws_l + WS_U); bf16* VT = (bf16*)(ws_l + WS_VT); bf16* SVT = (bf16*)(ws_l + WS_SVT);
    const int lane = tid & 63, gw = blockIdx.x * NWAVES + (tid >> 6), NGW = gridDim.x * NWAVES;
    constexpr int NPI = 32 * (T / 64), NSI = 32 * (SKP / 64);
    for (int it = gw; it < NPI + NSI; it += NGW) {
        float v[64];
        bf16* dst;
        int pitch;
        if (it < NPI) {
            const int bh = it / (T / 64), tb = it % (T / 64), b = bh >> 2, h = bh & 3, t = tb * 64 + lane;
            const bf16* src = U + (size_t)(b * T + t) * NU + UV + h * 64;
#pragma unroll
            for (int q = 0; q < 8; ++q) { float f[8]; ld8(src + 8 * q, f);
#pragma unroll
                for (int i = 0; i < 8; ++i) v[8 * q + i] = f[i]; }
            dst = VT + (size_t)bh * 64 * VTP + t; pitch = VTP;
        } else {
            const int r = it - NPI, bh = r / (SKP / 64), kb = r % (SKP / 64), b = bh >> 2, h = bh & 3, key = kb * 64 + lane;
            if (key < PAST) { const float* src = in_I_CV + (((size_t)(l * NB + b) * PAST + key) * 256 + h * 64);
#pragma unroll
                for (int q = 0; q < 16; ++q) { const f32x4 x = *(const f32x4*)(src + 4 * q); v[4 * q] = x.x; v[4 * q + 1] = x.y; v[4 * q + 2] = x.z; v[4 * q + 3] = x.w; } }
            else if (key < SKEYS) { const bf16* src = U + (size_t)(MP + b * TS + (key - PAST)) * NU + UV + h * 64;
#pragma unroll
                for (int q = 0; q < 8; ++q) { float f[8]; ld8(src + 8 * q, f);
#pragma unroll
                    for (int i = 0; i < 8; ++i) v[8 * q + i] = f[i]; } }
            else {
#pragma unroll
                for (int i = 0; i < 64; ++i) v[i] = 0.f; }
            dst = SVT + (size_t)bh * 64 * SKP + key; pitch = SKP;
        }
#pragma unroll
        for (int d = 0; d < 64; ++d) dst[(size_t)d * pitch] = (bf16)f2bf(v[d]);
    }
}

constexpr int STEP_B = 1344;
template <int CH>
__device__ __forceinline__ void scan_unit(const Args& a, int l, int unit, unsigned char* lds) {
    constexpr int NP = CH / 16, CHUNK_B = CH * STEP_B;
    struct LdSet { u32x2 r[NP], kh[NP], kk[NP], aa[NP], v[NP]; f32x4 w[NP]; };
    const int tid = ltid();
    KArgP ap = kargs(); unsigned char* ws_l = ap->ws; float* out_l = ap->out;
    const float* in_I_SWKV = ap->in[I_SWKV];
    const int lane = tid & 63, wave = tid >> 6;
    const bool sample = unit >= 128; const int bh = (unit & 127) >> 2, rg = unit & 3, b = bh >> 2, h = bh & 3;
    const int Tn = sample ? TS : T, rowbase = sample ? MP + b * TS : b * T, nch = Tn / CH;
    const unsigned char* rec0 = ws_l + WS_SIN + ((size_t)rowbase * 4 + (size_t)h * Tn) * REC;
    float* YS = (float*)(ws_l + WS_YS);
    const bool loader = wave >= 4;
    const int lt = tid - 256, lstep = lt >> 4, ljq = lt & 15;
    const int rowl = lane >> 4, jq = lane & 15, vrow = rg * 16 + wave * 4 + rowl;
    f32x2v S01 = {0.f, 0.f}, S23 = {0.f, 0.f};
    if (!loader && sample) { const f32x4 s = *(const f32x4*)(in_I_SWKV + ((size_t)((l * NB + b) * 4 + h) * 64 + vrow) * 64 + 4 * jq); S01 = s.lo; S23 = s.hi; }
#define SC_LD(set, chunk) do { if ((chunk) < nch) { _Pragma("unroll") for (int q = 0; q < NP; ++q) { const unsigned char* rp = rec0 + (size_t)((chunk) * CH + 16 * q + lstep) * REC; \
        set.r[q] = *(const u32x2*)(rp + 8 * ljq); set.kh[q] = *(const u32x2*)(rp + 128 + 8 * ljq); set.kk[q] = *(const u32x2*)(rp + 384 + 8 * ljq); set.aa[q] = *(const u32x2*)(rp + 512 + 8 * ljq); \
        set.w[q] = *(const f32x4*)(rp + 640 + 16 * ljq); set.v[q] = *(const u32x2*)(rp + 256 + 2 * (rg * 16) + 8 * (ljq & 3)); } } } while (0)
#define SC_ST(set, bufi) do { _Pragma("unroll") for (int q = 0; q < NP; ++q) { unsigned char* sp = lds + (bufi) * CHUNK_B + (16 * q + lstep) * STEP_B; \
        const f32x4 kkf = {bflo(set.kk[q].x), bfhi(set.kk[q].x), bflo(set.kk[q].y), bfhi(set.kk[q].y)}; const f32x4 af = {bflo(set.aa[q].x), bfhi(set.aa[q].x), bflo(set.aa[q].y), bfhi(set.aa[q].y)}; \
        *(f32x4*)(sp + 16 * ljq) = (f32x4){bflo(set.r[q].x), bfhi(set.r[q].x), bflo(set.r[q].y), bfhi(set.r[q].y)}; \
        *(f32x4*)(sp + 256 + 16 * ljq) = set.w[q]; \
        *(f32x4*)(sp + 512 + 16 * ljq) = (f32x4){bflo(set.kh[q].x), bfhi(set.kh[q].x), bflo(set.kh[q].y), bfhi(set.kh[q].y)}; \
        *(f32x4*)(sp + 768 + 16 * ljq) = kkf; *(f32x4*)(sp + 1024 + 16 * ljq) = kkf * af; \
        if (ljq < 4) *(f32x4*)(sp + 1280 + 16 * ljq) = (f32x4){bflo(set.v[q].x), bfhi(set.v[q].x), bflo(set.v[q].y), bfhi(set.v[q].y)}; } } while (0)
#define SC_RD(slot, s_) do { const unsigned char* sp = cp + (s_) * STEP_B; rr[slot] = *(const f32x4*)(sp + 16 * jq); ww[slot] = *(const f32x4*)(sp + 256 + 16 * jq); kh[slot] = *(const f32x4*)(sp + 512 + 16 * jq); \
        kk[slot] = *(const f32x4*)(sp + 768 + 16 * jq); ka[slot] = *(const f32x4*)(sp + 1024 + 16 * jq); vv[slot] = *(const float*)(sp + 1280 + 4 * (wave * 4 + rowl)); } while (0)
#define SC_SCAN(bufi, chunk) do { const unsigned char* cp = lds + (bufi) * CHUNK_B; float* yp = YS + (size_t)(rowbase + (chunk) * CH + jq) * 256 + h * 64 + vrow; \
        f32x4 rr[3], ww[3], kh[3], kk[3], ka[3]; float vv[3]; float ysel = 0.f; f32x4 rprev = {0.f, 0.f, 0.f, 0.f}; \
        SC_RD(0, 0); SC_RD(1, 1); \
        _Pragma("unroll") for (int s = 0; s < CH; ++s) { const int c_ = s % 3; if (s > 0) rprev = rr[(s + 2) % 3]; if (s + 2 < CH) SC_RD((s + 2) % 3, s + 2); \
            const f32x2v p2 = S01 * kk[c_].lo + S23 * kk[c_].hi; float sa = p2.x + p2.y; \
            if (s > 0) { const f32x2v q2 = S01 * rprev.lo + S23 * rprev.hi; float yq = q2.x + q2.y; red16_2(sa, yq); ysel = (((s - 1) & 15) == jq) ? yq : ysel; if (((s - 1) & 15) == 15) yp[(size_t)(s - 16) * 256] = ysel; } \
            else sa = red16(sa); \
            const f32x2v vk01 = vv[c_] * kh[c_].lo, vk23 = vv[c_] * kh[c_].hi; \
            S01 = S01 * ww[c_].lo + (vk01 - sa * ka[c_].lo); S23 = S23 * ww[c_].hi + (vk23 - sa * ka[c_].hi); } \
        { const int p_ = (CH - 1) % 3; const f32x2v q2 = S01 * rr[p_].lo + S23 * rr[p_].hi; const float yq = red16(q2.x + q2.y); ysel = (15 == jq) ? yq : ysel; yp[(size_t)(CH - 16) * 256] = ysel; } } while (0)
    if (loader) {
        __builtin_amdgcn_s_setprio(2);
        LdSet A, B;
        SC_LD(A, 0); SC_ST(A, 0); SC_LD(A, 1); SC_LD(B, 2);
        __syncthreads();
        for (int ch = 0; ch < nch; ch += 2) {
            if (ch + 1 < nch) SC_ST(A, 1);
            SC_LD(A, ch + 3);
            __syncthreads();
            if (ch + 1 < nch) { if (ch + 2 < nch) SC_ST(B, 0); SC_LD(B, ch + 4); __syncthreads(); }
        }
        __builtin_amdgcn_s_setprio(0);
    } else {
        __syncthreads();
        for (int ch = 0; ch < nch; ch += 2) {
            SC_SCAN(0, ch);
            __syncthreads();
            if (ch + 1 < nch) { SC_SCAN(1, ch + 1); __syncthreads(); }
        }
    }
#undef SC_LD
#undef SC_ST
#undef SC_RD
#undef SC_SCAN
    if (!loader) {
        float* so = out_l + (sample ? O_SWKV : O_PWKV) + ((size_t)((l * NB + b) * 4 + h) * 64 + vrow) * 64 + 4 * jq;
        *(f32x4*)so = (f32x4){S01.x, S01.y, S23.x, S23.y};
    }
}

__device__ __forceinline__ f32x4 mfma16(bf16x8 A, bf16x8 B, f32x4 C) { return __builtin_amdgcn_mfma_f32_16x16x32_bf16(A, B, C, 0, 0, 0); }
__device__ __forceinline__ bf16x8 pack8(const f32x4 lo, const f32x4 hi) {
    u32x4 w; w.x = pk2(lo.x, lo.y); w.y = pk2(lo.z, lo.w); w.z = pk2(hi.x, hi.y); w.w = pk2(hi.z, hi.w); return __builtin_bit_cast(bf16x8, w);
}
__device__ __forceinline__ void attn_unit(const bf16* Q, int qp, const bf16* K, int kp, const bf16* VT, int vp, int qpos0, int kmax, bf16* O, int op, int lane) {
    const int fr = lane & 15, g = lane >> 4;
    bf16x8 qf[2];
#pragma unroll
    for (int ds = 0; ds < 2; ++ds) qf[ds] = *(const bf16x8*)(Q + (size_t)fr * qp + 32 * ds + 8 * g);
    f32x4 o[4];
#pragma unroll
    for (int i = 0; i < 4; ++i) o[i] = (f32x4){0.f, 0.f, 0.f, 0.f};
    float R = 0.f;
    const int qpos = qpos0 + fr;
    u32x4 onesw = {0x3F803F80u, 0x3F803F80u, 0x3F803F80u, 0x3F803F80u};
    const bf16x8 ones = __builtin_bit_cast(bf16x8, onesw);
    bf16x8 kf[4][2];
#define AT_LDK(kt_) do { _Pragma("unroll") for (int kb = 0; kb < 4; ++kb) { int kr = (kt_) * 64 + 16 * kb + fr; kr = kr > kmax ? kmax : kr; const bf16* krow = K + (size_t)kr * kp + 8 * g; \
        kf[kb][0] = *(const bf16x8*)krow; kf[kb][1] = *(const bf16x8*)(krow + 32); } } while (0)
    AT_LDK((qpos0 + 14) >> 6);
    for (int kt = (qpos0 + 14) >> 6; kt >= 0; --kt) {
        const int key0 = kt * 64;
        u32x2 vf[2][4][2];
#pragma unroll
        for (int ks = 0; ks < 2; ++ks)
#pragma unroll
            for (int db = 0; db < 4; ++db) { const bf16* vrow = VT + (size_t)(16 * db + fr) * vp + key0 + 32 * ks + 4 * g; vf[ks][db][0] = *(const u32x2*)vrow; vf[ks][db][1] = *(const u32x2*)(vrow + 16); }
        f32x4 z[4];
#pragma unroll
        for (int kb = 0; kb < 4; ++kb) {
            f32x4 acc = {0.f, 0.f, 0.f, 0.f};
            acc = mfma16(kf[kb][0], qf[0], acc);
            acc = mfma16(kf[kb][1], qf[1], acc);
            z[kb] = acc;
        }
        if (kt > 0) AT_LDK(kt - 1);
        f32x4 lk[4], ls[4]; bool vis[4][4];
#pragma unroll
        for (int kb = 0; kb < 4; ++kb)
#pragma unroll
            for (int r = 0; r < 4; ++r) {
                const int key = key0 + 16 * kb + 4 * g + r;
                const float zz = z[kb][r] * 0.125f, sp = softplus_f(zz);
                vis[kb][r] = key < qpos;
                lk[kb][r] = vis[kb][r] ? -sp : 0.f;
                ls[kb][r] = zz - sp;
            }
        bf16x8 Bhi[2], Blo[2];
#pragma unroll
        for (int ks = 0; ks < 2; ++ks) {
            u32x4 hw, lw;
            { const f32x4 x = lk[2 * ks]; const unsigned h01 = pk2(x.x, x.y), h23 = pk2(x.z, x.w); hw.x = h01; hw.y = h23; lw.x = pk2(x.x - bflo(h01), x.y - bfhi(h01)); lw.y = pk2(x.z - bflo(h23), x.w - bfhi(h23)); }
            { const f32x4 x = lk[2 * ks + 1]; const unsigned h01 = pk2(x.x, x.y), h23 = pk2(x.z, x.w); hw.z = h01; hw.w = h23; lw.z = pk2(x.x - bflo(h01), x.y - bfhi(h01)); lw.w = pk2(x.z - bflo(h23), x.w - bfhi(h23)); }
            Bhi[ks] = __builtin_bit_cast(bf16x8, hw); Blo[ks] = __builtin_bit_cast(bf16x8, lw);
        }
        f32x4 tot = {0.f, 0.f, 0.f, 0.f};
#pragma unroll
        for (int ks = 0; ks < 2; ++ks) { tot = mfma16(ones, Bhi[ks], tot); tot = mfma16(ones, Blo[ks], tot); }
        f32x4 p[4];
#pragma unroll
        for (int kb = 0; kb < 4; ++kb) {
            f32x4 la = {0.f, 0.f, 0.f, 0.f};
            const int s = 16 * kb + fr;
#pragma unroll
            for (int ks = 0; ks < 2; ++ks) {
                if (32 * ks + 31 > 16 * kb) {
                    u32x4 tw;
                    unsigned e[8];
#pragma unroll
                    for (int j = 0; j < 8; ++j) { const int jp = 32 * ks + 16 * (j >> 2) + 4 * g + (j & 3); e[j] = jp > s ? 0x3F80u : 0u; }
                    tw.x = e[0] | (e[1] << 16); tw.y = e[2] | (e[3] << 16); tw.z = e[4] | (e[5] << 16); tw.w = e[6] | (e[7] << 16);
                    const bf16x8 tri = __builtin_bit_cast(bf16x8, tw);
                    la = mfma16(tri, Bhi[ks], la); la = mfma16(tri, Blo[ks], la);
                }
            }
#pragma unroll
            for (int r = 0; r < 4; ++r) p[kb][r] = vis[kb][r] ? __expf(ls[kb][r] + la[r] + R) : 0.f;
        }
        R += tot[0];
#pragma unroll
        for (int ks = 0; ks < 2; ++ks) {
            const bf16x8 pf = pack8(p[2 * ks], p[2 * ks + 1]);
#pragma unroll
            for (int db = 0; db < 4; ++db) {
                u32x4 vw; vw.x = vf[ks][db][0].x; vw.y = vf[ks][db][0].y; vw.z = vf[ks][db][1].x; vw.w = vf[ks][db][1].y;
                o[db] = mfma16(__builtin_bit_cast(bf16x8, vw), pf, o[db]);
            }
        }
        if (__all(R < -110.f)) break;
    }
#undef AT_LDK
#pragma unroll
    for (int db = 0; db < 4; ++db) { u32x2 w; w.x = pk2(o[db][0], o[db][1]); w.y = pk2(o[db][2], o[db][3]); *(u32x2*)(O + (size_t)fr * op + 16 * db + 4 * g) = w; }
}
__device__ __forceinline__ void attn_part(const Args& a, int l, int aw, int naw) {
    const int tid = ltid();
    KArgP ap = kargs(); unsigned char* ws_l = ap->ws; float* out_l = ap->out; (void)ws_l; (void)out_l;
    const bf16* U = (const bf16*)(ws_l + WS_U); bf16* YC = (bf16*)(ws_l + WS_H);
    const bf16* SK = (const bf16*)(ws_l + WS_SKV); const bf16* VT = (const bf16*)(ws_l + WS_VT); const bf16* SVT = (const bf16*)(ws_l + WS_SVT);
    const int lane = tid & 63;
    constexpr int NUNIT = 32 + NB * 4 * (T / 16);
    for (int u = aw; u < NUNIT; u += naw) {
        if (u < 32) { const int b = u >> 2, h = u & 3; const int row0 = MP + b * TS;
            attn_unit(U + (size_t)row0 * NU + UQ + h * 64, NU, SK + (size_t)b * SKEYS * 256 + h * 64, 256, SVT + (size_t)u * 64 * SKP, SKP, PAST, SKEYS - 1, YC + (size_t)row0 * D + 768 + h * 64, D, lane);
        } else { const int v = u - 32, qb = v & 255, bh = v >> 8, b = bh >> 2, h = bh & 3; const int row0 = b * T + qb * 16;
            attn_unit(U + (size_t)row0 * NU + UQ + h * 64, NU, U + (size_t)(b * T) * NU + UK + h * 64, NU, VT + (size_t)bh * 64 * VTP, VTP, qb * 16, T - 1, YC + (size_t)row0 * D + 768 + h * 64, D, lane);
        }
    }
}

__device__ __forceinline__ void rwkv_post(const Args& a, int l) {
    const int tid = ltid();
    KArgP ap = kargs(); unsigned char* ws_l = ap->ws;
    const float* in_I_LNB = ap->in[I_LNB]; const float* in_I_LNW = ap->in[I_LNW];
    const float* YS = (const float*)(ws_l + WS_YS); const bf16* Gb = (const bf16*)(ws_l + WS_G); const float* RKb = (const float*)(ws_l + WS_RK);
    bf16* YC = (bf16*)(ws_l + WS_H);
    const int lane = tid & 63, wave = tid >> 6, h = lane >> 4, c4 = 4 * lane, cc = 4 * (lane & 15);
    const f32x4 lnw = *(const f32x4*)(in_I_LNW + l * 256 + c4), lnb = *(const f32x4*)(in_I_LNB + l * 256 + c4);
    const int gw = blockIdx.x * NWAVES + wave, NGW = gridDim.x * NWAVES;
#define PO_BODY(row_, y_, gq_, vq_, rk_) do { \
        const float mean = red16((y_.x + y_.y) + (y_.z + y_.w)) * (1.f / 64.f); const f32x4 dv = y_ - mean; \
        const float var = red16((dv.x * dv.x + dv.y * dv.y) + (dv.z * dv.z + dv.w * dv.w)) * (1.f / 64.f); const float rs = rsqrtf(var + GN_EPS); \
        const float o0 = (dv.x * rs * lnw.x + lnb.x + rk_ * bflo(vq_.x)) * bflo(gq_.x), o1 = (dv.y * rs * lnw.y + lnb.y + rk_ * bfhi(vq_.x)) * bfhi(gq_.x); \
        const float o2 = (dv.z * rs * lnw.z + lnb.z + rk_ * bflo(vq_.y)) * bflo(gq_.y), o3 = (dv.w * rs * lnw.w + lnb.w + rk_ * bfhi(vq_.y)) * bfhi(gq_.y); \
        u32x2 o; o.x = pk2(o0, o1); o.y = pk2(o2, o3); *(u32x2*)(YC + (size_t)(row_) * D + 256 + c4) = o; } while (0)
#define PO_LOAD(r_, y_, g_, v_, k_) do { y_ = *(const f32x4*)(YS + (size_t)(r_) * 256 + c4); g_ = *(const u32x2*)(Gb + (size_t)(r_) * 256 + c4); \
        v_ = *(const u32x2*)(ws_l + WS_SIN + rec_index((r_), h) * REC + 256 + 2 * cc); k_ = RKb[(size_t)(r_) * 4 + h]; } while (0)
    for (int row = gw; row < MR; row += 4 * NGW) {
        f32x4 y0, y1, y2, y3; u32x2 g0, g1, g2, g3, v0, v1, v2, v3; float k0, k1, k2, k3;
        const int r1 = row + NGW, r2 = row + 2 * NGW, r3 = row + 3 * NGW;
        PO_LOAD(row, y0, g0, v0, k0);
        if (r1 < MR) PO_LOAD(r1, y1, g1, v1, k1);
        if (r2 < MR) PO_LOAD(r2, y2, g2, v2, k2);
        if (r3 < MR) PO_LOAD(r3, y3, g3, v3, k3);
        PO_BODY(row, y0, g0, v0, k0);
        if (r1 < MR) PO_BODY(r1, y1, g1, v1, k1);
        if (r2 < MR) PO_BODY(r2, y2, g2, v2, k2);
        if (r3 < MR) PO_BODY(r3, y3, g3, v3, k3);
    }
#undef PO_BODY
#undef PO_LOAD
}

template <int MODE, int K>
__device__ __forceinline__ void small_gemm(const bf16* A, const bf16* Bt, int ncol16, bf16* Ob, float* Of, int ldc, float* sk, float* sv, unsigned char* lds, int bid, int G) {
    constexpr int KW = K / 8, NKS = KW / 32, NB_ = (MODE == 1) ? 4 : 2;
    static_assert(KW % 32 == 0, "K split");
    const int tid = ltid(), lane = tid & 63, wave = tid >> 6, fr = lane & 15, g = lane >> 4;
    float* part = (float*)lds;
    const int ntile = 8 * (ncol16 / 2);
    bf16x8 af[NKS], b0[NKS], b1[NKS], b2[NKS], b3[NKS];
    int tile = bid;
#define SG_ROW(c_) ((MODE == 1) ? (256 * ((c_) >> 7) + ((c_) & 127)) : (c_))
#define SG_LOAD(tl) do { const int mt_ = (tl) & 7, c0_ = ((tl) >> 3) * 32; \
        const bf16* ap_ = A + (size_t)(mt_ * 16 + fr) * K + wave * KW + 8 * g; const bf16* bp_ = Bt + (size_t)(SG_ROW(c0_) + fr) * K + wave * KW + 8 * g; const bf16* bq_ = bp_ + (size_t)16 * K; \
        _Pragma("unroll") for (int q = 0; q < NKS; ++q) { af[q] = *(const bf16x8*)(ap_ + 32 * q); b0[q] = *(const bf16x8*)(bp_ + 32 * q); b1[q] = *(const bf16x8*)(bq_ + 32 * q); \
            if (MODE == 1) { b2[q] = *(const bf16x8*)(bp_ + (size_t)128 * K + 32 * q); b3[q] = *(const bf16x8*)(bq_ + (size_t)128 * K + 32 * q); } } } while (0)
    if (tile < ntile) SG_LOAD(tile);
    for (int it = 0; tile < ntile; ++it, tile += G) {
        f32x4 acc0 = {0.f, 0.f, 0.f, 0.f}, acc1 = acc0, acc2 = acc0, acc3 = acc0;
#pragma unroll
        for (int q = 0; q < NKS; ++q) { acc0 = mfma16(b0[q], af[q], acc0); acc1 = mfma16(b1[q], af[q], acc1); if (MODE == 1) { acc2 = mfma16(b2[q], af[q], acc2); acc3 = mfma16(b3[q], af[q], acc3); } }
        if (tile + G < ntile) SG_LOAD(tile + G);
        float* pb = part + (it & 1) * (8 * NB_ * 256);
        *(f32x4*)(pb + (wave * NB_ + 0) * 256 + lane * 4) = acc0; *(f32x4*)(pb + (wave * NB_ + 1) * 256 + lane * 4) = acc1;
        if (MODE == 1) { *(f32x4*)(pb + (wave * NB_ + 2) * 256 + lane * 4) = acc2; *(f32x4*)(pb + (wave * NB_ + 3) * 256 + lane * 4) = acc3; }
        __syncthreads();
        {
            const int sub = tid >> 8, e = tid & 255;
            float s0 = 0.f, s1 = 0.f;
#pragma unroll
            for (int w = 0; w < 8; ++w) { s0 += pb[(w * NB_ + sub) * 256 + e]; if (MODE == 1) s1 += pb[(w * NB_ + 2 + sub) * 256 + e]; }
            const int ln = e >> 2, r = e & 3, mt = tile & 7, c0 = (tile >> 3) * 32 + 16 * sub;
            const int m = mt * 16 + (ln & 15), n = c0 + 4 * (ln >> 4) + r;
            if (MODE == 0) Ob[(size_t)m * ldc + n] = (bf16)f2bf(s0);
            else if (MODE == 1) Ob[(size_t)m * ldc + n] = (bf16)f2bf(pg8::silu_f(s0) * s1);
            else { Ob[(size_t)m * ldc + n] = (bf16)f2bf(s0); if (n >= UK && n < UK + 512) ((n < UV ? sk : sv) + (size_t)m * 256)[n & 255] = s0; }
        }
    }
#undef SG_LOAD
#undef SG_ROW
    __syncthreads();
}

#define XB_TMO      128
#define XB_XCNT(j)  (256  + 64 * (j))
#define XB_XSUB(j)  (1280 + 64 * (j))
#define XB_XGEN(j)  (2304 + 64 * (j))
#define XB_TOP      3328
#define XB_TOPGEN   3392
#define XCD_BAR_WORDS 3456
#define XB_SPIN_CAP (1u << 18)

__device__ __forceinline__ unsigned xb_ld(unsigned* p)              { return __hip_atomic_load(p, __ATOMIC_RELAXED, __HIP_MEMORY_SCOPE_AGENT); }
__device__ __forceinline__ unsigned xb_add(unsigned* p, unsigned v) { return __hip_atomic_fetch_add(p, v, __ATOMIC_RELAXED, __HIP_MEMORY_SCOPE_AGENT); }
__device__ __forceinline__ unsigned xb_xcc_id() { return (unsigned)__builtin_amdgcn_s_getreg((3 << 11) | 20) & 0xFu; }
#define XB_SPIN(cond, bar) do { unsigned _sp = 0; while (cond) { __builtin_amdgcn_s_sleep(1); \
    if ((++_sp & 255u) == 0u) { if (xb_ld(&(bar)[XB_TMO])) break; if (_sp > XB_SPIN_CAP) { atomicAdd(&(bar)[XB_TMO], 1u); break; } } } } while (0)

struct XcdBarrier {
    unsigned* bar; unsigned x;
    volatile LAS unsigned* st;
};

__device__ __forceinline__ XcdBarrier xcd_barrier_post(unsigned* bar, volatile LAS unsigned* st) {
    XcdBarrier b; b.bar = bar; b.x = xb_xcc_id(); b.st = st;
    if (threadIdx.x == 0) (void)xb_add(&bar[XB_XCNT(b.x)], 1u);
    return b;
}
__device__ __forceinline__ void xcd_barrier_complete(unsigned* bar, unsigned x, unsigned& nloc, unsigned& nx) {
    const unsigned G = gridDim.x * gridDim.y * gridDim.z;
    unsigned sum, cnt, mine, sp = 0u;
    for (;;) {
        sum = 0u; cnt = 0u; mine = 0u;
#pragma unroll
        for (unsigned j = 0; j < 16; ++j) { const unsigned c = xb_ld(&bar[XB_XCNT(j)]); sum += c; cnt += (c > 0u) ? 1u : 0u; mine = (j == x) ? c : mine; }
        if (sum == G) break;
        __builtin_amdgcn_s_sleep(1);
        if ((++sp & 255u) == 0u) { if (xb_ld(&bar[XB_TMO])) break; if (sp > XB_SPIN_CAP) { atomicAdd(&bar[XB_TMO], 1u); break; } }
    }
    nloc = mine > 0u ? mine : 1u; nx = cnt > 0u ? cnt : 1u;
}

__device__ __forceinline__ void xcd_barrier(const XcdBarrier& b) {
    asm volatile("s_waitcnt vmcnt(0)" ::: "memory");
    __syncthreads();
    if (threadIdx.x == 0) {
        unsigned* bar = b.bar;
        __builtin_amdgcn_s_waitcnt(0);
        unsigned nloc = b.st[0], nx = b.st[1];
        if (nloc == 0u) { xcd_barrier_complete(bar, b.x, nloc, nx); b.st[0] = nloc; b.st[1] = nx; }
        const unsigned old = xb_add(&bar[XB_XSUB(b.x)], 1u);
        const unsigned gen = old / nloc;
        if (old + 1u == (gen + 1u) * nloc) {
            __builtin_amdgcn_fence(__ATOMIC_RELEASE, "agent");
            asm volatile("s_waitcnt vmcnt(0)" ::: "memory");
            const unsigned og = xb_add(&bar[XB_TOP], 1u);
            const unsigned tg = og / nx;
            if (og + 1u == (tg + 1u) * nx) xb_add(&bar[XB_TOPGEN], 1u);
            else XB_SPIN(xb_ld(&bar[XB_TOPGEN]) == tg, bar);
            __builtin_amdgcn_fence(__ATOMIC_ACQUIRE, "agent");
            xb_add(&bar[XB_XGEN(b.x)], 1u);
            asm volatile("s_waitcnt vmcnt(0)" ::: "memory");
        } else {
            XB_SPIN(xb_ld(&bar[XB_XGEN(b.x)]) == gen, bar);
            __builtin_amdgcn_fence(__ATOMIC_ACQUIRE, "agent");
            asm volatile("s_waitcnt vmcnt(0)" ::: "memory");
        }
    }
    __syncthreads();
}

__global__ void __launch_bounds__(NTHR, 2) mk_fwd(Args a) {
    extern __shared__ __attribute__((aligned(16))) unsigned char lds[];
    cg::grid_group grid = cg::this_grid();
    const int lo = MK_PER_PHASE ? a.ph_lo : 0, hi = MK_PER_PHASE ? a.ph_hi : NPH, G = gridDim.x;
#define IN(k) (lo <= (k) && (k) < hi)
    for (int u_ = ltid(); u_ < 64; u_ += NTHR) ((LAS unsigned*)((LAS unsigned char*)lds + 131072))[u_] = 0u;
    __syncthreads();
    (void)xcd_barrier_post((unsigned*)(a.ws + WS_CTL), (volatile LAS unsigned*)((LAS unsigned char*)lds + 131072 + 64));
#define XBAR_NOW() do { XcdBarrier xb_; xb_.bar = (unsigned*)(kargs()->ws + WS_CTL); xb_.x = xb_xcc_id(); xb_.st = (volatile LAS unsigned*)((LAS unsigned char*)lds + 131072 + 64); xcd_barrier(xb_); } while (0)
#define SEAM(k) do { if (IN(k) && IN((k) + 1)) { if ((k) == PH_PRE) grid.sync(); else XBAR_NOW(); } } while (0)
    PG8_LAS unsigned char* ring = (PG8_LAS unsigned char*)lds;
#define PHASE_PTRS KArgP ap = kargs(); unsigned char* ws_ = ap->ws; float* out_ = ap->out; \
    bf16* Wb = (bf16*)(ws_ + WS_W); bf16* H = (bf16*)(ws_ + WS_H); bf16* ACT = (bf16*)(ws_ + WS_U); bf16* Y = (bf16*)(ws_ + WS_Y); float* X = out_ + O_X; bf16* XB = (bf16*)(out_ + O_X); bf16* XALT = (bf16*)(ws_ + WS_Y + (size_t)M * D * 2); \
    const bf16* WL = Wb + (size_t)l * LW; const float* ng = ap->in[I_NG] + (size_t)l * 6 * D; (void)H; (void)ACT; (void)Y; (void)X; (void)XB; (void)XALT; (void)WL; (void)ng;

#define REPEAT(bit) _Pragma("nounroll") for (int rep_ = 0; rep_ < ((REP & (bit)) ? 2 : 1); ++rep_)
#define RSYNC if (rep_) XBAR_NOW();
#define GEMM_MAIN(EPI, Aptr, Wptr, NN, KK, EOBJ) { pg8::Gemm g{Aptr, Wptr, MP, NN, KK}; pg8::StaticOrder S; S.init(MP, NN, G, (int)blockIdx.x); pg8::gemm_phase<EPI, pg8::StaticOrder, true, true>(ring, g, S, EOBJ); }
#define SMALL_IDS const int tid_ = ltid(); const int gw_ = (int)blockIdx.x * NWAVES + (tid_ >> 6), ngw_ = G * NWAVES, lane_ = tid_ & 63;
    if (REP & 16384) { for (int i = 0; i < 20; ++i) XBAR_NOW(); }
    if (IN(PH_PRE)) REPEAT(128) { RSYNC phase_pre(a, lds); }
    SEAM(PH_PRE);
    for (int l = 0; l < 2; ++l) {
        const int p0 = 1 + l * PH_PER_LAYER;
        if (IN(p0 + P_A1)) REPEAT(1) { RSYNC PHASE_PTRS
            { pg8::EpiSwiglu E{ACT, FF}; GEMM_MAIN(pg8::EpiSwiglu, H, WL + W_GUA, 2 * FF, D, E) }
            small_gemm<1, D>(H + (size_t)MP * D, WL + W_GUA, FF / 16, ACT + (size_t)MP * FF, nullptr, FF, nullptr, nullptr, lds, (int)blockIdx.x, G); }
        SEAM(p0 + P_A1);
        if (IN(p0 + P_A2)) REPEAT(2) { RSYNC PHASE_PTRS
            { pg8::EpiBf E{Y, D}; GEMM_MAIN(pg8::EpiBf, ACT, WL + W_DA, D, FF, E) }
            small_gemm<0, FF>(ACT + (size_t)MP * FF, WL + W_DA, D / 16, Y + (size_t)MP * D, nullptr, D, nullptr, nullptr, lds, (int)blockIdx.x, G); }
        SEAM(p0 + P_A2);
        if (IN(p0 + P_A3)) { PHASE_PTRS
            if (l == 0) phase_rowpass<true, false, true>(ap->in[I_XP], ap->in[I_XS], Y, 0.5f, ng + 1 * D, ng + 2 * D, XB, H);
            else        phase_rowpass<false, false, true>(XB, XB, Y, 0.5f, ng + 1 * D, ng + 2 * D, XB, H);
        }
        SEAM(p0 + P_A3);
        if (IN(p0 + P_B1)) REPEAT(4) { RSYNC PHASE_PTRS
            { pg8::EpiU E{ACT, NU, out_ + O_PK + (size_t)l * MP * 256, out_ + O_PV + (size_t)l * MP * 256, out_ + O_SK + (size_t)l * MS * 256, out_ + O_SV + (size_t)l * MS * 256, MP, MR};
              GEMM_MAIN(pg8::EpiU, H, WL + W_IN, NU, D, E) }
            if (G == 256) { if ((int)blockIdx.x >= 128) small_gemm<2, D>(H + (size_t)MP * D, WL + W_IN, NU / 16, ACT + (size_t)MP * NU, nullptr, NU, out_ + O_SK + (size_t)l * MS * 256, out_ + O_SV + (size_t)l * MS * 256, lds, (int)blockIdx.x - 128, 128); }
              else small_gemm<2, D>(H + (size_t)MP * D, WL + W_IN, NU / 16, ACT + (size_t)MP * NU, nullptr, NU, out_ + O_SK + (size_t)l * MS * 256, out_ + O_SV + (size_t)l * MS * 256, lds, (int)blockIdx.x, G); }
        SEAM(p0 + P_B1);
        if (IN(p0 + P_C1)) REPEAT(16) { RSYNC
            skv_part(a, l); vt_part(a, l);
            for (int r4_ = 0; r4_ < ((REP & 4096) ? 2 : 1); ++r4_) rwkv_prep_part(a, l, lds);
        }
        SEAM(p0 + P_C1);
        if (IN(p0 + P_C2)) REPEAT(32) { RSYNC
            _Pragma("nounroll") for (int r2_ = 0; r2_ < ((REP & 256) ? 2 : 1); ++r2_)
            for (int u = blockIdx.x; u < 256; u += G) { if (u < 128) scan_unit<32>(a, l, u, lds); else scan_unit<16>(a, l, u, lds); }
            const int ab0 = G / 2;
            if ((int)blockIdx.x >= ab0) { _Pragma("nounroll") for (int r3_ = 0; r3_ < ((REP & 512) ? 2 : 1); ++r3_) attn_part(a, l, ((int)blockIdx.x - ab0) * NWAVES + (int)(ltid() >> 6), (G - ab0) * NWAVES);
                for (int r4_ = 0; r4_ < ((REP & 1024) ? 2 : 1); ++r4_) conv_part(a, l, (int)blockIdx.x - ab0, G - ab0);
                for (int r4_ = 0; r4_ < ((REP & 2048) ? 2 : 1); ++r4_) pool_part(a, l, lds, (int)blockIdx.x - ab0, G - ab0); }
        }
        SEAM(p0 + P_C2);
        if (IN(p0 + P_C3)) REPEAT(64) { RSYNC rwkv_post(a, l); }
        SEAM(p0 + P_C3);
        if (IN(p0 + P_D1)) REPEAT(8) { RSYNC PHASE_PTRS
            { pg8::EpiBf E{Y, D}; GEMM_MAIN(pg8::EpiBf, H, WL + W_OUT, D, D, E) }
            small_gemm<0, D>(H + (size_t)MP * D, WL + W_OUT, D / 16, Y + (size_t)MP * D, nullptr, D, nullptr, nullptr, lds, (int)blockIdx.x, G); }
        SEAM(p0 + P_D1);
        if (IN(p0 + P_D2)) { PHASE_PTRS if (l == 0) phase_rowpass<false, false, true>(XB, XB, Y, 1.0f, ng + 3 * D, ng + 4 * D, XB, H);
            else        phase_rowpass<false, false, true>(XB, XB, Y, 1.0f, ng + 3 * D, ng + 4 * D, XALT, H); }
        SEAM(p0 + P_D2);
        if (IN(p0 + P_E1)) REPEAT(1) { RSYNC PHASE_PTRS
            { pg8::EpiSwiglu E{ACT, FF}; GEMM_MAIN(pg8::EpiSwiglu, H, WL + W_GUB, 2 * FF, D, E) }
            small_gemm<1, D>(H + (size_t)MP * D, WL + W_GUB, FF / 16, ACT + (size_t)MP * FF, nullptr, FF, nullptr, nullptr, lds, (int)blockIdx.x, G); }
        SEAM(p0 + P_E1);
        if (IN(p0 + P_E2)) REPEAT(2) { RSYNC PHASE_PTRS
            { pg8::EpiBf E{Y, D}; GEMM_MAIN(pg8::EpiBf, ACT, WL + W_DB, D, FF, E) }
            small_gemm<0, FF>(ACT + (size_t)MP * FF, WL + W_DB, D / 16, Y + (size_t)MP * D, nullptr, D, nullptr, nullptr, lds, (int)blockIdx.x, G); }
        SEAM(p0 + P_E2);
        if (IN(p0 + P_E3)) { PHASE_PTRS
            if (l == 0) phase_rowpass<false, false, true>(XB, XB, Y, 0.5f, ng + 5 * D, ng + 6 * D, XB, H);
            else        phase_rowpass<false, true, false>(XALT, XALT, Y, 0.5f, ng + 5 * D, ng, X, H);
        }
        SEAM(p0 + P_E3);
    }
#undef IN
#undef SEAM
}

extern "C" void kernel_launch(void* const* d_in, const int* in_sizes, int n_in, void* d_out, int out_size, void* d_ws, size_t ws_size, hipStream_t stream) {
    static int grid = 0;
    if (grid == 0) {
        if (n_in != 28 || (size_t)out_size != O_END || ws_size < WS_END) { fprintf(stderr, "kernel_launch: unexpected shapes: n_in %d out %d ws %zu (need %zu)\n", n_in, out_size, ws_size, (size_t)WS_END); grid = -1; return; }
        int dev = 0, cus = 0, per_cu = 0;
        if (hipGetDevice(&dev) != hipSuccess || hipDeviceGetAttribute(&cus, hipDeviceAttributeMultiprocessorCount, dev) != hipSuccess) { grid = -1; return; }
        if (hipFuncSetAttribute((const void*)mk_fwd, hipFuncAttributeMaxDynamicSharedMemorySize, LDS_BYTES) != hipSuccess) { fprintf(stderr, "kernel_launch: hipFuncSetAttribute failed\n"); grid = -1; return; }
        if (hipOccupancyMaxActiveBlocksPerMultiprocessor(&per_cu, (const void*)mk_fwd, NTHR, LDS_BYTES) != hipSuccess || per_cu < 1) { fprintf(stderr, "kernel_launch: occupancy query says %d\n", per_cu); per_cu = 1; }
        (void)hipGetLastError();
        grid = cus * 1;
    }
    if (grid < 0) return;
    if (hipMemsetAsync((char*)d_ws + WS_CTL, 0, 16384, stream) != hipSuccess) { fprintf(stderr, "kernel_launch: hipMemsetAsync failed\n"); return; }
    Args a{};
    for (int i = 0; i < 28; ++i) a.in[i] = (const float*)d_in[i];
    a.out = (float*)d_out; a.ws = (unsigned char*)d_ws;
#if MK_PER_PHASE
    for (int ph = 0; ph < NPH; ++ph) { a.ph_lo = ph; a.ph_hi = ph + 1; hipLaunchKernelGGL(mk_fwd, dim3(grid), dim3(NTHR), LDS_BYTES, stream, a); }
#else
    a.ph_lo = 0; a.ph_hi = NPH;
    void* args[] = {&a};
    hipError_t e = hipLaunchCooperativeKernel((const void*)mk_fwd, dim3(grid), dim3(NTHR), args, LDS_BYTES, stream);
    if (e != hipSuccess) fprintf(stderr, "kernel_launch: cooperative launch failed: %s (grid %d)\n", hipGetErrorString(e), grid);
#endif
}
```

```cpp
#include <hip/hip_runtime.h>
#include <hip/hip_cooperative_groups.h>
#include <cstdio>
#include <cstdint>
namespace cg = cooperative_groups;
#ifndef MK_PER_PHASE
#define MK_PER_PHASE 0
#endif
#ifndef DIS
#define DIS 0
#endif
__device__ __forceinline__ int ltid() { int t = threadIdx.x; asm volatile("" : "+v"(t)); return t; }
#ifndef REP
#define REP 0
#endif
namespace pg8 {
#define PG8_LAS __attribute__((address_space(3)))
typedef unsigned short bf16_t;
typedef short bf16x8 __attribute__((ext_vector_type(8)));
typedef float f32x4 __attribute__((ext_vector_type(4)));
typedef unsigned u32x4 __attribute__((ext_vector_type(4)));
constexpr int BM = 256, BK = 64, HALF = 128, HTB = HALF * BK * 2  , STAGE_BYTES = 8 * HTB, NXCD = 8, WGM = 8;

__host__ __device__ __forceinline__ int lds_byte(int r, int c) { const int st = (r >> 4) * 2 + (c >> 5), rr = r & 15, cc = c & 31, ob = rr * 64 + cc * 2; return st * 1024 + (ob ^ (((ob >> 9) & 1) << 5)); }
__host__ __device__ __forceinline__ void stage_rc(int b, int& R, int& C) { const int st = b / 1024, sb = b % 1024, swz = sb ^ (((sb >> 9) & 1) << 5); R = (st >> 1) * 16 + swz / 64; C = (st & 1) * 32 + (swz % 64) / 2; }
__host__ __device__ __forceinline__ int perm32(int rho) { const int n = rho >> 4, i = rho & 15; return 8 * (i >> 2) + 4 * n + (i & 3); }

struct Unit { int pm, pn; };
struct Gemm { const bf16_t* A; const bf16_t* Bt; int M, N, K; };

struct StaticOrder {
    int nM, nN, nwg, G, c;
    __host__ __device__ void init(int M, int N, int G_, int c_) { nM = M / BM; nN = N / BM; nwg = nM * nN; G = G_; c = c_; }
    __host__ __device__ bool next(int i, Unit& u) const {
        const long L = (long)i * G + c; if (L >= nwg) return false;
        int wgid = (int)L; { const int q = nwg / NXCD, r = nwg % NXCD, xcd = wgid % NXCD, off = wgid / NXCD; wgid = (xcd < r ? xcd * (q + 1) : r * (q + 1) + (xcd - r) * q) + off; }
        const int nig = WGM * nN, gid = wgid / nig, fm = gid * WGM, gsz = (nM - fm) < WGM ? (nM - fm) : WGM;
        u.pm = fm + ((wgid % nig) % gsz); u.pn = (wgid % nig) / gsz; return true;
    }
    __device__ __forceinline__ void a_ready(const Unit&) const {}
    __device__ __forceinline__ void done(const Unit&) const {}
};

__device__ __forceinline__ unsigned cvt_pk_bf16(float lo, float hi) { unsigned r; asm volatile("v_cvt_pk_bf16_f32 %0, %1, %2" : "=v"(r) : "v"(lo), "v"(hi)); return r; }

__device__ __forceinline__ float silu_f(float x) { return x * __builtin_amdgcn_rcpf(1.0f + __builtin_amdgcn_exp2f(-1.44269504089f * x)); }
struct EpiSwiglu {
    static constexpr bool PERM = true, AFTER_DRAIN = false;
    bf16_t* O; int ldc;
    __device__ __forceinline__ void operator()(const f32x4 (&acc)[2][2][4][2], const Unit& u, int wr, int wc, int fr, int fq) const {
        const int row0 = u.pm * BM + wr * 64 + fr, col0 = u.pn * HALF + wc * 32 + 8 * fq;
#pragma unroll
        for (int ai = 0; ai < 2; ++ai)
#pragma unroll
            for (int m = 0; m < 4; ++m) {
                bf16_t* rowp = O + (size_t)(row0 + ai * HALF + m * 16) * ldc + col0;
                const f32x4 g0 = acc[ai][0][m][0], g1 = acc[ai][0][m][1], u0 = acc[ai][1][m][0], u1 = acc[ai][1][m][1];
                u32x4 w;
                w.x = cvt_pk_bf16(silu_f(g0[0]) * u0[0], silu_f(g0[1]) * u0[1]); w.y = cvt_pk_bf16(silu_f(g0[2]) * u0[2], silu_f(g0[3]) * u0[3]);
                w.z = cvt_pk_bf16(silu_f(g1[0]) * u1[0], silu_f(g1[1]) * u1[1]); w.w = cvt_pk_bf16(silu_f(g1[2]) * u1[2], silu_f(g1[3]) * u1[3]);
                *(u32x4*)rowp = w;
            }
    }
};
struct EpiF32 {
    static constexpr bool PERM = false, AFTER_DRAIN = false;
    float* O; int ldc;
    __device__ __forceinline__ void operator()(const f32x4 (&acc)[2][2][4][2], const Unit& u, int wr, int wc, int fr, int fq) const {
        const int row0 = u.pm * BM + wr * 64 + fr, col0 = u.pn * BM + wc * 32 + 4 * fq;
#pragma unroll
        for (int ai = 0; ai < 2; ++ai)
#pragma unroll
            for (int m = 0; m < 4; ++m) {
                float* rowp = O + (size_t)(row0 + ai * HALF + m * 16) * ldc + col0;
#pragma unroll
                for (int bj = 0; bj < 2; ++bj)
#pragma unroll
                    for (int n = 0; n < 2; ++n) *(f32x4*)(rowp + bj * HALF + n * 16) = acc[ai][bj][m][n];
            }
    }
};
struct EpiU {
    static constexpr bool PERM = true, AFTER_DRAIN = false;
    bf16_t* O; int ldc; float* pk; float* pv; float* sk; float* sv; int mp, mr;
    __device__ __forceinline__ void operator()(const f32x4 (&acc)[2][2][4][2], const Unit& u, int wr, int wc, int fr, int fq) const {
        const int row0 = u.pm * BM + wr * 64 + fr, colt = wc * 32 + 8 * fq;
        const bool kv = (u.pn == 1) || (u.pn == 2);
#pragma unroll
        for (int ai = 0; ai < 2; ++ai)
#pragma unroll
            for (int m = 0; m < 4; ++m) {
                const int row = row0 + ai * HALF + m * 16;
                bf16_t* rowp = O + (size_t)row * ldc + u.pn * BM + colt;
#pragma unroll
                for (int bj = 0; bj < 2; ++bj) {
                    const f32x4 v0 = acc[ai][bj][m][0], v1 = acc[ai][bj][m][1];
                    u32x4 w; w.x = cvt_pk_bf16(v0[0], v0[1]); w.y = cvt_pk_bf16(v0[2], v0[3]); w.z = cvt_pk_bf16(v1[0], v1[1]); w.w = cvt_pk_bf16(v1[2], v1[3]);
                    *(u32x4*)(rowp + bj * HALF) = w;
                    if (kv && row < mr) {
                        float* dst = (row < mp) ? ((u.pn == 1 ? pk : pv) + (size_t)row * 256) : ((u.pn == 1 ? sk : sv) + (size_t)(row - mp) * 256);
                        dst += bj * HALF + colt;
                        *(f32x4*)dst = v0; *(f32x4*)(dst + 4) = v1;
                    }
                }
            }
    }
};
struct EpiBf {
    static constexpr bool PERM = true, AFTER_DRAIN = false;
    bf16_t* O; int ldc;
    __device__ __forceinline__ void operator()(const f32x4 (&acc)[2][2][4][2], const Unit& u, int wr, int wc, int fr, int fq) const {
        const int row0 = u.pm * BM + wr * 64 + fr, col0 = u.pn * BM + wc * 32 + 8 * fq;
#pragma unroll
        for (int ai = 0; ai < 2; ++ai)
#pragma unroll
            for (int m = 0; m < 4; ++m) {
                bf16_t* rowp = O + (size_t)(row0 + ai * HALF + m * 16) * ldc + col0;
#pragma unroll
                for (int bj = 0; bj < 2; ++bj) {
                    const f32x4 v0 = acc[ai][bj][m][0], v1 = acc[ai][bj][m][1];
                    u32x4 w; w.x = cvt_pk_bf16(v0[0], v0[1]); w.y = cvt_pk_bf16(v0[2], v0[3]); w.z = cvt_pk_bf16(v1[0], v1[1]); w.w = cvt_pk_bf16(v1[2], v1[3]);
                    *(u32x4*)(rowp + bj * HALF) = w;
                }
            }
    }
};

template <class Epi, class Sched, bool ALIGN_EPI = false, bool SP2 = false>
__device__ __forceinline__ void gemm_phase(PG8_LAS unsigned char* lds, const Gemm g, const Sched& S, const Epi& E) {
    const int tid = ltid(), wid = __builtin_amdgcn_readfirstlane(tid >> 6), lane = tid & 63, wr = wid >> 2, wc = wid & 3, fr = lane & 15, fq = lane >> 4;
    const int K = g.K, nt = K / BK;
    unsigned voffA[2], voffB[2];
#pragma unroll
    for (int i = 0; i < 2; ++i) { int R, C; stage_rc(tid * 16 + i * 8192, R, C); const int Rb = Epi::PERM ? ((R & ~31) + perm32(R & 31)) : R;
        voffA[i] = (unsigned)(R * K + C) * 2u; voffB[i] = (unsigned)(Rb * K + C) * 2u; }
    const size_t kstep = (size_t)(BK * 2);
    const size_t hstep = (size_t)HALF * K * 2;
    const size_t tstep = 2 * hstep;
    const unsigned ldsw = (unsigned)wid * 1024u;
    const int aoff = lds_byte(wr * 64 + fr, fq * 8), boff = lds_byte(wc * 32 + fr, fq * 8);
#define PG8_SA(b, h) (((b) * 2 + (h)) * HTB)
#define PG8_SB(b, h) ((4 + (b) * 2 + (h)) * HTB)
#define PG8_STAGE(bufoff, gbase, voff) do { _Pragma("unroll") for (int _i = 0; _i < 2; ++_i) \
        __builtin_amdgcn_global_load_lds((const unsigned*)((const char*)(gbase) + (voff)[_i]), (PG8_LAS unsigned*)(lds + (bufoff) + ldsw + _i * 8192), 16, 0, 0); } while (0)
#define PG8_LDA(dst, b, h) do { _Pragma("unroll") for (int m = 0; m < 4; ++m) _Pragma("unroll") for (int k = 0; k < 2; ++k) dst[m][k] = *(const PG8_LAS bf16x8*)(lds + PG8_SA(b, h) + aoff + m * 2048 + k * 1024); } while (0)
#define PG8_LDB(dst, b, h) do { _Pragma("unroll") for (int n = 0; n < 2; ++n) _Pragma("unroll") for (int k = 0; k < 2; ++k) dst[n][k] = *(const PG8_LAS bf16x8*)(lds + PG8_SB(b, h) + boff + n * 2048 + k * 1024); } while (0)
#define PG8_MMA(ai, bj, At, Bt) do { __builtin_amdgcn_s_setprio(1); _Pragma("unroll") for (int m = 0; m < 4; ++m) _Pragma("unroll") for (int n = 0; n < 2; ++n) _Pragma("unroll") for (int k = 0; k < 2; ++k) \
        acc[ai][bj][m][n] = __builtin_amdgcn_mfma_f32_16x16x32_bf16(Bt[n][k], At[m][k], acc[ai][bj][m][n], 0, 0, 0); __builtin_amdgcn_s_setprio(0); } while (0)
#define PG8_WAIT_V(n) asm volatile("s_waitcnt vmcnt(" #n ")" ::: "memory")
#define PG8_WAIT_L(n) asm volatile("s_waitcnt lgkmcnt(" #n ")" ::: "memory")
#define PG8_BAR __builtin_amdgcn_s_barrier()
#define PG8_SCHED __builtin_amdgcn_sched_barrier(0)
    Unit cur, nxt; int ui = 0;
    if (!S.next(0, cur)) return;
    f32x4 acc[2][2][4][2];
#pragma unroll
    for (int a = 0; a < 2; ++a)
#pragma unroll
        for (int b = 0; b < 2; ++b)
#pragma unroll
            for (int m = 0; m < 4; ++m)
#pragma unroll
                for (int n = 0; n < 2; ++n) acc[a][b][m][n] = (f32x4){0.f, 0.f, 0.f, 0.f};
    bf16x8 At[4][2], B0[2][2], B1[2][2];
    const char* cA = (const char*)g.A + (size_t)cur.pm * tstep; const char* cB = (const char*)g.Bt + (size_t)cur.pn * tstep;
    S.a_ready(cur);
    if constexpr (SP2) {
        PG8_STAGE(PG8_SB(0, 0), cB, voffB); PG8_STAGE(PG8_SB(0, 1), cB + hstep, voffB); PG8_STAGE(PG8_SA(0, 0), cA, voffA); PG8_STAGE(PG8_SA(0, 1), cA + hstep, voffA);
        if (wr == 1) PG8_BAR;
        PG8_WAIT_V(2); PG8_BAR;
        PG8_STAGE(PG8_SB(1, 0), cB + kstep, voffB); PG8_STAGE(PG8_SA(1, 0), cA + kstep, voffA); PG8_STAGE(PG8_SB(1, 1), cB + hstep + kstep, voffB);
        PG8_WAIT_V(6); PG8_BAR;
    } else {
        PG8_STAGE(PG8_SB(0, 0), cB, voffB); PG8_STAGE(PG8_SA(0, 0), cA, voffA); PG8_STAGE(PG8_SB(0, 1), cB + hstep, voffB); PG8_STAGE(PG8_SA(0, 1), cA + hstep, voffA);
        if (wr == 1) PG8_BAR;
        PG8_WAIT_V(4); PG8_BAR;
        PG8_STAGE(PG8_SB(1, 0), cB + kstep, voffB); PG8_STAGE(PG8_SA(1, 0), cA + kstep, voffA); PG8_STAGE(PG8_SB(1, 1), cB + hstep + kstep, voffB);
        PG8_WAIT_V(6); PG8_BAR;
    }
    for (;;) {
        const bool has_next = S.next(ui + 1, nxt);
        const char* nA = has_next ? (const char*)g.A + (size_t)nxt.pm * tstep : cA; const char* nB = has_next ? (const char*)g.Bt + (size_t)nxt.pn * tstep : cB;
        for (int t = 0; t < nt; t += 2) {
            const bool last = (t == nt - 2);
            const char* a1 = cA + (size_t)(t + 1) * kstep;
            const char* a2 = last ? nA : cA + (size_t)(t + 2) * kstep; const char* b2 = last ? nB : cB + (size_t)(t + 2) * kstep;
            const char* a3 = a2 + kstep; const char* b3 = b2 + kstep;
            if (last && has_next) S.a_ready(nxt);
            if constexpr (SP2) {
            PG8_LDB(B0, 0, 0); PG8_LDB(B1, 0, 1); PG8_SCHED; PG8_LDA(At, 0, 0); PG8_STAGE(PG8_SA(1, 1), a1 + hstep, voffA);
            PG8_WAIT_V(8); PG8_WAIT_L(0); PG8_BAR; PG8_MMA(0, 0, At, B0); PG8_MMA(0, 1, At, B1); PG8_BAR; PG8_SCHED;
            PG8_LDA(At, 0, 1); PG8_STAGE(PG8_SB(0, 0), b2, voffB); PG8_STAGE(PG8_SB(0, 1), b2 + hstep, voffB); PG8_STAGE(PG8_SA(0, 0), a2, voffA);
            PG8_WAIT_V(8); PG8_WAIT_L(0); PG8_BAR; PG8_MMA(1, 0, At, B0); PG8_MMA(1, 1, At, B1); PG8_BAR; PG8_SCHED;
            PG8_LDB(B0, 1, 0); PG8_LDB(B1, 1, 1); PG8_SCHED; PG8_LDA(At, 1, 0); PG8_STAGE(PG8_SA(0, 1), a2 + hstep, voffA);
            PG8_WAIT_V(8); PG8_WAIT_L(0); PG8_BAR; PG8_MMA(0, 0, At, B0); PG8_MMA(0, 1, At, B1); PG8_BAR; PG8_SCHED;
            PG8_LDA(At, 1, 1); PG8_STAGE(PG8_SB(1, 0), b3, voffB); PG8_STAGE(PG8_SB(1, 1), b3 + hstep, voffB); PG8_STAGE(PG8_SA(1, 0), a3, voffA);
            PG8_WAIT_V(8); PG8_WAIT_L(0); PG8_BAR; PG8_MMA(1, 0, At, B0); PG8_MMA(1, 1, At, B1); PG8_BAR; PG8_SCHED;
            } else {
            PG8_LDB(B0, 0, 0); PG8_SCHED; PG8_LDA(At, 0, 0); PG8_STAGE(PG8_SA(1, 1), a1 + hstep, voffA);
            PG8_WAIT_L(8); PG8_BAR; PG8_WAIT_L(0); PG8_MMA(0, 0, At, B0); PG8_BAR; PG8_SCHED;
            PG8_LDB(B1, 0, 1); PG8_STAGE(PG8_SB(0, 0), b2, voffB);
            PG8_BAR; PG8_WAIT_L(0); PG8_MMA(0, 1, At, B1); PG8_BAR;
            PG8_LDA(At, 0, 1); PG8_STAGE(PG8_SA(0, 0), a2, voffA);
            PG8_BAR; PG8_WAIT_L(0); PG8_MMA(1, 0, At, B0); PG8_BAR; PG8_SCHED;
            PG8_STAGE(PG8_SB(0, 1), b2 + hstep, voffB);
            PG8_WAIT_V(6); PG8_BAR; PG8_MMA(1, 1, At, B1); PG8_BAR;
            PG8_LDB(B0, 1, 0); PG8_SCHED; PG8_LDA(At, 1, 0); PG8_STAGE(PG8_SA(0, 1), a2 + hstep, voffA);
            PG8_WAIT_L(8); PG8_BAR; PG8_WAIT_L(0); PG8_MMA(0, 0, At, B0); PG8_BAR; PG8_SCHED;
            PG8_LDB(B1, 1, 1); PG8_STAGE(PG8_SB(1, 0), b3, voffB);
            PG8_BAR; PG8_WAIT_L(0); PG8_MMA(0, 1, At, B1); PG8_BAR;
            PG8_LDA(At, 1, 1); PG8_STAGE(PG8_SA(1, 0), a3, voffA);
            PG8_BAR; PG8_WAIT_L(0); PG8_MMA(1, 0, At, B0); PG8_BAR; PG8_SCHED;
            PG8_STAGE(PG8_SB(1, 1), b3 + hstep, voffB);
            PG8_WAIT_V(6); PG8_BAR; PG8_MMA(1, 1, At, B1); PG8_BAR;
            }
        }
        if constexpr (ALIGN_EPI) { if (wr == 0) PG8_BAR; }
        if constexpr (!Epi::AFTER_DRAIN) { E(acc, cur, wr, wc, fr, fq); S.done(cur); }
        if (!has_next) break;
#pragma unroll
        for (int a = 0; a < 2; ++a)
#pragma unroll
            for (int b = 0; b < 2; ++b)
#pragma unroll
                for (int m = 0; m < 4; ++m)
#pragma unroll
                    for (int n = 0; n < 2; ++n) acc[a][b][m][n] = (f32x4){0.f, 0.f, 0.f, 0.f};
        cur = nxt; cA = nA; cB = nB; ++ui;
        if constexpr (ALIGN_EPI) { if (wr == 1) PG8_BAR; }
    }
    PG8_WAIT_V(0);
    if constexpr (!ALIGN_EPI) { if (wr == 0) PG8_BAR; }
    PG8_BAR;
    if constexpr (Epi::AFTER_DRAIN) { E.fused(acc, cur, wr, wc, fr, fq, lds, wid, lane); S.done(cur); }
#undef PG8_SA
#undef PG8_SB
#undef PG8_STAGE
#undef PG8_LDA
#undef PG8_LDB
#undef PG8_MMA
#undef PG8_WAIT_V
#undef PG8_WAIT_L
#undef PG8_BAR
#undef PG8_SCHED
}
}

typedef unsigned short bf16;
typedef short bf16x8 __attribute__((ext_vector_type(8)));
typedef float f32x4 __attribute__((ext_vector_type(4)));
typedef unsigned u32x4 __attribute__((ext_vector_type(4)));
typedef unsigned u32x2 __attribute__((ext_vector_type(2)));
#define LAS __attribute__((address_space(3)))
#define LAUNDER(p) asm volatile("" : "+s"(p))

constexpr int D = 1024, T = 4096, NB = 8, TS = 16, PAST = 1024, FF = 2816, RW = 896;
constexpr int MP = NB * T, MS = NB * TS, MR = MP + MS, M = 33024;
constexpr int NU = 2816;
constexpr int UQ = 0, UK = 256, UV = 512, UPOOL = 768, UCB = 1024, UCC = 1280, UCX = 1536, URW = 1792;
constexpr float RMS_EPS = 1e-6f, GN_EPS = 64e-5f;
constexpr int VTP = T + 64;
constexpr int SKEYS = PAST + TS, SKP = 1088;

constexpr size_t O_X = 0, O_PK = 33685504, O_PV = 50462720, O_PWKV = 67239936, O_PSHIFT = 67502080, O_PCONV = 67516416, O_PPOOL = 67524608,
                 O_SK = 67586048, O_SV = 67651584, O_SWKV = 67717120, O_SSHIFT = 67979264, O_SCONV = 67993600, O_SPOOL = 68001792, O_END = 68063232;
constexpr size_t LW = 21233664;
constexpr size_t W_GUA = 0, W_DA = 5767168, W_IN = 8650752, W_OUT = 11534336, W_GUB = 12582912, W_DB = 18350080;
constexpr size_t WS_W = 0, WS_H = 84934656, WS_U = 152567808, WS_Y = 338558976;
constexpr size_t WS_SIN = WS_Y, WS_G = 456458240, WS_RK = 473300992, WS_YS = 473827328, WS_SKV = 507512832, WS_VT = 511772672, WS_SVT = 528812032, WS_CTL = 533268480, WS_END = 533268480 + 16384;
constexpr size_t SKV_ELEMS = (size_t)NB * SKEYS * 256;
constexpr int REC = 896;
static_assert(WS_Y + (size_t)M * D * 4 <= WS_END && WS_SIN + (size_t)MR * 4 * REC == WS_G && WS_G + (size_t)MR * 512 == WS_RK && WS_RK + (size_t)MR * 16 == WS_YS && WS_YS + (size_t)MR * 1024 == WS_SKV && WS_SKV + SKV_ELEMS * 2 == WS_VT && WS_VT + (size_t)32 * 64 * VTP * 2 == WS_SVT && WS_SVT + (size_t)32 * 64 * SKP * 2 == WS_CTL && WS_END <= 536870912, "ws map");
static_assert(WS_U + (size_t)M * NU * 2 == WS_Y && WS_H + (size_t)M * D * 2 == WS_U && 2 * LW * 2 == WS_H, "ws map 2");

constexpr int LDS_BYTES = 147456;
constexpr int NTHR = 512, NWAVES = 8;

constexpr int PH_PRE = 0, PH_PER_LAYER = 12, NPH = 1 + 2 * PH_PER_LAYER;
enum { P_A1 = 0, P_A2, P_A3, P_B1, P_C1, P_C2, P_C3, P_D1, P_D2, P_E1, P_E2, P_E3 };

struct Args { const float* in[28]; float* out; unsigned char* ws; int ph_lo, ph_hi; };
enum { I_XP = 0, I_XS, I_CK, I_CV, I_SWKV, I_SSHIFT, I_SCONV, I_SPOOL, I_NG, I_WG, I_WU, I_WD, I_WIN, I_WOUT, I_POOLW, I_POOLS, I_MU, I_W0, I_W2, I_A0, I_A2, I_G2, I_KK, I_KA, I_RK, I_LNW, I_LNB, I_CONVW };
typedef const __attribute__((address_space(4))) Args* KArgP;
__device__ __forceinline__ KArgP kargs() { KArgP p = (KArgP)__builtin_amdgcn_kernarg_segment_ptr(); asm volatile("" : "+s"(p)); return p; }

__device__ __forceinline__ unsigned f2bf(float f) { return (unsigned)__builtin_bit_cast(unsigned short, (__bf16)f); }
typedef float f32x2_t __attribute__((ext_vector_type(2))); typedef __bf16 bf16x2_t __attribute__((ext_vector_type(2)));
__device__ __forceinline__ unsigned pk2(float lo, float hi) { f32x2_t v = {lo, hi}; bf16x2_t b = __builtin_convertvector(v, bf16x2_t); return __builtin_bit_cast(unsigned, b); }
__device__ __forceinline__ float bf2f(unsigned h) { return __builtin_bit_cast(float, h << 16); }
__device__ __forceinline__ float bflo(unsigned w) { return __builtin_bit_cast(float, w << 16); }
__device__ __forceinline__ float bfhi(unsigned w) { return __builtin_bit_cast(float, w & 0xffff0000u); }
__device__ __forceinline__ float ldbf(const bf16* p) { return bf2f((unsigned)*p); }
template <int CTRL> __device__ __forceinline__ float dppf(float x) { return __builtin_bit_cast(float, __builtin_amdgcn_update_dpp(0, __builtin_bit_cast(int, x), CTRL, 0xF, 0xF, true)); }
__device__ __forceinline__ float red16(float x) {
    x += dppf<0xB1>(x);
    x += dppf<0x4E>(x);
    x += dppf<0x141>(x);
    x += dppf<0x140>(x);
    return x;
}
__device__ __forceinline__ float wave_sum(float v) {
    v = red16(v);
    const int iv = __builtin_bit_cast(int, v);
    return (__builtin_bit_cast(float, __builtin_amdgcn_readlane(iv, 0)) + __builtin_bit_cast(float, __builtin_amdgcn_readlane(iv, 16))) +
           (__builtin_bit_cast(float, __builtin_amdgcn_readlane(iv, 32)) + __builtin_bit_cast(float, __builtin_amdgcn_readlane(iv, 48)));
}
__device__ __forceinline__ void red16_2(float& a, float& b) {
    a += dppf<0xB1>(a); b += dppf<0xB1>(b);
    a += dppf<0x4E>(a); b += dppf<0x4E>(b);
    a += dppf<0x141>(a); b += dppf<0x141>(b);
    a += dppf<0x140>(a); b += dppf<0x140>(b);
}
typedef float f32x2v __attribute__((ext_vector_type(2)));
typedef __bf16 bf2_t __attribute__((ext_vector_type(2)));
__device__ __forceinline__ float dot2bf(unsigned a, unsigned b, float c) { return __builtin_amdgcn_fdot2_f32_bf16(__builtin_bit_cast(bf2_t, a), __builtin_bit_cast(bf2_t, b), c, false); }
__device__ __forceinline__ float sigmoid_f(float x) { return __builtin_amdgcn_rcpf(1.0f + __expf(-x)); }
__device__ __forceinline__ float tanh_f(float x) { return 2.0f * sigmoid_f(2.0f * x) - 1.0f; }
__device__ __forceinline__ float softplus_f(float x) { return fmaxf(x, 0.f) + __logf(1.0f + __expf(-fabsf(x))); }

__device__ __forceinline__ void transpose_item(const float* __restrict__ W, int K, int N, bf16* WT, int dst_row0, float* scr, int kb, int n0, int lane) {
    const int k0 = 64 * kb;
    float wv[32];
#pragma unroll
    for (int i = 0; i < 32; ++i) wv[i] = W[(size_t)(k0 + 2 * i + (lane >> 5)) * N + n0 + (lane & 31)];
#pragma unroll
    for (int i = 0; i < 32; ++i) scr[(2 * i + (lane >> 5)) * 33 + (lane & 31)] = wv[i];
    asm volatile("s_waitcnt lgkmcnt(0)" ::: "memory");
    const int c = lane & 7;
#pragma unroll
    for (int j = 0; j < 4; ++j) { const int n = (lane >> 3) + 8 * j; const float* s = scr + (8 * c) * 33 + n;
        u32x4 o; o.x = pk2(s[0 * 33], s[1 * 33]); o.y = pk2(s[2 * 33], s[3 * 33]); o.z = pk2(s[4 * 33], s[5 * 33]); o.w = pk2(s[6 * 33], s[7 * 33]);
        *(u32x4*)(WT + (size_t)(dst_row0 + n) * K + k0 + 8 * c) = o; }
    asm volatile("s_waitcnt lgkmcnt(0)" ::: "memory");
}
__device__ __forceinline__ int win_rowmap(int n0) { return n0 < 256 ? UPOOL + n0 : (n0 < 1152 ? URW + (n0 - 256) : (n0 < 1920 ? UCB + (n0 - 1152) : n0 - 1920)); }

__device__ __forceinline__ void norm_row_to_bf16(const float* xrow, const float* g, bf16* hrow, int lane) {
    f32x4 v[4]; float s = 0.f;
#pragma unroll
    for (int j = 0; j < 4; ++j) { v[j] = *((const f32x4*)xrow + lane + 64 * j); s += (v[j].x * v[j].x + v[j].y * v[j].y) + (v[j].z * v[j].z + v[j].w * v[j].w); }
    const float rstd = rsqrtf(wave_sum(s) * (1.f / D) + RMS_EPS);
#pragma unroll
    for (int j = 0; j < 4; ++j) { const f32x4 gg = *((const f32x4*)g + lane + 64 * j); u32x2 o; o.x = pk2(v[j].x * rstd * gg.x, v[j].y * rstd * gg.y); o.y = pk2(v[j].z * rstd * gg.z, v[j].w * rstd * gg.w);
        *((u32x2*)hrow + lane + 64 * j) = o; }
}

__device__ __forceinline__ void phase_pre(const Args& a, unsigned char* lds) {
    KArgP ap = kargs(); unsigned char* ws_l = ap->ws; float* out_l = ap->out; (void)ws_l; (void)out_l;
    const float* in_I_NG = ap->in[I_NG];
    const float* in_I_WD = ap->in[I_WD];
    const float* in_I_WG = ap->in[I_WG];
    const float* in_I_WIN = ap->in[I_WIN];
    const float* in_I_WOUT = ap->in[I_WOUT];
    const float* in_I_WU = ap->in[I_WU];
    const float* in_I_XP = ap->in[I_XP];
    const float* in_I_XS = ap->in[I_XS];
    const int tid = ltid(), lane = tid & 63, wave = tid >> 6, G = gridDim.x;
    const int gw = blockIdx.x * NWAVES + wave, NGW = G * NWAVES;
    float* scr = (float*)(lds + wave * 16384);
    bf16* Wb = (bf16*)(ws_l + WS_W);
    constexpr int IT_L = 10304;
    for (int it = gw; it < 2 * IT_L; it += NGW) {
        const int l = it / IT_L; int r = it % IT_L; bf16* WL = Wb + (size_t)l * LW;
        const float* src; int K, N; bf16* dst; int mode;
        if (r < 1408)      { src = in_I_WG + (size_t)(l * 2 + 0) * D * FF; K = D; N = FF; dst = WL + W_GUA; mode = 1; }
        else if ((r -= 1408) < 1408) { src = in_I_WU + (size_t)(l * 2 + 0) * D * FF; K = D; N = FF; dst = WL + W_GUA; mode = 2; }
        else if ((r -= 1408) < 1408) { src = in_I_WD + (size_t)(l * 2 + 0) * FF * D; K = FF; N = D; dst = WL + W_DA; mode = 0; }
        else if ((r -= 1408) < 1344) { src = in_I_WIN + (size_t)l * D * 2688; K = D; N = 2688; dst = WL + W_IN; mode = 3; }
        else if ((r -= 1344) < 512)  { src = in_I_WOUT + (size_t)l * D * D; K = D; N = D; dst = WL + W_OUT; mode = 0; }
        else if ((r -= 512) < 1408)  { src = in_I_WG + (size_t)(l * 2 + 1) * D * FF; K = D; N = FF; dst = WL + W_GUB; mode = 1; }
        else if ((r -= 1408) < 1408) { src = in_I_WU + (size_t)(l * 2 + 1) * D * FF; K = D; N = FF; dst = WL + W_GUB; mode = 2; }
        else { r -= 1408;            src = in_I_WD + (size_t)(l * 2 + 1) * FF * D; K = FF; N = D; dst = WL + W_DB; mode = 0; }
        const int nblk = N / 32, kb = r / nblk, n0 = 32 * (r % nblk);
        int dr = n0;
        if (mode == 1) dr = 256 * (n0 >> 7) + (n0 & 127); else if (mode == 2) dr = 256 * (n0 >> 7) + 128 + (n0 & 127); else if (mode == 3) dr = win_rowmap(n0);
        transpose_item(src, K, N, dst, dr, scr, kb, n0, lane);
    }
    const int gt = blockIdx.x * NTHR + tid, NGT = G * NTHR;
    for (int i = gt; i < 2 * 16384 + 16384; i += NGT) {
        u32x4 z = {0u, 0u, 0u, 0u};
        if (i < 32768) { const int l = i >> 14, o = i & 16383; *((u32x4*)(Wb + (size_t)l * LW + W_IN + (size_t)2688 * D) + o) = z; }
        else { *((u32x4*)((bf16*)(ws_l + WS_H) + (size_t)MR * D) + (i - 32768)) = z; }
    }
    bf16* H = (bf16*)(ws_l + WS_H);
    for (int m = gw; m < MR; m += NGW) {
        const float* xr = m < MP ? in_I_XP + (size_t)m * D : in_I_XS + (size_t)(m - MP) * D;
        norm_row_to_bf16(xr, in_I_NG, H + (size_t)m * D, lane);
    }
}

template <bool SRC_F32, bool DST_F32, bool HAS_H>
__device__ __forceinline__ void phase_rowpass(const void* xp, const void* xs, const bf16* Y, float coef, const float* gpost, const float* gpre, void* xdst, bf16* H) {
    const int tid = ltid(), lane = tid & 63, wave = tid >> 6;
    const int gw = blockIdx.x * NWAVES + wave, NGW = gridDim.x * NWAVES;
    f32x4 y[4], x[4], nxf[4]; u32x2 ny[4], nxb[4];
#define RP_LOAD(m_) do { const bf16* yr_ = Y + (size_t)(m_) * D; \
        _Pragma("unroll") for (int j = 0; j < 4; ++j) ny[j] = *((const u32x2*)yr_ + lane + 64 * j); \
        if (SRC_F32) { const float* xr_ = (m_) < MP ? (const float*)xp + (size_t)(m_) * D : (const float*)xs + (size_t)((m_) - MP) * D; \
            _Pragma("unroll") for (int j = 0; j < 4; ++j) nxf[j] = *((const f32x4*)xr_ + lane + 64 * j); } \
        else { const bf16* xr_ = (const bf16*)xp + (size_t)(m_) * D; \
            _Pragma("unroll") for (int j = 0; j < 4; ++j) nxb[j] = *((const u32x2*)xr_ + lane + 64 * j); } } while (0)
    if (gw < MR) RP_LOAD(gw);
    for (int m = gw; m < MR; m += NGW) {
#pragma unroll
        for (int j = 0; j < 4; ++j) { y[j] = (f32x4){bflo(ny[j].x), bfhi(ny[j].x), bflo(ny[j].y), bfhi(ny[j].y)};
            x[j] = SRC_F32 ? nxf[j] : (f32x4){bflo(nxb[j].x), bfhi(nxb[j].x), bflo(nxb[j].y), bfhi(nxb[j].y)}; }
        if (m + NGW < MR) RP_LOAD(m + NGW);
        float s = 0.f;
#pragma unroll
        for (int j = 0; j < 4; ++j) s += (y[j].x * y[j].x + y[j].y * y[j].y) + (y[j].z * y[j].z + y[j].w * y[j].w);
        const float rstd = rsqrtf(wave_sum(s) * (1.f / D) + RMS_EPS) * coef;
        float s2 = 0.f;
#pragma unroll
        for (int j = 0; j < 4; ++j) { const f32x4 gg = *((const f32x4*)gpost + lane + 64 * j);
            x[j].x += y[j].x * rstd * gg.x; x[j].y += y[j].y * rstd * gg.y; x[j].z += y[j].z * rstd * gg.z; x[j].w += y[j].w * rstd * gg.w;
            s2 += (x[j].x * x[j].x + x[j].y * x[j].y) + (x[j].z * x[j].z + x[j].w * x[j].w);
            if (DST_F32) *((f32x4*)((float*)xdst + (size_t)m * D) + lane + 64 * j) = x[j];
            else { u32x2 o; o.x = pk2(x[j].x, x[j].y); o.y = pk2(x[j].z, x[j].w); *((u32x2*)((bf16*)xdst + (size_t)m * D) + lane + 64 * j) = o; } }
        if (HAS_H) {
            const float r2 = rsqrtf(wave_sum(s2) * (1.f / D) + RMS_EPS);
#pragma unroll
            for (int j = 0; j < 4; ++j) { const f32x4 gg = *((const f32x4*)gpre + lane + 64 * j); u32x2 o; o.x = pk2(x[j].x * r2 * gg.x, x[j].y * r2 * gg.y); o.y = pk2(x[j].z * r2 * gg.z, x[j].w * r2 * gg.w);
                *((u32x2*)(H + (size_t)m * D) + lane + 64 * j) = o; }
        }
    }
#undef RP_LOAD
}

__device__ __forceinline__ void ld8(const bf16* p, float (&f)[8]) {
    const u32x4 w = *(const u32x4*)p;
    f[0] = bflo(w.x); f[1] = bfhi(w.x); f[2] = bflo(w.y); f[3] = bfhi(w.y); f[4] = bflo(w.z); f[5] = bfhi(w.z); f[6] = bflo(w.w); f[7] = bfhi(w.w);
}
__device__ __forceinline__ void conv_part(const Args& a, int l, int bid, int nblk) {
    const int tid = ltid();
    KArgP ap = kargs(); unsigned char* ws_l = ap->ws; float* out_l = ap->out; (void)ws_l; (void)out_l;
    const float* in_I_CONVW = ap->in[I_CONVW];
    const float* in_I_SCONV = ap->in[I_SCONV];
    const bf16* U = (const bf16*)(ws_l + WS_U); bf16* YC = (bf16*)(ws_l + WS_H);
    const float* cw = in_I_CONVW + (size_t)l * 3 * 256;
    const int gt = bid * NTHR + tid, NGT = nblk * NTHR;
    for (int it = gt; it < MR * 32; it += NGT) {
        const int row = it >> 5, c8 = (it & 31) * 8;
        int b, t, Tn; const float* prefix; float* sout;
        if (row < MP) { b = row >> 12; t = row & 4095; Tn = T; prefix = nullptr; sout = out_l + O_PCONV + (size_t)(l * NB + b) * 2 * 256; }
        else { const int rr = row - MP; b = rr >> 4; t = rr & 15; Tn = TS; prefix = in_I_SCONV + (size_t)(l * NB + b) * 2 * 256; sout = out_l + O_SCONV + (size_t)(l * NB + b) * 2 * 256; }
        const bf16* ur = U + (size_t)row * NU;
        float bg[8], z0[8], z1[8], z2[8], cc[8], xx[8];
        ld8(ur + UCB + c8, bg); ld8(ur + UCC + c8, cc); ld8(ur + UCX + c8, xx);
#pragma unroll
        for (int i = 0; i < 8; ++i) z2[i] = cc[i] * xx[i];
        if (t >= 1) { ld8(ur - NU + UCC + c8, cc); ld8(ur - NU + UCX + c8, xx);
#pragma unroll
            for (int i = 0; i < 8; ++i) z1[i] = cc[i] * xx[i]; }
        else {
#pragma unroll
            for (int i = 0; i < 8; ++i) z1[i] = prefix ? prefix[256 + c8 + i] : 0.f; }
        if (t >= 2) { ld8(ur - 2 * NU + UCC + c8, cc); ld8(ur - 2 * NU + UCX + c8, xx);
#pragma unroll
            for (int i = 0; i < 8; ++i) z0[i] = cc[i] * xx[i]; }
        else {
#pragma unroll
            for (int i = 0; i < 8; ++i) z0[i] = prefix ? prefix[(t + 0) * 256 + c8 + i] : 0.f; }
        float y[8];
#pragma unroll
        for (int i = 0; i < 8; ++i) y[i] = bg[i] * (z0[i] * cw[c8 + i] + z1[i] * cw[256 + c8 + i] + z2[i] * cw[512 + c8 + i]);
        u32x4 o; o.x = pk2(y[0], y[1]); o.y = pk2(y[2], y[3]); o.z = pk2(y[4], y[5]); o.w = pk2(y[6], y[7]);
        *(u32x4*)(YC + (size_t)row * D + 512 + c8) = o;
        if (t >= Tn - 2) { float* so = sout + (size_t)(t - (Tn - 2)) * 256 + c8;
            *(f32x4*)so = (f32x4){z2[0], z2[1], z2[2], z2[3]}; *(f32x4*)(so + 4) = (f32x4){z2[4], z2[5], z2[6], z2[7]}; }
    }
}

template <int W>
__device__ __forceinline__ void pool_window(const float (&vals)[31], int pos0, float (&d)[16]) {
#pragma unroll
    for (int i = 0; i < 16; ++i) {
        float s = 0.f;
#pragma unroll
        for (int k = 0; k < W; ++k) s += vals[15 + i - k];
        const int cnt = (pos0 + i + 1) < W ? (pos0 + i + 1) : W;
        d[i] = s / (float)cnt - vals[15 + i];
    }
}
__device__ __forceinline__ void pool_part(const Args& a, int l, unsigned char* lds, int bid, int nblk) {
    KArgP ap = kargs(); unsigned char* ws_l = ap->ws; float* out_l = ap->out; (void)ws_l; (void)out_l;
    const float* in_I_POOLS = ap->in[I_POOLS];
    const float* in_I_POOLW = ap->in[I_POOLW];
    const float* in_I_SPOOL = ap->in[I_SPOOL];
    const bf16* U = (const bf16*)(ws_l + WS_U); bf16* YC = (bf16*)(ws_l + WS_H);
    bf16* dl = (bf16*)lds;
    const int tid = ltid(), c = tid & 255, th = tid >> 8, gi = c >> 6;
    const float* pw = in_I_POOLW + (size_t)(l * 4 + gi) * 64 * 64 + (c & 63);
    const float scale = in_I_POOLS[l * 256 + c];
    for (int item = bid; item < MR / 32; item += nblk) {
        const int row0 = item * 32 + th * 16;
        int b, t0, pos0, Tn; const float* prefix; float* sout;
        if (row0 < MP) { b = row0 >> 12; t0 = row0 & 4095; pos0 = t0; Tn = T; prefix = nullptr; sout = out_l + O_PPOOL + (size_t)(l * NB + b) * 15 * 256; }
        else { const int rr = row0 - MP; b = rr >> 4; t0 = 0; pos0 = PAST; Tn = TS; prefix = in_I_SPOOL + (size_t)(l * NB + b) * 15 * 256; sout = out_l + O_SPOOL + (size_t)(l * NB + b) * 15 * 256; }
        float vals[31];
#pragma unroll
        for (int i = 0; i < 31; ++i) {
            const int tt = t0 - 15 + i;
            vals[i] = (tt >= 0) ? ldbf(U + (size_t)(row0 - 15 + i) * NU + UPOOL + c) : (prefix ? prefix[(size_t)(i + t0) * 256 + c] : 0.f);
        }
        float d[16];
        if (gi == 0) pool_window<2>(vals, pos0, d); else if (gi == 1) pool_window<4>(vals, pos0, d); else if (gi == 2) pool_window<8>(vals, pos0, d); else pool_window<16>(vals, pos0, d);
#pragma unroll
        for (int i = 0; i < 16; ++i) {
            dl[(th * 16 + i) * 256 + c] = (bf16)f2bf(d[i]);
            const int t = t0 + i; if (t >= Tn - 15) sout[(size_t)(t - (Tn - 15)) * 256 + c] = vals[15 + i];
        }
        __syncthreads();
        float acc[16];
#pragma unroll
        for (int i = 0; i < 16; ++i) acc[i] = 0.f;
        for (int j8 = 0; j8 < 8; ++j8) {
            const unsigned w01 = pk2(pw[(8 * j8 + 0) * 64], pw[(8 * j8 + 1) * 64]), w23 = pk2(pw[(8 * j8 + 2) * 64], pw[(8 * j8 + 3) * 64]);
            const unsigned w45 = pk2(pw[(8 * j8 + 4) * 64], pw[(8 * j8 + 5) * 64]), w67 = pk2(pw[(8 * j8 + 6) * 64], pw[(8 * j8 + 7) * 64]);
#pragma unroll
            for (int i = 0; i < 16; ++i) { const u32x4 dv = *(const u32x4*)(dl + (th * 16 + i) * 256 + gi * 64 + 8 * j8);
                acc[i] = dot2bf(dv.w, w67, dot2bf(dv.z, w45, dot2bf(dv.y, w23, dot2bf(dv.x, w01, acc[i])))); }
        }
#pragma unroll
        for (int i = 0; i < 16; ++i) YC[(size_t)(row0 + i) * D + c] = (bf16)f2bf(acc[i] * scale);
        __syncthreads();
    }
}

__device__ __forceinline__ size_t rec_index(int row, int h) {
    if (row < MP) { const int b = row >> 12, t = row & 4095; return ((size_t)b * T) * 4 + (size_t)h * T + t; }
    const int rr = row - MP, b = rr >> 4, t = rr & 15; return ((size_t)MP + (size_t)b * TS) * 4 + (size_t)h * TS + t;
}
__device__ __forceinline__ void rwkv_prep_part(const Args& a, int l, unsigned char* lds) {
    const int tid = ltid();
    KArgP ap = kargs(); unsigned char* ws_l = ap->ws; float* out_l = ap->out;
    const float* in_I_A0 = ap->in[I_A0]; const float* in_I_A2 = ap->in[I_A2]; const float* in_I_G2 = ap->in[I_G2]; const float* in_I_KA = ap->in[I_KA]; const float* in_I_KK = ap->in[I_KK];
    const float* in_I_MU = ap->in[I_MU]; const float* in_I_RK = ap->in[I_RK]; const float* in_I_SSHIFT = ap->in[I_SSHIFT]; const float* in_I_W0 = ap->in[I_W0]; const float* in_I_W2 = ap->in[I_W2];
    const bf16* U = (const bf16*)(ws_l + WS_U);
    unsigned char* SIN = ws_l + WS_SIN; bf16* Gb = (bf16*)(ws_l + WS_G); float* RKb = (float*)(ws_l + WS_RK);
    bf16* lrb = (bf16*)lds;
    const int lane = tid & 63, c = tid & 255, half = tid >> 8, h = c >> 6, cc = c & 63;
    const float* mu = in_I_MU + (size_t)l * RW;
    const float mur = mu[c], muk = mu[256 + c], muv = mu[512 + c];
    const float w0c = in_I_W0[l * 256 + c], a0c = in_I_A0[l * 256 + c], kkc = in_I_KK[l * 256 + c], kac = in_I_KA[l * 256 + c], rkc = in_I_RK[l * 256 + c];
    unsigned w2p[16], a2p[16], g2p[32];
#pragma unroll
    for (int i = 0; i < 16; ++i) { w2p[i] = pk2(in_I_W2[(size_t)(l * 32 + 2 * i) * 256 + c], in_I_W2[(size_t)(l * 32 + 2 * i + 1) * 256 + c]);
                                   a2p[i] = pk2(in_I_A2[(size_t)(l * 32 + 2 * i) * 256 + c], in_I_A2[(size_t)(l * 32 + 2 * i + 1) * 256 + c]); }
#pragma unroll
    for (int i = 0; i < 32; ++i) g2p[i] = pk2(in_I_G2[(size_t)(l * 64 + 2 * i) * 256 + c], in_I_G2[(size_t)(l * 64 + 2 * i + 1) * 256 + c]);
    constexpr int TPI = 16, TPH = 8;
    for (int item = blockIdx.x; item < MR / TPI; item += gridDim.x) {
        const int row0 = item * TPI;
#pragma unroll
        for (int k = 0; k < TPI / 4; ++k) {
            const int idx = tid + NTHR * k, tok = idx >> 7, col = idx & 127, row = row0 + tok;
            int t, Tn; const float* shift; float* sout;
            if (row < MP) { t = row & 4095; Tn = T; shift = nullptr; sout = out_l + O_PSHIFT + (size_t)(l * NB + (row >> 12)) * RW; }
            else { const int rr = row - MP; t = rr & 15; Tn = TS; shift = in_I_SSHIFT + (size_t)(l * NB + (rr >> 4)) * RW; sout = out_l + O_SSHIFT + (size_t)(l * NB + (rr >> 4)) * RW; }
            const float cur = ldbf(U + (size_t)row * NU + URW + 768 + col);
            const float prev = (t > 0) ? ldbf(U + (size_t)(row - 1) * NU + URW + 768 + col) : (shift ? shift[768 + col] : 0.f);
            const float xs = cur + (prev - cur) * mu[768 + col];
            lrb[tok * 128 + col] = (bf16)f2bf(col < 32 ? tanh_f(xs) : (col < 64 ? xs : sigmoid_f(xs)));
            if (t == Tn - 1) sout[768 + col] = cur;
        }
        __syncthreads();
        const int rowh = row0 + half * TPH;
        int t0, Tn; const float* shift; float* sout;
        if (rowh < MP) { t0 = rowh & 4095; Tn = T; shift = nullptr; sout = out_l + O_PSHIFT + (size_t)(l * NB + (rowh >> 12)) * RW; }
        else { const int rr = rowh - MP; t0 = rr & 15; Tn = TS; shift = in_I_SSHIFT + (size_t)(l * NB + (rr >> 4)) * RW; sout = out_l + O_SSHIFT + (size_t)(l * NB + (rr >> 4)) * RW; }
        const bf16* ur = U + (size_t)rowh * NU + URW;
        float rp, kp, vp;
        if (t0 > 0) { rp = ldbf(ur - NU + c); kp = ldbf(ur - NU + 256 + c); vp = ldbf(ur - NU + 512 + c); }
        else if (shift) { rp = shift[c]; kp = shift[256 + c]; vp = shift[512 + c]; }
        else { rp = 0.f; kp = 0.f; vp = 0.f; }
        float rua[TPH], kua[TPH], vua[TPH];
#pragma unroll
        for (int i = 0; i < TPH; ++i) { rua[i] = ldbf(ur + (size_t)i * NU + c); kua[i] = ldbf(ur + (size_t)i * NU + 256 + c); vua[i] = ldbf(ur + (size_t)i * NU + 512 + c); }
#pragma unroll
        for (int i = 0; i < TPH; ++i) {
            const int tok = half * TPH + i, row = rowh + i, t = t0 + i;
            const float ru = rua[i], ku = kua[i], vu = vua[i];
            const float r = ru + (rp - ru) * mur, k = ku + (kp - ku) * muk, v = vu + (vp - vu) * muv;
            rp = ru; kp = ku; vp = vu;
            if (t == Tn - 1) { sout[c] = ru; sout[256 + c] = ku; sout[512 + c] = vu; }
            const u32x4* lt = (const u32x4*)(lrb + tok * 128);
            float wp = w0c, ap2 = a0c, gg = 0.f;
#pragma unroll
            for (int j = 0; j < 4; ++j) { const u32x4 x = lt[j]; wp = dot2bf(x.x, w2p[4 * j], wp); wp = dot2bf(x.y, w2p[4 * j + 1], wp); wp = dot2bf(x.z, w2p[4 * j + 2], wp); wp = dot2bf(x.w, w2p[4 * j + 3], wp); }
#pragma unroll
            for (int j = 0; j < 4; ++j) { const u32x4 x = lt[4 + j]; ap2 = dot2bf(x.x, a2p[4 * j], ap2); ap2 = dot2bf(x.y, a2p[4 * j + 1], ap2); ap2 = dot2bf(x.z, a2p[4 * j + 2], ap2); ap2 = dot2bf(x.w, a2p[4 * j + 3], ap2); }
#pragma unroll
            for (int j = 0; j < 8; ++j) { const u32x4 x = lt[8 + j]; gg = dot2bf(x.x, g2p[4 * j], gg); gg = dot2bf(x.y, g2p[4 * j + 1], gg); gg = dot2bf(x.z, g2p[4 * j + 2], gg); gg = dot2bf(x.w, g2p[4 * j + 3], gg); }
            const float w = -softplus_f(-wp) - 0.5f;
            const float decay = __expf(-__expf(w));
            const float aa = sigmoid_f(ap2);
            const float kkr = k * kkc;
            const float nrm = sqrtf(wave_sum(kkr * kkr));
            const float kk = kkr / fmaxf(nrm, 1e-12f);
            const float kh = k * (1.0f + (aa - 1.0f) * kac);
            const float rks = wave_sum(r * kh * rkc);
            unsigned char* rec = SIN + rec_index(row, h) * REC;
            ((bf16*)rec)[cc] = (bf16)f2bf(r); ((bf16*)rec)[64 + cc] = (bf16)f2bf(kh); ((bf16*)rec)[128 + cc] = (bf16)f2bf(v); ((bf16*)rec)[192 + cc] = (bf16)f2bf(kk); ((bf16*)rec)[256 + cc] = (bf16)f2bf(aa);
            ((float*)(rec + 640))[cc] = decay;
            Gb[(size_t)row * 256 + c] = (bf16)f2bf(gg);
            if (lane == 0) RKb[(size_t)row * 4 + h] = rks;
        }
        __syncthreads();
    }
}
__device__ __forceinline__ void skv_part(const Args& a, int l) {
    const int tid = ltid();
    KArgP ap = kargs(); unsigned char* ws_l = ap->ws;
    const float* in_I_CK = ap->in[I_CK];
    const bf16* U = (const bf16*)(ws_l + WS_U); bf16* SK = (bf16*)(ws_l + WS_SKV);
    const int gt = blockIdx.x * NTHR + tid, NGT = gridDim.x * NTHR;
    for (int it = gt; it < NB * SKEYS * 32; it += NGT) {
        const int c8 = (it & 31) * 8, kr = it >> 5, b = kr / SKEYS, key = kr % SKEYS;
        bf16* dst = SK + ((size_t)b * SKEYS + key) * 256 + c8;
        if (key < PAST) {
            const float* src = in_I_CK + (((size_t)(l * NB + b) * PAST + key) * 256 + c8);
            const f32x4 x0 = *(const f32x4*)src, x1 = *(const f32x4*)(src + 4);
            u32x4 o; o.x = pk2(x0.x, x0.y); o.y = pk2(x0.z, x0.w); o.z = pk2(x1.x, x1.y); o.w = pk2(x1.z, x1.w);
            *(u32x4*)dst = o;
        } else {
            *(u32x4*)dst = *(const u32x4*)(U + (size_t)(MP + b * TS + (key - PAST)) * NU + UK + c8);
        }
    }
}
__device__ __forceinline__ void vt_part(const Args& a, int l) {
    const int tid = ltid();
    KArgP ap = kargs(); unsigned char* ws_l = ap->ws;
    const float* in_I_CV = ap->in[I_CV];
    const bf16* U = (const bf16*)(ws_l + WS_U); bf16* VT = (bf16*)(ws_l + WS_VT); bf16* SVT = (bf16*)(ws_l + WS_SVT);
    const int lane = tid & 63, gw = blockIdx.x * NWAVES + (tid >> 6), NGW = gridDim.x * NWAVES;
    constexpr int NPI = 32 * (T / 64), NSI = 32 * (SKP / 64);
    for (int it = gw; it < NPI + NSI; it += NGW) {
        float v[64];
        bf16* dst;
        int pitch;
        if (it < NPI) {
            const int bh = it / (T / 64), tb = it % (T / 64), b = bh >> 2, h = bh & 3, t = tb * 64 + lane;
            const bf16* src = U + (size_t)(b * T + t) * NU + UV + h * 64;
#pragma unroll
            for (int q = 0; q < 8; ++q) { float f[8]; ld8(src + 8 * q, f);
#pragma unroll
                for (int i = 0; i < 8; ++i) v[8 * q + i] = f[i]; }
            dst = VT + (size_t)bh * 64 * VTP + t; pitch = VTP;
        } else {
            const int r = it - NPI, bh = r / (SKP / 64), kb = r % (SKP / 64), b = bh >> 2, h = bh & 3, key = kb * 64 + lane;
            if (key < PAST) { const float* src = in_I_CV + (((size_t)(l * NB + b) * PAST + key) * 256 + h * 64);
#pragma unroll
                for (int q = 0; q < 16; ++q) { const f32x4 x = *(const f32x4*)(src + 4 * q); v[4 * q] = x.x; v[4 * q + 1] = x.y; v[4 * q + 2] = x.z; v[4 * q + 3] = x.w; } }
            else if (key < SKEYS) { const bf16* src = U + (size_t)(MP + b * TS + (key - PAST)) * NU + UV + h * 64;
#pragma unroll
                for (int q = 0; q < 8; ++q) { float f[8]; ld8(src + 8 * q, f);
#pragma unroll
                    for (int i = 0; i < 8; ++i) v[8 * q + i] = f[i]; } }
            else {
#pragma unroll
                for (int i = 0; i < 64; ++i) v[i] = 0.f; }
            dst = SVT + (size_t)bh * 64 * SKP + key; pitch = SKP;
        }
#pragma unroll
        for (int d = 0; d < 64; ++d) dst[(size_t)d * pitch] = (bf16)f2bf(v[d]);
    }
}

constexpr int STEP_B = 1344;
template <int CH>
__device__ __forceinline__ void scan_unit(const Args& a, int l, int unit, unsigned char* lds) {
    constexpr int NP = CH / 16, CHUNK_B = CH * STEP_B;
    struct LdSet { u32x2 r[NP], kh[NP], kk[NP], aa[NP], v[NP]; f32x4 w[NP]; };
    const int tid = ltid();
    KArgP ap = kargs(); unsigned char* ws_l = ap->ws; float* out_l = ap->out;
    const float* in_I_SWKV = ap->in[I_SWKV];
    const int lane = tid & 63, wave = tid >> 6;
    const bool sample = unit >= 128; const int bh = (unit & 127) >> 2, rg = unit & 3, b = bh >> 2, h = bh & 3;
    const int Tn = sample ? TS : T, rowbase = sample ? MP + b * TS : b * T, nch = Tn / CH;
    const unsigned char* rec0 = ws_l + WS_SIN + ((size_t)rowbase * 4 + (size_t)h * Tn) * REC;
    float* YS = (float*)(ws_l + WS_YS);
    const bool loader = wave >= 4;
    const int lt = tid - 256, lstep = lt >> 4, ljq = lt & 15;
    const int rowl = lane >> 4, jq = lane & 15, vrow = rg * 16 + wave * 4 + rowl;
    f32x2v S01 = {0.f, 0.f}, S23 = {0.f, 0.f};
    if (!loader && sample) { const f32x4 s = *(const f32x4*)(in_I_SWKV + ((size_t)((l * NB + b) * 4 + h) * 64 + vrow) * 64 + 4 * jq); S01 = s.lo; S23 = s.hi; }
#define SC_LD(set, chunk) do { if ((chunk) < nch) { _Pragma("unroll") for (int q = 0; q < NP; ++q) { const unsigned char* rp = rec0 + (size_t)((chunk) * CH + 16 * q + lstep) * REC; \
        set.r[q] = *(const u32x2*)(rp + 8 * ljq); set.kh[q] = *(const u32x2*)(rp + 128 + 8 * ljq); set.kk[q] = *(const u32x2*)(rp + 384 + 8 * ljq); set.aa[q] = *(const u32x2*)(rp + 512 + 8 * ljq); \
        set.w[q] = *(const f32x4*)(rp + 640 + 16 * ljq); set.v[q] = *(const u32x2*)(rp + 256 + 2 * (rg * 16) + 8 * (ljq & 3)); } } } while (0)
#define SC_ST(set, bufi) do { _Pragma("unroll") for (int q = 0; q < NP; ++q) { unsigned char* sp = lds + (bufi) * CHUNK_B + (16 * q + lstep) * STEP_B; \
        const f32x4 kkf = {bflo(set.kk[q].x), bfhi(set.kk[q].x), bflo(set.kk[q].y), bfhi(set.kk[q].y)}; const f32x4 af = {bflo(set.aa[q].x), bfhi(set.aa[q].x), bflo(set.aa[q].y), bfhi(set.aa[q].y)}; \
        *(f32x4*)(sp + 16 * ljq) = (f32x4){bflo(set.r[q].x), bfhi(set.r[q].x), bflo(set.r[q].y), bfhi(set.r[q].y)}; \
        *(f32x4*)(sp + 256 + 16 * ljq) = set.w[q]; \
        *(f32x4*)(sp + 512 + 16 * ljq) = (f32x4){bflo(set.kh[q].x), bfhi(set.kh[q].x), bflo(set.kh[q].y), bfhi(set.kh[q].y)}; \
        *(f32x4*)(sp + 768 + 16 * ljq) = kkf; *(f32x4*)(sp + 1024 + 16 * ljq) = kkf * af; \
        if (ljq < 4) *(f32x4*)(sp + 1280 + 16 * ljq) = (f32x4){bflo(set.v[q].x), bfhi(set.v[q].x), bflo(set.v[q].y), bfhi(set.v[q].y)}; } } while (0)
#define SC_RD(slot, s_) do { const unsigned char* sp = cp + (s_) * STEP_B; rr[slot] = *(const f32x4*)(sp + 16 * jq); ww[slot] = *(const f32x4*)(sp + 256 + 16 * jq); kh[slot] = *(const f32x4*)(sp + 512 + 16 * jq); \
        kk[slot] = *(const f32x4*)(sp + 768 + 16 * jq); ka[slot] = *(const f32x4*)(sp + 1024 + 16 * jq); vv[slot] = *(const float*)(sp + 1280 + 4 * (wave * 4 + rowl)); } while (0)
#define SC_SCAN(bufi, chunk) do { const unsigned char* cp = lds + (bufi) * CHUNK_B; float* yp = YS + (size_t)(rowbase + (chunk) * CH + jq) * 256 + h * 64 + vrow; \
        f32x4 rr[3], ww[3], kh[3], kk[3], ka[3]; float vv[3]; float ysel = 0.f; f32x4 rprev = {0.f, 0.f, 0.f, 0.f}; \
        SC_RD(0, 0); SC_RD(1, 1); \
        _Pragma("unroll") for (int s = 0; s < CH; ++s) { const int c_ = s % 3; if (s > 0) rprev = rr[(s + 2) % 3]; if (s + 2 < CH) SC_RD((s + 2) % 3, s + 2); \
            const f32x2v p2 = S01 * kk[c_].lo + S23 * kk[c_].hi; float sa = p2.x + p2.y; \
            if (s > 0) { const f32x2v q2 = S01 * rprev.lo + S23 * rprev.hi; float yq = q2.x + q2.y; red16_2(sa, yq); ysel = (((s - 1) & 15) == jq) ? yq : ysel; if (((s - 1) & 15) == 15) yp[(size_t)(s - 16) * 256] = ysel; } \
            else sa = red16(sa); \
            const f32x2v vk01 = vv[c_] * kh[c_].lo, vk23 = vv[c_] * kh[c_].hi; \
            S01 = S01 * ww[c_].lo + (vk01 - sa * ka[c_].lo); S23 = S23 * ww[c_].hi + (vk23 - sa * ka[c_].hi); } \
        { const int p_ = (CH - 1) % 3; const f32x2v q2 = S01 * rr[p_].lo + S23 * rr[p_].hi; const float yq = red16(q2.x + q2.y); ysel = (15 == jq) ? yq : ysel; yp[(size_t)(CH - 16) * 256] = ysel; } } while (0)
    if (loader) {
        __builtin_amdgcn_s_setprio(2);
        LdSet A, B;
        SC_LD(A, 0); SC_ST(A, 0); SC_LD(A, 1); SC_LD(B, 2);
        __syncthreads();
        for (int ch = 0; ch < nch; ch += 2) {
            if (ch + 1 < nch) SC_ST(A, 1);
            SC_LD(A, ch + 3);
            __syncthreads();
            if (ch + 1 < nch) { if (ch + 2 < nch) SC_ST(B, 0); SC_LD(B, ch + 4); __syncthreads(); }
        }
        __builtin_amdgcn_s_setprio(0);
    } else {
        __syncthreads();
        for (int ch = 0; ch < nch; ch += 2) {
            SC_SCAN(0, ch);
            __syncthreads();
            if (ch + 1 < nch) { SC_SCAN(1, ch + 1); __syncthreads(); }
        }
    }
#undef SC_LD
#undef SC_ST
#undef SC_RD
#undef SC_SCAN
    if (!loader) {
        float* so = out_l + (sample ? O_SWKV : O_PWKV) + ((size_t)((l * NB + b) * 4 + h) * 64 + vrow) * 64 + 4 * jq;
        *(f32x4*)so = (f32x4){S01.x, S01.y, S23.x, S23.y};
    }
}

__device__ __forceinline__ f32x4 mfma16(bf16x8 A, bf16x8 B, f32x4 C) { return __builtin_amdgcn_mfma_f32_16x16x32_bf16(A, B, C, 0, 0, 0); }
__device__ __forceinline__ bf16x8 pack8(const f32x4 lo, const f32x4 hi) {
    u32x4 w; w.x = pk2(lo.x, lo.y); w.y = pk2(lo.z, lo.w); w.z = pk2(hi.x, hi.y); w.w = pk2(hi.z, hi.w); return __builtin_bit_cast(bf16x8, w);
}
__device__ __forceinline__ void attn_unit(const bf16* Q, int qp, const bf16* K, int kp, const bf16* VT, int vp, int qpos0, int kmax, bf16* O, int op, int lane) {
    const int fr = lane & 15, g = lane >> 4;
    bf16x8 qf[2];
#pragma unroll
    for (int ds = 0; ds < 2; ++ds) qf[ds] = *(const bf16x8*)(Q + (size_t)fr * qp + 32 * ds + 8 * g);
    f32x4 o[4];
#pragma unroll
    for (int i = 0; i < 4; ++i) o[i] = (f32x4){0.f, 0.f, 0.f, 0.f};
    float R = 0.f;
    const int qpos = qpos0 + fr;
    u32x4 onesw = {0x3F803F80u, 0x3F803F80u, 0x3F803F80u, 0x3F803F80u};
    const bf16x8 ones = __builtin_bit_cast(bf16x8, onesw);
    bf16x8 kf[4][2];
#define AT_LDK(kt_) do { _Pragma("unroll") for (int kb = 0; kb < 4; ++kb) { int kr = (kt_) * 64 + 16 * kb + fr; kr = kr > kmax ? kmax : kr; const bf16* krow = K + (size_t)kr * kp + 8 * g; \
        kf[kb][0] = *(const bf16x8*)krow; kf[kb][1] = *(const bf16x8*)(krow + 32); } } while (0)
    AT_LDK((qpos0 + 14) >> 6);
    for (int kt = (qpos0 + 14) >> 6; kt >= 0; --kt) {
        const int key0 = kt * 64;
        u32x2 vf[2][4][2];
#pragma unroll
        for (int ks = 0; ks < 2; ++ks)
#pragma unroll
            for (int db = 0; db < 4; ++db) { const bf16* vrow = VT + (size_t)(16 * db + fr) * vp + key0 + 32 * ks + 4 * g; vf[ks][db][0] = *(const u32x2*)vrow; vf[ks][db][1] = *(const u32x2*)(vrow + 16); }
        f32x4 z[4];
#pragma unroll
        for (int kb = 0; kb < 4; ++kb) {
            f32x4 acc = {0.f, 0.f, 0.f, 0.f};
            acc = mfma16(kf[kb][0], qf[0], acc);
            acc = mfma16(kf[kb][1], qf[1], acc);
            z[kb] = acc;
        }
        if (kt > 0) AT_LDK(kt - 1);
        f32x4 lk[4], ls[4]; bool vis[4][4];
#pragma unroll
        for (int kb = 0; kb < 4; ++kb)
#pragma unroll
            for (int r = 0; r < 4; ++r) {
                const int key = key0 + 16 * kb + 4 * g + r;
                const float zz = z[kb][r] * 0.125f, sp = softplus_f(zz);
                vis[kb][r] = key < qpos;
                lk[kb][r] = vis[kb][r] ? -sp : 0.f;
                ls[kb][r] = zz - sp;
            }
        bf16x8 Bhi[2], Blo[2];
#pragma unroll
        for (int ks = 0; ks < 2; ++ks) {
            u32x4 hw, lw;
            { const f32x4 x = lk[2 * ks]; const unsigned h01 = pk2(x.x, x.y), h23 = pk2(x.z, x.w); hw.x = h01; hw.y = h23; lw.x = pk2(x.x - bflo(h01), x.y - bfhi(h01)); lw.y = pk2(x.z - bflo(h23), x.w - bfhi(h23)); }
            { const f32x4 x = lk[2 * ks + 1]; const unsigned h01 = pk2(x.x, x.y), h23 = pk2(x.z, x.w); hw.z = h01; hw.w = h23; lw.z = pk2(x.x - bflo(h01), x.y - bfhi(h01)); lw.w = pk2(x.z - bflo(h23), x.w - bfhi(h23)); }
            Bhi[ks] = __builtin_bit_cast(bf16x8, hw); Blo[ks] = __builtin_bit_cast(bf16x8, lw);
        }
        f32x4 tot = {0.f, 0.f, 0.f, 0.f};
#pragma unroll
        for (int ks = 0; ks < 2; ++ks) { tot = mfma16(ones, Bhi[ks], tot); tot = mfma16(ones, Blo[ks], tot); }
        f32x4 p[4];
#pragma unroll
        for (int kb = 0; kb < 4; ++kb) {
            f32x4 la = {0.f, 0.f, 0.f, 0.f};
            const int s = 16 * kb + fr;
#pragma unroll
            for (int ks = 0; ks < 2; ++ks) {
                if (32 * ks + 31 > 16 * kb) {
                    u32x4 tw;
                    unsigned e[8];
#pragma unroll
                    for (int j = 0; j < 8; ++j) { const int jp = 32 * ks + 16 * (j >> 2) + 4 * g + (j & 3); e[j] = jp > s ? 0x3F80u : 0u; }
                    tw.x = e[0] | (e[1] << 16); tw.y = e[2] | (e[3] << 16); tw.z = e[4] | (e[5] << 16); tw.w = e[6] | (e[7] << 16);
                    const bf16x8 tri = __builtin_bit_cast(bf16x8, tw);
                    la = mfma16(tri, Bhi[ks], la); la = mfma16(tri, Blo[ks], la);
                }
            }
#pragma unroll
            for (int r = 0; r < 4; ++r) p[kb][r] = vis[kb][r] ? __expf(ls[kb][r] + la[r] + R) : 0.f;
        }
        R += tot[0];
#pragma unroll
        for (int ks = 0; ks < 2; ++ks) {
            const bf16x8 pf = pack8(p[2 * ks], p[2 * ks + 1]);
#pragma unroll
            for (int db = 0; db < 4; ++db) {
                u32x4 vw; vw.x = vf[ks][db][0].x; vw.y = vf[ks][db][0].y; vw.z = vf[ks][db][1].x; vw.w = vf[ks][db][1].y;
                o[db] = mfma16(__builtin_bit_cast(bf16x8, vw), pf, o[db]);
            }
        }
        if (__all(R < -110.f)) break;
    }
#undef AT_LDK
#pragma unroll
    for (int db = 0; db < 4; ++db) { u32x2 w; w.x = pk2(o[db][0], o[db][1]); w.y = pk2(o[db][2], o[db][3]); *(u32x2*)(O + (size_t)fr * op + 16 * db + 4 * g) = w; }
}
__device__ __forceinline__ void attn_part(const Args& a, int l, int aw, int naw) {
    const int tid = ltid();
    KArgP ap = kargs(); unsigned char* ws_l = ap->ws; float* out_l = ap->out; (void)ws_l; (void)out_l;
    const bf16* U = (const bf16*)(ws_l + WS_U); bf16* YC = (bf16*)(ws_l + WS_H);
    const bf16* SK = (const bf16*)(ws_l + WS_SKV); const bf16* VT = (const bf16*)(ws_l + WS_VT); const bf16* SVT = (const bf16*)(ws_l + WS_SVT);
    const int lane = tid & 63;
    constexpr int NPU = NB * 4 * (T / 16);
    for (int v = aw; v < NPU; v += naw) {
        const int qb = v & 255, bh = v >> 8, b = bh >> 2, h = bh & 3; const int row0 = b * T + qb * 16;
        attn_unit(U + (size_t)row0 * NU + UQ + h * 64, NU, U + (size_t)(b * T) * NU + UK + h * 64, NU, VT + (size_t)bh * 64 * VTP, VTP, qb * 16, T - 1, YC + (size_t)row0 * D + 768 + h * 64, D, lane);
    }
    if (naw == 1024) {
        if ((aw & 255) < 8) { const int u = (aw & 255) * 4 + (aw >> 8), b = u >> 2, h = u & 3; const int row0 = MP + b * TS;
            attn_unit(U + (size_t)row0 * NU + UQ + h * 64, NU, SK + (size_t)b * SKEYS * 256 + h * 64, 256, SVT + (size_t)u * 64 * SKP, SKP, PAST, SKEYS - 1, YC + (size_t)row0 * D + 768 + h * 64, D, lane); }
    } else {
        for (int u = aw; u < 32; u += naw) { const int b = u >> 2, h = u & 3; const int row0 = MP + b * TS;
            attn_unit(U + (size_t)row0 * NU + UQ + h * 64, NU, SK + (size_t)b * SKEYS * 256 + h * 64, 256, SVT + (size_t)u * 64 * SKP, SKP, PAST, SKEYS - 1, YC + (size_t)row0 * D + 768 + h * 64, D, lane); }
    }
}

__device__ __forceinline__ void rwkv_post(const Args& a, int l) {
    const int tid = ltid();
    KArgP ap = kargs(); unsigned char* ws_l = ap->ws;
    const float* in_I_LNB = ap->in[I_LNB]; const float* in_I_LNW = ap->in[I_LNW];
    const float* YS = (const float*)(ws_l + WS_YS); const bf16* Gb = (const bf16*)(ws_l + WS_G); const float* RKb = (const float*)(ws_l + WS_RK);
    bf16* YC = (bf16*)(ws_l + WS_H);
    const int lane = tid & 63, wave = tid >> 6, h = lane >> 4, c4 = 4 * lane, cc = 4 * (lane & 15);
    const f32x4 lnw = *(const f32x4*)(in_I_LNW + l * 256 + c4), lnb = *(const f32x4*)(in_I_LNB + l * 256 + c4);
    const int gw = blockIdx.x * NWAVES + wave, NGW = gridDim.x * NWAVES;
#define PO_BODY(row_, y_, gq_, vq_, rk_) do { \
        const float mean = red16((y_.x + y_.y) + (y_.z + y_.w)) * (1.f / 64.f); const f32x4 dv = y_ - mean; \
        const float var = red16((dv.x * dv.x + dv.y * dv.y) + (dv.z * dv.z + dv.w * dv.w)) * (1.f / 64.f); const float rs = rsqrtf(var + GN_EPS); \
        const float o0 = (dv.x * rs * lnw.x + lnb.x + rk_ * bflo(vq_.x)) * bflo(gq_.x), o1 = (dv.y * rs * lnw.y + lnb.y + rk_ * bfhi(vq_.x)) * bfhi(gq_.x); \
        const float o2 = (dv.z * rs * lnw.z + lnb.z + rk_ * bflo(vq_.y)) * bflo(gq_.y), o3 = (dv.w * rs * lnw.w + lnb.w + rk_ * bfhi(vq_.y)) * bfhi(gq_.y); \
        u32x2 o; o.x = pk2(o0, o1); o.y = pk2(o2, o3); *(u32x2*)(YC + (size_t)(row_) * D + 256 + c4) = o; } while (0)
#define PO_LOAD(r_, y_, g_, v_, k_) do { y_ = *(const f32x4*)(YS + (size_t)(r_) * 256 + c4); g_ = *(const u32x2*)(Gb + (size_t)(r_) * 256 + c4); \
        v_ = *(const u32x2*)(ws_l + WS_SIN + rec_index((r_), h) * REC + 256 + 2 * cc); k_ = RKb[(size_t)(r_) * 4 + h]; } while (0)
    for (int row = gw; row < MR; row += 4 * NGW) {
        f32x4 y0, y1, y2, y3; u32x2 g0, g1, g2, g3, v0, v1, v2, v3; float k0, k1, k2, k3;
        const int r1 = row + NGW, r2 = row + 2 * NGW, r3 = row + 3 * NGW;
        PO_LOAD(row, y0, g0, v0, k0);
        if (r1 < MR) PO_LOAD(r1, y1, g1, v1, k1);
        if (r2 < MR) PO_LOAD(r2, y2, g2, v2, k2);
        if (r3 < MR) PO_LOAD(r3, y3, g3, v3, k3);
        PO_BODY(row, y0, g0, v0, k0);
        if (r1 < MR) PO_BODY(r1, y1, g1, v1, k1);
        if (r2 < MR) PO_BODY(r2, y2, g2, v2, k2);
        if (r3 < MR) PO_BODY(r3, y3, g3, v3, k3);
    }
#undef PO_BODY
#undef PO_LOAD
}

template <int MODE, int K>
__device__ __forceinline__ void small_gemm(const bf16* A, const bf16* Bt, int ncol16, bf16* Ob, float* Of, int ldc, float* sk, float* sv, unsigned char* lds, int bid, int G) {
    constexpr int KW = K / 8, NKS = KW / 32, NB_ = (MODE == 1) ? 4 : 2;
    static_assert(KW % 32 == 0, "K split");
    const int tid = ltid(), lane = tid & 63, wave = tid >> 6, fr = lane & 15, g = lane >> 4;
    float* part = (float*)lds;
    const int ntile = 8 * (ncol16 / 2);
    bf16x8 af[NKS], b0[NKS], b1[NKS], b2[NKS], b3[NKS];
    int tile = bid;
#define SG_ROW(c_) ((MODE == 1) ? (256 * ((c_) >> 7) + ((c_) & 127)) : (c_))
#define SG_LOAD(tl) do { const int mt_ = (tl) & 7, c0_ = ((tl) >> 3) * 32; \
        const bf16* ap_ = A + (size_t)(mt_ * 16 + fr) * K + wave * KW + 8 * g; const bf16* bp_ = Bt + (size_t)(SG_ROW(c0_) + fr) * K + wave * KW + 8 * g; const bf16* bq_ = bp_ + (size_t)16 * K; \
        _Pragma("unroll") for (int q = 0; q < NKS; ++q) { af[q] = *(const bf16x8*)(ap_ + 32 * q); b0[q] = *(const bf16x8*)(bp_ + 32 * q); b1[q] = *(const bf16x8*)(bq_ + 32 * q); \
            if (MODE == 1) { b2[q] = *(const bf16x8*)(bp_ + (size_t)128 * K + 32 * q); b3[q] = *(const bf16x8*)(bq_ + (size_t)128 * K + 32 * q); } } } while (0)
    if (tile < ntile) SG_LOAD(tile);
    for (int it = 0; tile < ntile; ++it, tile += G) {
        f32x4 acc0 = {0.f, 0.f, 0.f, 0.f}, acc1 = acc0, acc2 = acc0, acc3 = acc0;
#pragma unroll
        for (int q = 0; q < NKS; ++q) { acc0 = mfma16(b0[q], af[q], acc0); acc1 = mfma16(b1[q], af[q], acc1); if (MODE == 1) { acc2 = mfma16(b2[q], af[q], acc2); acc3 = mfma16(b3[q], af[q], acc3); } }
        if (tile + G < ntile) SG_LOAD(tile + G);
        float* pb = part + (it & 1) * (8 * NB_ * 256);
        *(f32x4*)(pb + (wave * NB_ + 0) * 256 + lane * 4) = acc0; *(f32x4*)(pb + (wave * NB_ + 1) * 256 + lane * 4) = acc1;
        if (MODE == 1) { *(f32x4*)(pb + (wave * NB_ + 2) * 256 + lane * 4) = acc2; *(f32x4*)(pb + (wave * NB_ + 3) * 256 + lane * 4) = acc3; }
        __syncthreads();
        {
            const int sub = tid >> 8, e = tid & 255;
            float s0 = 0.f, s1 = 0.f;
#pragma unroll
            for (int w = 0; w < 8; ++w) { s0 += pb[(w * NB_ + sub) * 256 + e]; if (MODE == 1) s1 += pb[(w * NB_ + 2 + sub) * 256 + e]; }
            const int ln = e >> 2, r = e & 3, mt = tile & 7, c0 = (tile >> 3) * 32 + 16 * sub;
            const int m = mt * 16 + (ln & 15), n = c0 + 4 * (ln >> 4) + r;
            if (MODE == 0) Ob[(size_t)m * ldc + n] = (bf16)f2bf(s0);
            else if (MODE == 1) Ob[(size_t)m * ldc + n] = (bf16)f2bf(pg8::silu_f(s0) * s1);
            else { Ob[(size_t)m * ldc + n] = (bf16)f2bf(s0); if (n >= UK && n < UK + 512) ((n < UV ? sk : sv) + (size_t)m * 256)[n & 255] = s0; }
        }
    }
#undef SG_LOAD
#undef SG_ROW
    __syncthreads();
}

#define XB_TMO      128
#define XB_XCNT(j)  (256  + 64 * (j))
#define XB_XSUB(j)  (1280 + 64 * (j))
#define XB_XGEN(j)  (2304 + 64 * (j))
#define XB_TOP      3328
#define XB_TOPGEN   3392
#define XCD_BAR_WORDS 3456
#define XB_SPIN_CAP (1u << 18)

__device__ __forceinline__ unsigned xb_ld(unsigned* p)              { return __hip_atomic_load(p, __ATOMIC_RELAXED, __HIP_MEMORY_SCOPE_AGENT); }
__device__ __forceinline__ unsigned xb_add(unsigned* p, unsigned v) { return __hip_atomic_fetch_add(p, v, __ATOMIC_RELAXED, __HIP_MEMORY_SCOPE_AGENT); }
__device__ __forceinline__ unsigned xb_xcc_id() { return (unsigned)__builtin_amdgcn_s_getreg((3 << 11) | 20) & 0xFu; }
#define XB_SPIN(cond, bar) do { unsigned _sp = 0; while (cond) { __builtin_amdgcn_s_sleep(1); \
    if ((++_sp & 255u) == 0u) { if (xb_ld(&(bar)[XB_TMO])) break; if (_sp > XB_SPIN_CAP) { atomicAdd(&(bar)[XB_TMO], 1u); break; } } } } while (0)

struct XcdBarrier {
    unsigned* bar; unsigned x;
    volatile LAS unsigned* st;
};

__device__ __forceinline__ XcdBarrier xcd_barrier_post(unsigned* bar, volatile LAS unsigned* st) {
    XcdBarrier b; b.bar = bar; b.x = xb_xcc_id(); b.st = st;
    if (threadIdx.x == 0) (void)xb_add(&bar[XB_XCNT(b.x)], 1u);
    return b;
}
__device__ __forceinline__ void xcd_barrier_complete(unsigned* bar, unsigned x, unsigned& nloc, unsigned& nx) {
    const unsigned G = gridDim.x * gridDim.y * gridDim.z;
    unsigned sum, cnt, mine, sp = 0u;
    for (;;) {
        sum = 0u; cnt = 0u; mine = 0u;
#pragma unroll
        for (unsigned j = 0; j < 16; ++j) { const unsigned c = xb_ld(&bar[XB_XCNT(j)]); sum += c; cnt += (c > 0u) ? 1u : 0u; mine = (j == x) ? c : mine; }
        if (sum == G) break;
        __builtin_amdgcn_s_sleep(1);
        if ((++sp & 255u) == 0u) { if (xb_ld(&bar[XB_TMO])) break; if (sp > XB_SPIN_CAP) { atomicAdd(&bar[XB_TMO], 1u); break; } }
    }
    nloc = mine > 0u ? mine : 1u; nx = cnt > 0u ? cnt : 1u;
}

__device__ __forceinline__ void xcd_barrier(const XcdBarrier& b) {
    asm volatile("s_waitcnt vmcnt(0)" ::: "memory");
    __syncthreads();
    if (threadIdx.x == 0) {
        unsigned* bar = b.bar;
        __builtin_amdgcn_s_waitcnt(0);
        unsigned nloc = b.st[0], nx = b.st[1];
        if (nloc == 0u) { xcd_barrier_complete(bar, b.x, nloc, nx); b.st[0] = nloc; b.st[1] = nx; }
        const unsigned old = xb_add(&bar[XB_XSUB(b.x)], 1u);
        const unsigned gen = old / nloc;
        if (old + 1u == (gen + 1u) * nloc) {
            __builtin_amdgcn_fence(__ATOMIC_RELEASE, "agent");
            asm volatile("s_waitcnt vmcnt(0)" ::: "memory");
            const unsigned og = xb_add(&bar[XB_TOP], 1u);
            const unsigned tg = og / nx;
            if (og + 1u == (tg + 1u) * nx) xb_add(&bar[XB_TOPGEN], 1u);
            else XB_SPIN(xb_ld(&bar[XB_TOPGEN]) == tg, bar);
            __builtin_amdgcn_fence(__ATOMIC_ACQUIRE, "agent");
            xb_add(&bar[XB_XGEN(b.x)], 1u);
            asm volatile("s_waitcnt vmcnt(0)" ::: "memory");
        } else {
            XB_SPIN(xb_ld(&bar[XB_XGEN(b.x)]) == gen, bar);
            __builtin_amdgcn_fence(__ATOMIC_ACQUIRE, "agent");
            asm volatile("s_waitcnt vmcnt(0)" ::: "memory");
        }
    }
    __syncthreads();
}

__global__ void __launch_bounds__(NTHR, 2) mk_fwd(Args a) {
    extern __shared__ __attribute__((aligned(16))) unsigned char lds[];
    cg::grid_group grid = cg::this_grid();
    const int lo = MK_PER_PHASE ? a.ph_lo : 0, hi = MK_PER_PHASE ? a.ph_hi : NPH, G = gridDim.x;
#define IN(k) (lo <= (k) && (k) < hi)
    for (int u_ = ltid(); u_ < 64; u_ += NTHR) ((LAS unsigned*)((LAS unsigned char*)lds + 131072))[u_] = 0u;
    __syncthreads();
    (void)xcd_barrier_post((unsigned*)(a.ws + WS_CTL), (volatile LAS unsigned*)((LAS unsigned char*)lds + 131072 + 64));
#define XBAR_NOW() do { XcdBarrier xb_; xb_.bar = (unsigned*)(kargs()->ws + WS_CTL); xb_.x = xb_xcc_id(); xb_.st = (volatile LAS unsigned*)((LAS unsigned char*)lds + 131072 + 64); xcd_barrier(xb_); } while (0)
#define SEAM(k) do { if (IN(k) && IN((k) + 1)) { if ((k) == PH_PRE) grid.sync(); else XBAR_NOW(); } } while (0)
    PG8_LAS unsigned char* ring = (PG8_LAS unsigned char*)lds;
#define PHASE_PTRS KArgP ap = kargs(); unsigned char* ws_ = ap->ws; float* out_ = ap->out; \
    bf16* Wb = (bf16*)(ws_ + WS_W); bf16* H = (bf16*)(ws_ + WS_H); bf16* ACT = (bf16*)(ws_ + WS_U); bf16* Y = (bf16*)(ws_ + WS_Y); float* X = out_ + O_X; bf16* XB = (bf16*)(out_ + O_X); bf16* XALT = (bf16*)(ws_ + WS_Y + (size_t)M * D * 2); \
    const bf16* WL = Wb + (size_t)l * LW; const float* ng = ap->in[I_NG] + (size_t)l * 6 * D; (void)H; (void)ACT; (void)Y; (void)X; (void)XB; (void)XALT; (void)WL; (void)ng;

#define REPEAT(bit) _Pragma("nounroll") for (int rep_ = 0; rep_ < ((REP & (bit)) ? 2 : 1); ++rep_)
#define RSYNC if (rep_) XBAR_NOW();
#define GEMM_MAIN(EPI, Aptr, Wptr, NN, KK, EOBJ) { pg8::Gemm g{Aptr, Wptr, MP, NN, KK}; pg8::StaticOrder S; S.init(MP, NN, G, (int)blockIdx.x); pg8::gemm_phase<EPI, pg8::StaticOrder, true, true>(ring, g, S, EOBJ); }
#define SMALL_IDS const int tid_ = ltid(); const int gw_ = (int)blockIdx.x * NWAVES + (tid_ >> 6), ngw_ = G * NWAVES, lane_ = tid_ & 63;
    if (REP & 16384) { for (int i = 0; i < 20; ++i) XBAR_NOW(); }
    if (IN(PH_PRE)) REPEAT(128) { RSYNC phase_pre(a, lds); }
    SEAM(PH_PRE);
    for (int l = 0; l < 2; ++l) {
        const int p0 = 1 + l * PH_PER_LAYER;
        if (IN(p0 + P_A1)) REPEAT(1) { RSYNC PHASE_PTRS
            { pg8::EpiSwiglu E{ACT, FF}; GEMM_MAIN(pg8::EpiSwiglu, H, WL + W_GUA, 2 * FF, D, E) }
            small_gemm<1, D>(H + (size_t)MP * D, WL + W_GUA, FF / 16, ACT + (size_t)MP * FF, nullptr, FF, nullptr, nullptr, lds, (int)blockIdx.x, G); }
        SEAM(p0 + P_A1);
        if (IN(p0 + P_A2)) REPEAT(2) { RSYNC PHASE_PTRS
            { pg8::EpiBf E{Y, D}; GEMM_MAIN(pg8::EpiBf, ACT, WL + W_DA, D, FF, E) }
            small_gemm<0, FF>(ACT + (size_t)MP * FF, WL + W_DA, D / 16, Y + (size_t)MP * D, nullptr, D, nullptr, nullptr, lds, (int)blockIdx.x, G); }
        SEAM(p0 + P_A2);
        if (IN(p0 + P_A3)) { PHASE_PTRS
            if (l == 0) phase_rowpass<true, false, true>(ap->in[I_XP], ap->in[I_XS], Y, 0.5f, ng + 1 * D, ng + 2 * D, XB, H);
            else        phase_rowpass<false, false, true>(XB, XB, Y, 0.5f, ng + 1 * D, ng + 2 * D, XB, H);
        }
        SEAM(p0 + P_A3);
        if (IN(p0 + P_B1)) REPEAT(4) { RSYNC PHASE_PTRS
            { pg8::EpiU E{ACT, NU, out_ + O_PK + (size_t)l * MP * 256, out_ + O_PV + (size_t)l * MP * 256, out_ + O_SK + (size_t)l * MS * 256, out_ + O_SV + (size_t)l * MS * 256, MP, MR};
              GEMM_MAIN(pg8::EpiU, H, WL + W_IN, NU, D, E) }
            if (G == 256) { if ((int)blockIdx.x >= 128) small_gemm<2, D>(H + (size_t)MP * D, WL + W_IN, NU / 16, ACT + (size_t)MP * NU, nullptr, NU, out_ + O_SK + (size_t)l * MS * 256, out_ + O_SV + (size_t)l * MS * 256, lds, (int)blockIdx.x - 128, 128); }
              else small_gemm<2, D>(H + (size_t)MP * D, WL + W_IN, NU / 16, ACT + (size_t)MP * NU, nullptr, NU, out_ + O_SK + (size_t)l * MS * 256, out_ + O_SV + (size_t)l * MS * 256, lds, (int)blockIdx.x, G); }
        SEAM(p0 + P_B1);
        if (IN(p0 + P_C1)) REPEAT(16) { RSYNC
            skv_part(a, l); vt_part(a, l);
            for (int r4_ = 0; r4_ < ((REP & 4096) ? 2 : 1); ++r4_) rwkv_prep_part(a, l, lds);
        }
        SEAM(p0 + P_C1);
        if (IN(p0 + P_C2)) REPEAT(32) { RSYNC
            _Pragma("nounroll") for (int r2_ = 0; r2_ < ((REP & 256) ? 2 : 1); ++r2_)
            for (int ub = blockIdx.x; ub < 256; ub += G) {
                const int c_ = ub & 127, xcd_ = c_ & 7, idx_ = c_ >> 3, u = (ub & 128) | (((xcd_ * 4 + (idx_ >> 2)) << 2) | (idx_ & 3));
                if (u < 128) scan_unit<32>(a, l, u, lds); else scan_unit<16>(a, l, u, lds); }
            const int ab0 = G / 2;
            if ((int)blockIdx.x >= ab0) { _Pragma("nounroll") for (int r3_ = 0; r3_ < ((REP & 512) ? 2 : 1); ++r3_) attn_part(a, l, ((int)blockIdx.x - ab0) * NWAVES + (int)(ltid() >> 6), (G - ab0) * NWAVES);
                for (int r4_ = 0; r4_ < ((REP & 1024) ? 2 : 1); ++r4_) conv_part(a, l, (int)blockIdx.x - ab0, G - ab0);
                for (int r4_ = 0; r4_ < ((REP & 2048) ? 2 : 1); ++r4_) pool_part(a, l, lds, (int)blockIdx.x - ab0, G - ab0); }
        }
        SEAM(p0 + P_C2);
        if (IN(p0 + P_C3)) REPEAT(64) { RSYNC rwkv_post(a, l); }
        SEAM(p0 + P_C3);
        if (IN(p0 + P_D1)) REPEAT(8) { RSYNC PHASE_PTRS
            { pg8::EpiBf E{Y, D}; GEMM_MAIN(pg8::EpiBf, H, WL + W_OUT, D, D, E) }
            small_gemm<0, D>(H + (size_t)MP * D, WL + W_OUT, D / 16, Y + (size_t)MP * D, nullptr, D, nullptr, nullptr, lds, (int)blockIdx.x, G); }
        SEAM(p0 + P_D1);
        if (IN(p0 + P_D2)) { PHASE_PTRS if (l == 0) phase_rowpass<false, false, true>(XB, XB, Y, 1.0f, ng + 3 * D, ng + 4 * D, XB, H);
            else        phase_rowpass<false, false, true>(XB, XB, Y, 1.0f, ng + 3 * D, ng + 4 * D, XALT, H); }
        SEAM(p0 + P_D2);
        if (IN(p0 + P_E1)) REPEAT(1) { RSYNC PHASE_PTRS
            { pg8::EpiSwiglu E{ACT, FF}; GEMM_MAIN(pg8::EpiSwiglu, H, WL + W_GUB, 2 * FF, D, E) }
            small_gemm<1, D>(H + (size_t)MP * D, WL + W_GUB, FF / 16, ACT + (size_t)MP * FF, nullptr, FF, nullptr, nullptr, lds, (int)blockIdx.x, G); }
        SEAM(p0 + P_E1);
        if (IN(p0 + P_E2)) REPEAT(2) { RSYNC PHASE_PTRS
            { pg8::EpiBf E{Y, D}; GEMM_MAIN(pg8::EpiBf, ACT, WL + W_DB, D, FF, E) }
            small_gemm<0, FF>(ACT + (size_t)MP * FF, WL + W_DB, D / 16, Y + (size_t)MP * D, nullptr, D, nullptr, nullptr, lds, (int)blockIdx.x, G); }
        SEAM(p0 + P_E2);
        if (IN(p0 + P_E3)) { PHASE_PTRS
            if (l == 0) phase_rowpass<false, false, true>(XB, XB, Y, 0.5f, ng + 5 * D, ng + 6 * D, XB, H);
            else        phase_rowpass<false, true, false>(XALT, XALT, Y, 0.5f, ng + 5 * D, ng, X, H);
        }
        SEAM(p0 + P_E3);
    }
#undef IN
#undef SEAM
}

extern "C" void kernel_launch(void* const* d_in, const int* in_sizes, int n_in, void* d_out, int out_size, void* d_ws, size_t ws_size, hipStream_t stream) {
    static int grid = 0;
    if (grid == 0) {
        if (n_in != 28 || (size_t)out_size != O_END || ws_size < WS_END) { fprintf(stderr, "kernel_launch: unexpected shapes: n_in %d out %d ws %zu (need %zu)\n", n_in, out_size, ws_size, (size_t)WS_END); grid = -1; return; }
        int dev = 0, cus = 0, per_cu = 0;
        if (hipGetDevice(&dev) != hipSuccess || hipDeviceGetAttribute(&cus, hipDeviceAttributeMultiprocessorCount, dev) != hipSuccess) { grid = -1; return; }
        if (hipFuncSetAttribute((const void*)mk_fwd, hipFuncAttributeMaxDynamicSharedMemorySize, LDS_BYTES) != hipSuccess) { fprintf(stderr, "kernel_launch: hipFuncSetAttribute failed\n"); grid = -1; return; }
        if (hipOccupancyMaxActiveBlocksPerMultiprocessor(&per_cu, (const void*)mk_fwd, NTHR, LDS_BYTES) != hipSuccess || per_cu < 1) { fprintf(stderr, "kernel_launch: occupancy query says %d\n", per_cu); per_cu = 1; }
        (void)hipGetLastError();
        grid = cus * 1;
    }
    if (grid < 0) return;
    if (hipMemsetAsync((char*)d_ws + WS_CTL, 0, 16384, stream) != hipSuccess) { fprintf(stderr, "kernel_launch: hipMemsetAsync failed\n"); return; }
    Args a{};
    for (int i = 0; i < 28; ++i) a.in[i] = (const float*)d_in[i];
    a.out = (float*)d_out; a.ws = (unsigned char*)d_ws;
#if MK_PER_PHASE
    for (int ph = 0; ph < NPH; ++ph) { a.ph_lo = ph; a.ph_hi = ph + 1; hipLaunchKernelGGL(mk_fwd, dim3(grid), dim3(NTHR), LDS_BYTES, stream, a); }
#else
    a.ph_lo = 0; a.ph_hi = NPH;
    void* args[] = {&a};
    hipError_t e = hipLaunchCooperativeKernel((const void*)mk_fwd, dim3(grid), dim3(NTHR), args, LDS_BYTES, stream);
    if (e != hipSuccess) fprintf(stderr, "kernel_launch: cooperative launch failed: %s (grid %d)\n", hipGetErrorString(e), grid);
#endif
}
```

```cpp
#include <hip/hip_runtime.h>
#include <hip/hip_cooperative_groups.h>
#include <cstdio>
#include <cstdint>
namespace cg = cooperative_groups;
#ifndef MK_PER_PHASE
#define MK_PER_PHASE 0
#endif
#ifndef DIS
#define DIS 0
#endif
__device__ __forceinline__ int ltid() { int t = threadIdx.x; asm volatile("" : "+v"(t)); return t; }
#ifndef REP
#define REP 0
#endif
namespace pg8 {
#define PG8_LAS __attribute__((address_space(3)))
typedef unsigned short bf16_t;
typedef short bf16x8 __attribute__((ext_vector_type(8)));
typedef float f32x4 __attribute__((ext_vector_type(4)));
typedef unsigned u32x4 __attribute__((ext_vector_type(4)));
constexpr int BM = 256, BK = 64, HALF = 128, HTB = HALF * BK * 2  , STAGE_BYTES = 8 * HTB, NXCD = 8, WGM = 8;

__host__ __device__ __forceinline__ int lds_byte(int r, int c) { const int st = (r >> 4) * 2 + (c >> 5), rr = r & 15, cc = c & 31, ob = rr * 64 + cc * 2; return st * 1024 + (ob ^ (((ob >> 9) & 1) << 5)); }
__host__ __device__ __forceinline__ void stage_rc(int b, int& R, int& C) { const int st = b / 1024, sb = b % 1024, swz = sb ^ (((sb >> 9) & 1) << 5); R = (st >> 1) * 16 + swz / 64; C = (st & 1) * 32 + (swz % 64) / 2; }
__host__ __device__ __forceinline__ int perm32(int rho) { const int n = rho >> 4, i = rho & 15; return 8 * (i >> 2) + 4 * n + (i & 3); }

struct Unit { int pm, pn; };
struct Gemm { const bf16_t* A; const bf16_t* Bt; int M, N, K; };

struct StaticOrder {
    int nM, nN, nwg, G, c;
    __host__ __device__ void init(int M, int N, int G_, int c_) { nM = M / BM; nN = N / BM; nwg = nM * nN; G = G_; c = c_; }
    __host__ __device__ bool next(int i, Unit& u) const {
        const long L = (long)i * G + c; if (L >= nwg) return false;
        int wgid = (int)L; { const int q = nwg / NXCD, r = nwg % NXCD, xcd = wgid % NXCD, off = wgid / NXCD; wgid = (xcd < r ? xcd * (q + 1) : r * (q + 1) + (xcd - r) * q) + off; }
        const int nig = WGM * nN, gid = wgid / nig, fm = gid * WGM, gsz = (nM - fm) < WGM ? (nM - fm) : WGM;
        u.pm = fm + ((wgid % nig) % gsz); u.pn = (wgid % nig) / gsz; return true;
    }
    __device__ __forceinline__ void a_ready(const Unit&) const {}
    __device__ __forceinline__ void done(const Unit&) const {}
};

__device__ __forceinline__ unsigned cvt_pk_bf16(float lo, float hi) { unsigned r; asm volatile("v_cvt_pk_bf16_f32 %0, %1, %2" : "=v"(r) : "v"(lo), "v"(hi)); return r; }

__device__ __forceinline__ float silu_f(float x) { return x * __builtin_amdgcn_rcpf(1.0f + __builtin_amdgcn_exp2f(-1.44269504089f * x)); }
struct EpiSwiglu {
    static constexpr bool PERM = true, AFTER_DRAIN = false;
    bf16_t* O; int ldc;
    __device__ __forceinline__ void operator()(const f32x4 (&acc)[2][2][4][2], const Unit& u, int wr, int wc, int fr, int fq) const {
        const int row0 = u.pm * BM + wr * 64 + fr, col0 = u.pn * HALF + wc * 32 + 8 * fq;
#pragma unroll
        for (int ai = 0; ai < 2; ++ai)
#pragma unroll
            for (int m = 0; m < 4; ++m) {
                bf16_t* rowp = O + (size_t)(row0 + ai * HALF + m * 16) * ldc + col0;
                const f32x4 g0 = acc[ai][0][m][0], g1 = acc[ai][0][m][1], u0 = acc[ai][1][m][0], u1 = acc[ai][1][m][1];
                u32x4 w;
                w.x = cvt_pk_bf16(silu_f(g0[0]) * u0[0], silu_f(g0[1]) * u0[1]); w.y = cvt_pk_bf16(silu_f(g0[2]) * u0[2], silu_f(g0[3]) * u0[3]);
                w.z = cvt_pk_bf16(silu_f(g1[0]) * u1[0], silu_f(g1[1]) * u1[1]); w.w = cvt_pk_bf16(silu_f(g1[2]) * u1[2], silu_f(g1[3]) * u1[3]);
                *(u32x4*)rowp = w;
            }
    }
};
struct EpiF32 {
    static constexpr bool PERM = false, AFTER_DRAIN = false;
    float* O; int ldc;
    __device__ __forceinline__ void operator()(const f32x4 (&acc)[2][2][4][2], const Unit& u, int wr, int wc, int fr, int fq) const {
        const int row0 = u.pm * BM + wr * 64 + fr, col0 = u.pn * BM + wc * 32 + 4 * fq;
#pragma unroll
        for (int ai = 0; ai < 2; ++ai)
#pragma unroll
            for (int m = 0; m < 4; ++m) {
                float* rowp = O + (size_t)(row0 + ai * HALF + m * 16) * ldc + col0;
#pragma unroll
                for (int bj = 0; bj < 2; ++bj)
#pragma unroll
                    for (int n = 0; n < 2; ++n) *(f32x4*)(rowp + bj * HALF + n * 16) = acc[ai][bj][m][n];
            }
    }
};
struct EpiU {
    static constexpr bool PERM = true, AFTER_DRAIN = false;
    bf16_t* O; int ldc; float* pk; float* pv; float* sk; float* sv; int mp, mr;
    __device__ __forceinline__ void operator()(const f32x4 (&acc)[2][2][4][2], const Unit& u, int wr, int wc, int fr, int fq) const {
        const int row0 = u.pm * BM + wr * 64 + fr, colt = wc * 32 + 8 * fq;
        const bool kv = (u.pn == 1) || (u.pn == 2);
#pragma unroll
        for (int ai = 0; ai < 2; ++ai)
#pragma unroll
            for (int m = 0; m < 4; ++m) {
                const int row = row0 + ai * HALF + m * 16;
                bf16_t* rowp = O + (size_t)row * ldc + u.pn * BM + colt;
#pragma unroll
                for (int bj = 0; bj < 2; ++bj) {
                    const f32x4 v0 = acc[ai][bj][m][0], v1 = acc[ai][bj][m][1];
                    u32x4 w; w.x = cvt_pk_bf16(v0[0], v0[1]); w.y = cvt_pk_bf16(v0[2], v0[3]); w.z = cvt_pk_bf16(v1[0], v1[1]); w.w = cvt_pk_bf16(v1[2], v1[3]);
                    *(u32x4*)(rowp + bj * HALF) = w;
                    if (kv && row < mr) {
                        float* dst = (row < mp) ? ((u.pn == 1 ? pk : pv) + (size_t)row * 256) : ((u.pn == 1 ? sk : sv) + (size_t)(row - mp) * 256);
                        dst += bj * HALF + colt;
                        *(f32x4*)dst = v0; *(f32x4*)(dst + 4) = v1;
                    }
                }
            }
    }
};
struct EpiBf {
    static constexpr bool PERM = true, AFTER_DRAIN = false;
    bf16_t* O; int ldc;
    __device__ __forceinline__ void operator()(const f32x4 (&acc)[2][2][4][2], const Unit& u, int wr, int wc, int fr, int fq) const {
        const int row0 = u.pm * BM + wr * 64 + fr, col0 = u.pn * BM + wc * 32 + 8 * fq;
#pragma unroll
        for (int ai = 0; ai < 2; ++ai)
#pragma unroll
            for (int m = 0; m < 4; ++m) {
                bf16_t* rowp = O + (size_t)(row0 + ai * HALF + m * 16) * ldc + col0;
#pragma unroll
                for (int bj = 0; bj < 2; ++bj) {
                    const f32x4 v0 = acc[ai][bj][m][0], v1 = acc[ai][bj][m][1];
                    u32x4 w; w.x = cvt_pk_bf16(v0[0], v0[1]); w.y = cvt_pk_bf16(v0[2], v0[3]); w.z = cvt_pk_bf16(v1[0], v1[1]); w.w = cvt_pk_bf16(v1[2], v1[3]);
                    *(u32x4*)(rowp + bj * HALF) = w;
                }
            }
    }
};

template <class Epi, class Sched, bool ALIGN_EPI = false, bool SP2 = false>
__device__ __forceinline__ void gemm_phase(PG8_LAS unsigned char* lds, const Gemm g, const Sched& S, const Epi& E) {
    const int tid = ltid(), wid = __builtin_amdgcn_readfirstlane(tid >> 6), lane = tid & 63, wr = wid >> 2, wc = wid & 3, fr = lane & 15, fq = lane >> 4;
    const int K = g.K, nt = K / BK;
    unsigned voffA[2], voffB[2];
#pragma unroll
    for (int i = 0; i < 2; ++i) { int R, C; stage_rc(tid * 16 + i * 8192, R, C); const int Rb = Epi::PERM ? ((R & ~31) + perm32(R & 31)) : R;
        voffA[i] = (unsigned)(R * K + C) * 2u; voffB[i] = (unsigned)(Rb * K + C) * 2u; }
    const size_t kstep = (size_t)(BK * 2);
    const size_t hstep = (size_t)HALF * K * 2;
    const size_t tstep = 2 * hstep;
    const unsigned ldsw = (unsigned)wid * 1024u;
    const int aoff = lds_byte(wr * 64 + fr, fq * 8), boff = lds_byte(wc * 32 + fr, fq * 8);
#define PG8_SA(b, h) (((b) * 2 + (h)) * HTB)
#define PG8_SB(b, h) ((4 + (b) * 2 + (h)) * HTB)
#define PG8_STAGE(bufoff, gbase, voff) do { _Pragma("unroll") for (int _i = 0; _i < 2; ++_i) \
        __builtin_amdgcn_global_load_lds((const unsigned*)((const char*)(gbase) + (voff)[_i]), (PG8_LAS unsigned*)(lds + (bufoff) + ldsw + _i * 8192), 16, 0, 0); } while (0)
#define PG8_LDA(dst, b, h) do { _Pragma("unroll") for (int m = 0; m < 4; ++m) _Pragma("unroll") for (int k = 0; k < 2; ++k) dst[m][k] = *(const PG8_LAS bf16x8*)(lds + PG8_SA(b, h) + aoff + m * 2048 + k * 1024); } while (0)
#define PG8_LDB(dst, b, h) do { _Pragma("unroll") for (int n = 0; n < 2; ++n) _Pragma("unroll") for (int k = 0; k < 2; ++k) dst[n][k] = *(const PG8_LAS bf16x8*)(lds + PG8_SB(b, h) + boff + n * 2048 + k * 1024); } while (0)
#define PG8_MMA(ai, bj, At, Bt) do { __builtin_amdgcn_s_setprio(1); _Pragma("unroll") for (int m = 0; m < 4; ++m) _Pragma("unroll") for (int n = 0; n < 2; ++n) _Pragma("unroll") for (int k = 0; k < 2; ++k) \
        acc[ai][bj][m][n] = __builtin_amdgcn_mfma_f32_16x16x32_bf16(Bt[n][k], At[m][k], acc[ai][bj][m][n], 0, 0, 0); __builtin_amdgcn_s_setprio(0); } while (0)
#define PG8_WAIT_V(n) asm volatile("s_waitcnt vmcnt(" #n ")" ::: "memory")
#define PG8_WAIT_L(n) asm volatile("s_waitcnt lgkmcnt(" #n ")" ::: "memory")
#define PG8_BAR __builtin_amdgcn_s_barrier()
#define PG8_SCHED __builtin_amdgcn_sched_barrier(0)
    Unit cur, nxt; int ui = 0;
    if (!S.next(0, cur)) return;
    f32x4 acc[2][2][4][2];
#pragma unroll
    for (int a = 0; a < 2; ++a)
#pragma unroll
        for (int b = 0; b < 2; ++b)
#pragma unroll
            for (int m = 0; m < 4; ++m)
#pragma unroll
                for (int n = 0; n < 2; ++n) acc[a][b][m][n] = (f32x4){0.f, 0.f, 0.f, 0.f};
    bf16x8 At[4][2], B0[2][2], B1[2][2];
    const char* cA = (const char*)g.A + (size_t)cur.pm * tstep; const char* cB = (const char*)g.Bt + (size_t)cur.pn * tstep;
    S.a_ready(cur);
    if constexpr (SP2) {
        PG8_STAGE(PG8_SB(0, 0), cB, voffB); PG8_STAGE(PG8_SB(0, 1), cB + hstep, voffB); PG8_STAGE(PG8_SA(0, 0), cA, voffA); PG8_STAGE(PG8_SA(0, 1), cA + hstep, voffA);
        if (wr == 1) PG8_BAR;
        PG8_WAIT_V(2); PG8_BAR;
        PG8_STAGE(PG8_SB(1, 0), cB + kstep, voffB); PG8_STAGE(PG8_SA(1, 0), cA + kstep, voffA); PG8_STAGE(PG8_SB(1, 1), cB + hstep + kstep, voffB);
        PG8_WAIT_V(6); PG8_BAR;
    } else {
        PG8_STAGE(PG8_SB(0, 0), cB, voffB); PG8_STAGE(PG8_SA(0, 0), cA, voffA); PG8_STAGE(PG8_SB(0, 1), cB + hstep, voffB); PG8_STAGE(PG8_SA(0, 1), cA + hstep, voffA);
        if (wr == 1) PG8_BAR;
        PG8_WAIT_V(4); PG8_BAR;
        PG8_STAGE(PG8_SB(1, 0), cB + kstep, voffB); PG8_STAGE(PG8_SA(1, 0), cA + kstep, voffA); PG8_STAGE(PG8_SB(1, 1), cB + hstep + kstep, voffB);
        PG8_WAIT_V(6); PG8_BAR;
    }
    for (;;) {
        const bool has_next = S.next(ui + 1, nxt);
        const char* nA = has_next ? (const char*)g.A + (size_t)nxt.pm * tstep : cA; const char* nB = has_next ? (const char*)g.Bt + (size_t)nxt.pn * tstep : cB;
        for (int t = 0; t < nt; t += 2) {
            const bool last = (t == nt - 2);
            const char* a1 = cA + (size_t)(t + 1) * kstep;
            const char* a2 = last ? nA : cA + (size_t)(t + 2) * kstep; const char* b2 = last ? nB : cB + (size_t)(t + 2) * kstep;
            const char* a3 = a2 + kstep; const char* b3 = b2 + kstep;
            if (last && has_next) S.a_ready(nxt);
            if constexpr (SP2) {
            PG8_LDB(B0, 0, 0); PG8_LDB(B1, 0, 1); PG8_SCHED; PG8_LDA(At, 0, 0); PG8_STAGE(PG8_SA(1, 1), a1 + hstep, voffA);
            PG8_WAIT_V(8); PG8_WAIT_L(0); PG8_BAR; PG8_MMA(0, 0, At, B0); PG8_MMA(0, 1, At, B1); PG8_BAR; PG8_SCHED;
            PG8_LDA(At, 0, 1); PG8_STAGE(PG8_SB(0, 0), b2, voffB); PG8_STAGE(PG8_SB(0, 1), b2 + hstep, voffB); PG8_STAGE(PG8_SA(0, 0), a2, voffA);
            PG8_WAIT_V(8); PG8_WAIT_L(0); PG8_BAR; PG8_MMA(1, 0, At, B0); PG8_MMA(1, 1, At, B1); PG8_BAR; PG8_SCHED;
            PG8_LDB(B0, 1, 0); PG8_LDB(B1, 1, 1); PG8_SCHED; PG8_LDA(At, 1, 0); PG8_STAGE(PG8_SA(0, 1), a2 + hstep, voffA);
            PG8_WAIT_V(8); PG8_WAIT_L(0); PG8_BAR; PG8_MMA(0, 0, At, B0); PG8_MMA(0, 1, At, B1); PG8_BAR; PG8_SCHED;
            PG8_LDA(At, 1, 1); PG8_STAGE(PG8_SB(1, 0), b3, voffB); PG8_STAGE(PG8_SB(1, 1), b3 + hstep, voffB); PG8_STAGE(PG8_SA(1, 0), a3, voffA);
            PG8_WAIT_V(8); PG8_WAIT_L(0); PG8_BAR; PG8_MMA(1, 0, At, B0); PG8_MMA(1, 1, At, B1); PG8_BAR; PG8_SCHED;
            } else {
            PG8_LDB(B0, 0, 0); PG8_SCHED; PG8_LDA(At, 0, 0); PG8_STAGE(PG8_SA(1, 1), a1 + hstep, voffA);
            PG8_WAIT_L(8); PG8_BAR; PG8_WAIT_L(0); PG8_MMA(0, 0, At, B0); PG8_BAR; PG8_SCHED;
            PG8_LDB(B1, 0, 1); PG8_STAGE(PG8_SB(0, 0), b2, voffB);
            PG8_BAR; PG8_WAIT_L(0); PG8_MMA(0, 1, At, B1); PG8_BAR;
            PG8_LDA(At, 0, 1); PG8_STAGE(PG8_SA(0, 0), a2, voffA);
            PG8_BAR; PG8_WAIT_L(0); PG8_MMA(1, 0, At, B0); PG8_BAR; PG8_SCHED;
            PG8_STAGE(PG8_SB(0, 1), b2 + hstep, voffB);
            PG8_WAIT_V(6); PG8_BAR; PG8_MMA(1, 1, At, B1); PG8_BAR;
            PG8_LDB(B0, 1, 0); PG8_SCHED; PG8_LDA(At, 1, 0); PG8_STAGE(PG8_SA(0, 1), a2 + hstep, voffA);
            PG8_WAIT_L(8); PG8_BAR; PG8_WAIT_L(0); PG8_MMA(0, 0, At, B0); PG8_BAR; PG8_SCHED;
            PG8_LDB(B1, 1, 1); PG8_STAGE(PG8_SB(1, 0), b3, voffB);
            PG8_BAR; PG8_WAIT_L(0); PG8_MMA(0, 1, At, B1); PG8_BAR;
            PG8_LDA(At, 1, 1); PG8_STAGE(PG8_SA(1, 0), a3, voffA);
            PG8_BAR; PG8_WAIT_L(0); PG8_MMA(1, 0, At, B0); PG8_BAR; PG8_SCHED;
            PG8_STAGE(PG8_SB(1, 1), b3 + hstep, voffB);
            PG8_WAIT_V(6); PG8_BAR; PG8_MMA(1, 1, At, B1); PG8_BAR;
            }
        }
        if constexpr (ALIGN_EPI) { if (wr == 0) PG8_BAR; }
        if constexpr (!Epi::AFTER_DRAIN) { E(acc, cur, wr, wc, fr, fq); S.done(cur); }
        if (!has_next) break;
#pragma unroll
        for (int a = 0; a < 2; ++a)
#pragma unroll
            for (int b = 0; b < 2; ++b)
#pragma unroll
                for (int m = 0; m < 4; ++m)
#pragma unroll
                    for (int n = 0; n < 2; ++n) acc[a][b][m][n] = (f32x4){0.f, 0.f, 0.f, 0.f};
        cur = nxt; cA = nA; cB = nB; ++ui;
        if constexpr (ALIGN_EPI) { if (wr == 1) PG8_BAR; }
    }
    PG8_WAIT_V(0);
    if constexpr (!ALIGN_EPI) { if (wr == 0) PG8_BAR; }
    PG8_BAR;
    if constexpr (Epi::AFTER_DRAIN) { E.fused(acc, cur, wr, wc, fr, fq, lds, wid, lane); S.done(cur); }
#undef PG8_SA
#undef PG8_SB
#undef PG8_STAGE
#undef PG8_LDA
#undef PG8_LDB
#undef PG8_MMA
#undef PG8_WAIT_V
#undef PG8_WAIT_L
#undef PG8_BAR
#undef PG8_SCHED
}
}

typedef unsigned short bf16;
typedef short bf16x8 __attribute__((ext_vector_type(8)));
typedef float f32x4 __attribute__((ext_vector_type(4)));
typedef unsigned u32x4 __attribute__((ext_vector_type(4)));
typedef unsigned u32x2 __attribute__((ext_vector_type(2)));
#define LAS __attribute__((address_space(3)))
#define LAUNDER(p) asm volatile("" : "+s"(p))

constexpr int D = 1024, T = 4096, NB = 8, TS = 16, PAST = 1024, FF = 2816, RW = 896;
constexpr int MP = NB * T, MS = NB * TS, MR = MP + MS, M = 33024;
constexpr int NU = 2816;
constexpr int UQ = 0, UK = 256, UV = 512, UPOOL = 768, UCB = 1024, UCC = 1280, UCX = 1536, URW = 1792;
constexpr float RMS_EPS = 1e-6f, GN_EPS = 64e-5f;
constexpr int VTP = T + 64;
constexpr int SKEYS = PAST + TS, SKP = 1088;

constexpr size_t O_X = 0, O_PK = 33685504, O_PV = 50462720, O_PWKV = 67239936, O_PSHIFT = 67502080, O_PCONV = 67516416, O_PPOOL = 67524608,
                 O_SK = 67586048, O_SV = 67651584, O_SWKV = 67717120, O_SSHIFT = 67979264, O_SCONV = 67993600, O_SPOOL = 68001792, O_END = 68063232;
constexpr size_t LW = 21233664;
constexpr size_t W_GUA = 0, W_DA = 5767168, W_IN = 8650752, W_OUT = 11534336, W_GUB = 12582912, W_DB = 18350080;
constexpr size_t WS_W = 0, WS_H = 84934656, WS_U = 152567808, WS_Y = 338558976;
constexpr size_t WS_SIN = WS_Y, WS_G = 456458240, WS_RK = 473300992, WS_YS = 473827328, WS_SKV = 507512832, WS_VT = 511772672, WS_SVT = 528812032, WS_CTL = 533268480, WS_END = 533268480 + 16384;
constexpr size_t SKV_ELEMS = (size_t)NB * SKEYS * 256;
constexpr int REC = 896;
static_assert(WS_Y + (size_t)M * D * 4 <= WS_END && WS_SIN + (size_t)MR * 4 * REC == WS_G && WS_G + (size_t)MR * 512 == WS_RK && WS_RK + (size_t)MR * 16 == WS_YS && WS_YS + (size_t)MR * 1024 == WS_SKV && WS_SKV + SKV_ELEMS * 2 == WS_VT && WS_VT + (size_t)32 * 64 * VTP * 2 == WS_SVT && WS_SVT + (size_t)32 * 64 * SKP * 2 == WS_CTL && WS_END <= 536870912, "ws map");
static_assert(WS_U + (size_t)M * NU * 2 == WS_Y && WS_H + (size_t)M * D * 2 == WS_U && 2 * LW * 2 == WS_H, "ws map 2");

constexpr int LDS_BYTES = 147456;
constexpr int NTHR = 512, NWAVES = 8;

constexpr int PH_PRE = 0, PH_PER_LAYER = 12, NPH = 1 + 2 * PH_PER_LAYER;
enum { P_A1 = 0, P_A2, P_A3, P_B1, P_C1, P_C2, P_C3, P_D1, P_D2, P_E1, P_E2, P_E3 };

struct Args { const float* in[28]; float* out; unsigned char* ws; int ph_lo, ph_hi; };
enum { I_XP = 0, I_XS, I_CK, I_CV, I_SWKV, I_SSHIFT, I_SCONV, I_SPOOL, I_NG, I_WG, I_WU, I_WD, I_WIN, I_WOUT, I_POOLW, I_POOLS, I_MU, I_W0, I_W2, I_A0, I_A2, I_G2, I_KK, I_KA, I_RK, I_LNW, I_LNB, I_CONVW };
typedef const __attribute__((address_space(4))) Args* KArgP;
__device__ __forceinline__ KArgP kargs() { KArgP p = (KArgP)__builtin_amdgcn_kernarg_segment_ptr(); asm volatile("" : "+s"(p)); return p; }

__device__ __forceinline__ unsigned f2bf(float f) { return (unsigned)__builtin_bit_cast(unsigned short, (__bf16)f); }
typedef float f32x2_t __attribute__((ext_vector_type(2))); typedef __bf16 bf16x2_t __attribute__((ext_vector_type(2)));
__device__ __forceinline__ unsigned pk2(float lo, float hi) { f32x2_t v = {lo, hi}; bf16x2_t b = __builtin_convertvector(v, bf16x2_t); return __builtin_bit_cast(unsigned, b); }
__device__ __forceinline__ float bf2f(unsigned h) { return __builtin_bit_cast(float, h << 16); }
__device__ __forceinline__ float bflo(unsigned w) { return __builtin_bit_cast(float, w << 16); }
__device__ __forceinline__ float bfhi(unsigned w) { return __builtin_bit_cast(float, w & 0xffff0000u); }
__device__ __forceinline__ float ldbf(const bf16* p) { return bf2f((unsigned)*p); }
template <int CTRL> __device__ __forceinline__ float dppf(float x) { return __builtin_bit_cast(float, __builtin_amdgcn_update_dpp(0, __builtin_bit_cast(int, x), CTRL, 0xF, 0xF, true)); }
__device__ __forceinline__ float red16(float x) {
    x += dppf<0xB1>(x);
    x += dppf<0x4E>(x);
    x += dppf<0x141>(x);
    x += dppf<0x140>(x);
    return x;
}
__device__ __forceinline__ float wave_sum(float v) {
    v = red16(v);
    const int iv = __builtin_bit_cast(int, v);
    return (__builtin_bit_cast(float, __builtin_amdgcn_readlane(iv, 0)) + __builtin_bit_cast(float, __builtin_amdgcn_readlane(iv, 16))) +
           (__builtin_bit_cast(float, __builtin_amdgcn_readlane(iv, 32)) + __builtin_bit_cast(float, __builtin_amdgcn_readlane(iv, 48)));
}
__device__ __forceinline__ void red16_2(float& a, float& b) {
    a += dppf<0xB1>(a); b += dppf<0xB1>(b);
    a += dppf<0x4E>(a); b += dppf<0x4E>(b);
    a += dppf<0x141>(a); b += dppf<0x141>(b);
    a += dppf<0x140>(a); b += dppf<0x140>(b);
}
typedef float f32x2v __attribute__((ext_vector_type(2)));
typedef __bf16 bf2_t __attribute__((ext_vector_type(2)));
__device__ __forceinline__ float dot2bf(unsigned a, unsigned b, float c) { return __builtin_amdgcn_fdot2_f32_bf16(__builtin_bit_cast(bf2_t, a), __builtin_bit_cast(bf2_t, b), c, false); }
__device__ __forceinline__ float sigmoid_f(float x) { return __builtin_amdgcn_rcpf(1.0f + __expf(-x)); }
__device__ __forceinline__ float tanh_f(float x) { return 2.0f * sigmoid_f(2.0f * x) - 1.0f; }
__device__ __forceinline__ float softplus_f(float x) { return fmaxf(x, 0.f) + __logf(1.0f + __expf(-fabsf(x))); }

__device__ __forceinline__ void transpose_item(const float* __restrict__ W, int K, int N, bf16* WT, int dst_row0, float* scr, int kb, int n0, int lane) {
    const int k0 = 64 * kb;
    float wv[32];
#pragma unroll
    for (int i = 0; i < 32; ++i) wv[i] = W[(size_t)(k0 + 2 * i + (lane >> 5)) * N + n0 + (lane & 31)];
#pragma unroll
    for (int i = 0; i < 32; ++i) scr[(2 * i + (lane >> 5)) * 33 + (lane & 31)] = wv[i];
    asm volatile("s_waitcnt lgkmcnt(0)" ::: "memory");
    const int c = lane & 7;
#pragma unroll
    for (int j = 0; j < 4; ++j) { const int n = (lane >> 3) + 8 * j; const float* s = scr + (8 * c) * 33 + n;
        u32x4 o; o.x = pk2(s[0 * 33], s[1 * 33]); o.y = pk2(s[2 * 33], s[3 * 33]); o.z = pk2(s[4 * 33], s[5 * 33]); o.w = pk2(s[6 * 33], s[7 * 33]);
        *(u32x4*)(WT + (size_t)(dst_row0 + n) * K + k0 + 8 * c) = o; }
    asm volatile("s_waitcnt lgkmcnt(0)" ::: "memory");
}
__device__ __forceinline__ int win_rowmap(int n0) { return n0 < 256 ? UPOOL + n0 : (n0 < 1152 ? URW + (n0 - 256) : (n0 < 1920 ? UCB + (n0 - 1152) : n0 - 1920)); }

__device__ __forceinline__ void norm_row_to_bf16(const float* xrow, const float* g, bf16* hrow, int lane) {
    f32x4 v[4]; float s = 0.f;
#pragma unroll
    for (int j = 0; j < 4; ++j) { v[j] = *((const f32x4*)xrow + lane + 64 * j); s += (v[j].x * v[j].x + v[j].y * v[j].y) + (v[j].z * v[j].z + v[j].w * v[j].w); }
    const float rstd = rsqrtf(wave_sum(s) * (1.f / D) + RMS_EPS);
#pragma unroll
    for (int j = 0; j < 4; ++j) { const f32x4 gg = *((const f32x4*)g + lane + 64 * j); u32x2 o; o.x = pk2(v[j].x * rstd * gg.x, v[j].y * rstd * gg.y); o.y = pk2(v[j].z * rstd * gg.z, v[j].w * rstd * gg.w);
        *((u32x2*)hrow + lane + 64 * j) = o; }
}

__device__ __forceinline__ void phase_pre(const Args& a, unsigned char* lds) {
    KArgP ap = kargs(); unsigned char* ws_l = ap->ws; float* out_l = ap->out; (void)ws_l; (void)out_l;
    const float* in_I_NG = ap->in[I_NG];
    const float* in_I_WD = ap->in[I_WD];
    const float* in_I_WG = ap->in[I_WG];
    const float* in_I_WIN = ap->in[I_WIN];
    const float* in_I_WOUT = ap->in[I_WOUT];
    const float* in_I_WU = ap->in[I_WU];
    const float* in_I_XP = ap->in[I_XP];
    const float* in_I_XS = ap->in[I_XS];
    const int tid = ltid(), lane = tid & 63, wave = tid >> 6, G = gridDim.x;
    const int gw = blockIdx.x * NWAVES + wave, NGW = G * NWAVES;
    float* scr = (float*)(lds + wave * 16384);
    bf16* Wb = (bf16*)(ws_l + WS_W);
    constexpr int IT_L = 10304;
    for (int it = gw; it < 2 * IT_L; it += NGW) {
        const int l = it / IT_L; int r = it % IT_L; bf16* WL = Wb + (size_t)l * LW;
        const float* src; int K, N; bf16* dst; int mode;
        if (r < 1408)      { src = in_I_WG + (size_t)(l * 2 + 0) * D * FF; K = D; N = FF; dst = WL + W_GUA; mode = 1; }
        else if ((r -= 1408) < 1408) { src = in_I_WU + (size_t)(l * 2 + 0) * D * FF; K = D; N = FF; dst = WL + W_GUA; mode = 2; }
        else if ((r -= 1408) < 1408) { src = in_I_WD + (size_t)(l * 2 + 0) * FF * D; K = FF; N = D; dst = WL + W_DA; mode = 0; }
        else if ((r -= 1408) < 1344) { src = in_I_WIN + (size_t)l * D * 2688; K = D; N = 2688; dst = WL + W_IN; mode = 3; }
        else if ((r -= 1344) < 512)  { src = in_I_WOUT + (size_t)l * D * D; K = D; N = D; dst = WL + W_OUT; mode = 0; }
        else if ((r -= 512) < 1408)  { src = in_I_WG + (size_t)(l * 2 + 1) * D * FF; K = D; N = FF; dst = WL + W_GUB; mode = 1; }
        else if ((r -= 1408) < 1408) { src = in_I_WU + (size_t)(l * 2 + 1) * D * FF; K = D; N = FF; dst = WL + W_GUB; mode = 2; }
        else { r -= 1408;            src = in_I_WD + (size_t)(l * 2 + 1) * FF * D; K = FF; N = D; dst = WL + W_DB; mode = 0; }
        const int nblk = N / 32, kb = r / nblk, n0 = 32 * (r % nblk);
        int dr = n0;
        if (mode == 1) dr = 256 * (n0 >> 7) + (n0 & 127); else if (mode == 2) dr = 256 * (n0 >> 7) + 128 + (n0 & 127); else if (mode == 3) dr = win_rowmap(n0);
        transpose_item(src, K, N, dst, dr, scr, kb, n0, lane);
    }
    const int gt = blockIdx.x * NTHR + tid, NGT = G * NTHR;
    for (int i = gt; i < 2 * 16384 + 16384; i += NGT) {
        u32x4 z = {0u, 0u, 0u, 0u};
        if (i < 32768) { const int l = i >> 14, o = i & 16383; *((u32x4*)(Wb + (size_t)l * LW + W_IN + (size_t)2688 * D) + o) = z; }
        else { *((u32x4*)((bf16*)(ws_l + WS_H) + (size_t)MR * D) + (i - 32768)) = z; }
    }
    bf16* H = (bf16*)(ws_l + WS_H);
    for (int m = gw; m < MR; m += NGW) {
        const float* xr = m < MP ? in_I_XP + (size_t)m * D : in_I_XS + (size_t)(m - MP) * D;
        norm_row_to_bf16(xr, in_I_NG, H + (size_t)m * D, lane);
    }
}

template <bool SRC_F32, bool DST_F32, bool HAS_H>
__device__ __forceinline__ void phase_rowpass(const void* xp, const void* xs, const bf16* Y, float coef, const float* gpost, const float* gpre, void* xdst, bf16* H) {
    const int tid = ltid(), lane = tid & 63, wave = tid >> 6;
    const int gw = blockIdx.x * NWAVES + wave, NGW = gridDim.x * NWAVES;
    f32x4 y[4], x[4], nxf[4]; u32x2 ny[4], nxb[4];
#define RP_LOAD(m_) do { const bf16* yr_ = Y + (size_t)(m_) * D; \
        _Pragma("unroll") for (int j = 0; j < 4; ++j) ny[j] = *((const u32x2*)yr_ + lane + 64 * j); \
        if (SRC_F32) { const float* xr_ = (m_) < MP ? (const float*)xp + (size_t)(m_) * D : (const float*)xs + (size_t)((m_) - MP) * D; \
            _Pragma("unroll") for (int j = 0; j < 4; ++j) nxf[j] = *((const f32x4*)xr_ + lane + 64 * j); } \
        else { const bf16* xr_ = (const bf16*)xp + (size_t)(m_) * D; \
            _Pragma("unroll") for (int j = 0; j < 4; ++j) nxb[j] = *((const u32x2*)xr_ + lane + 64 * j); } } while (0)
    if (gw < MR) RP_LOAD(gw);
    for (int m = gw; m < MR; m += NGW) {
#pragma unroll
        for (int j = 0; j < 4; ++j) { y[j] = (f32x4){bflo(ny[j].x), bfhi(ny[j].x), bflo(ny[j].y), bfhi(ny[j].y)};
            x[j] = SRC_F32 ? nxf[j] : (f32x4){bflo(nxb[j].x), bfhi(nxb[j].x), bflo(nxb[j].y), bfhi(nxb[j].y)}; }
        if (m + NGW < MR) RP_LOAD(m + NGW);
        float s = 0.f;
#pragma unroll
        for (int j = 0; j < 4; ++j) s += (y[j].x * y[j].x + y[j].y * y[j].y) + (y[j].z * y[j].z + y[j].w * y[j].w);
        const float rstd = rsqrtf(wave_sum(s) * (1.f / D) + RMS_EPS) * coef;
        float s2 = 0.f;
#pragma unroll
        for (int j = 0; j < 4; ++j) { const f32x4 gg = *((const f32x4*)gpost + lane + 64 * j);
            x[j].x += y[j].x * rstd * gg.x; x[j].y += y[j].y * rstd * gg.y; x[j].z += y[j].z * rstd * gg.z; x[j].w += y[j].w * rstd * gg.w;
            s2 += (x[j].x * x[j].x + x[j].y * x[j].y) + (x[j].z * x[j].z + x[j].w * x[j].w);
            if (DST_F32) *((f32x4*)((float*)xdst + (size_t)m * D) + lane + 64 * j) = x[j];
            else { u32x2 o; o.x = pk2(x[j].x, x[j].y); o.y = pk2(x[j].z, x[j].w); *((u32x2*)((bf16*)xdst + (size_t)m * D) + lane + 64 * j) = o; } }
        if (HAS_H) {
            const float r2 = rsqrtf(wave_sum(s2) * (1.f / D) + RMS_EPS);
#pragma unroll
            for (int j = 0; j < 4; ++j) { const f32x4 gg = *((const f32x4*)gpre + lane + 64 * j); u32x2 o; o.x = pk2(x[j].x * r2 * gg.x, x[j].y * r2 * gg.y); o.y = pk2(x[j].z * r2 * gg.z, x[j].w * r2 * gg.w);
                *((u32x2*)(H + (size_t)m * D) + lane + 64 * j) = o; }
        }
    }
#undef RP_LOAD
}

__device__ __forceinline__ void ld8(const bf16* p, float (&f)[8]) {
    const u32x4 w = *(const u32x4*)p;
    f[0] = bflo(w.x); f[1] = bfhi(w.x); f[2] = bflo(w.y); f[3] = bfhi(w.y); f[4] = bflo(w.z); f[5] = bfhi(w.z); f[6] = bflo(w.w); f[7] = bfhi(w.w);
}
__device__ __forceinline__ void conv_part(const Args& a, int l, int bid, int nblk) {
    const int tid = ltid();
    KArgP ap = kargs(); unsigned char* ws_l = ap->ws; float* out_l = ap->out; (void)ws_l; (void)out_l;
    const float* in_I_CONVW = ap->in[I_CONVW];
    const float* in_I_SCONV = ap->in[I_SCONV];
    const bf16* U = (const bf16*)(ws_l + WS_U); bf16* YC = (bf16*)(ws_l + WS_H);
    const float* cw = in_I_CONVW + (size_t)l * 3 * 256;
    const int gt = bid * NTHR + tid, NGT = nblk * NTHR;
    for (int it = gt; it < MR * 32; it += NGT) {
        const int row = it >> 5, c8 = (it & 31) * 8;
        int b, t, Tn; const float* prefix; float* sout;
        if (row < MP) { b = row >> 12; t = row & 4095; Tn = T; prefix = nullptr; sout = out_l + O_PCONV + (size_t)(l * NB + b) * 2 * 256; }
        else { const int rr = row - MP; b = rr >> 4; t = rr & 15; Tn = TS; prefix = in_I_SCONV + (size_t)(l * NB + b) * 2 * 256; sout = out_l + O_SCONV + (size_t)(l * NB + b) * 2 * 256; }
        const bf16* ur = U + (size_t)row * NU;
        float bg[8], z0[8], z1[8], z2[8], cc[8], xx[8];
        ld8(ur + UCB + c8, bg); ld8(ur + UCC + c8, cc); ld8(ur + UCX + c8, xx);
#pragma unroll
        for (int i = 0; i < 8; ++i) z2[i] = cc[i] * xx[i];
        if (t >= 1) { ld8(ur - NU + UCC + c8, cc); ld8(ur - NU + UCX + c8, xx);
#pragma unroll
            for (int i = 0; i < 8; ++i) z1[i] = cc[i] * xx[i]; }
        else {
#pragma unroll
            for (int i = 0; i < 8; ++i) z1[i] = prefix ? prefix[256 + c8 + i] : 0.f; }
        if (t >= 2) { ld8(ur - 2 * NU + UCC + c8, cc); ld8(ur - 2 * NU + UCX + c8, xx);
#pragma unroll
            for (int i = 0; i < 8; ++i) z0[i] = cc[i] * xx[i]; }
        else {
#pragma unroll
            for (int i = 0; i < 8; ++i) z0[i] = prefix ? prefix[(t + 0) * 256 + c8 + i] : 0.f; }
        float y[8];
#pragma unroll
        for (int i = 0; i < 8; ++i) y[i] = bg[i] * (z0[i] * cw[c8 + i] + z1[i] * cw[256 + c8 + i] + z2[i] * cw[512 + c8 + i]);
        u32x4 o; o.x = pk2(y[0], y[1]); o.y = pk2(y[2], y[3]); o.z = pk2(y[4], y[5]); o.w = pk2(y[6], y[7]);
        *(u32x4*)(YC + (size_t)row * D + 512 + c8) = o;
        if (t >= Tn - 2) { float* so = sout + (size_t)(t - (Tn - 2)) * 256 + c8;
            *(f32x4*)so = (f32x4){z2[0], z2[1], z2[2], z2[3]}; *(f32x4*)(so + 4) = (f32x4){z2[4], z2[5], z2[6], z2[7]}; }
    }
}

template <int W>
__device__ __forceinline__ void pool_window(const float (&vals)[31], int pos0, float (&d)[16]) {
#pragma unroll
    for (int i = 0; i < 16; ++i) {
        float s = 0.f;
#pragma unroll
        for (int k = 0; k < W; ++k) s += vals[15 + i - k];
        const int cnt = (pos0 + i + 1) < W ? (pos0 + i + 1) : W;
        d[i] = s / (float)cnt - vals[15 + i];
    }
}
__device__ __forceinline__ void pool_part(const Args& a, int l, unsigned char* lds, int bid, int nblk) {
    KArgP ap = kargs(); unsigned char* ws_l = ap->ws; float* out_l = ap->out; (void)ws_l; (void)out_l;
    const float* in_I_POOLS = ap->in[I_POOLS];
    const float* in_I_POOLW = ap->in[I_POOLW];
    const float* in_I_SPOOL = ap->in[I_SPOOL];
    const bf16* U = (const bf16*)(ws_l + WS_U); bf16* YC = (bf16*)(ws_l + WS_H);
    bf16* dl = (bf16*)lds;
    const int tid = ltid(), c = tid & 255, th = tid >> 8, gi = c >> 6;
    const float* pw = in_I_POOLW + (size_t)(l * 4 + gi) * 64 * 64 + (c & 63);
    const float scale = in_I_POOLS[l * 256 + c];
    for (int item = bid; item < MR / 32; item += nblk) {
        const int row0 = item * 32 + th * 16;
        int b, t0, pos0, Tn; const float* prefix; float* sout;
        if (row0 < MP) { b = row0 >> 12; t0 = row0 & 4095; pos0 = t0; Tn = T; prefix = nullptr; sout = out_l + O_PPOOL + (size_t)(l * NB + b) * 15 * 256; }
        else { const int rr = row0 - MP; b = rr >> 4; t0 = 0; pos0 = PAST; Tn = TS; prefix = in_I_SPOOL + (size_t)(l * NB + b) * 15 * 256; sout = out_l + O_SPOOL + (size_t)(l * NB + b) * 15 * 256; }
        float vals[31];
#pragma unroll
        for (int i = 0; i < 31; ++i) {
            const int tt = t0 - 15 + i;
            vals[i] = (tt >= 0) ? ldbf(U + (size_t)(row0 - 15 + i) * NU + UPOOL + c) : (prefix ? prefix[(size_t)(i + t0) * 256 + c] : 0.f);
        }
        float d[16];
        if (gi == 0) pool_window<2>(vals, pos0, d); else if (gi == 1) pool_window<4>(vals, pos0, d); else if (gi == 2) pool_window<8>(vals, pos0, d); else pool_window<16>(vals, pos0, d);
#pragma unroll
        for (int i = 0; i < 16; ++i) {
            dl[(th * 16 + i) * 256 + c] = (bf16)f2bf(d[i]);
            const int t = t0 + i; if (t >= Tn - 15) sout[(size_t)(t - (Tn - 15)) * 256 + c] = vals[15 + i];
        }
        __syncthreads();
        float acc[16];
#pragma unroll
        for (int i = 0; i < 16; ++i) acc[i] = 0.f;
        for (int j8 = 0; j8 < 8; ++j8) {
            const unsigned w01 = pk2(pw[(8 * j8 + 0) * 64], pw[(8 * j8 + 1) * 64]), w23 = pk2(pw[(8 * j8 + 2) * 64], pw[(8 * j8 + 3) * 64]);
            const unsigned w45 = pk2(pw[(8 * j8 + 4) * 64], pw[(8 * j8 + 5) * 64]), w67 = pk2(pw[(8 * j8 + 6) * 64], pw[(8 * j8 + 7) * 64]);
#pragma unroll
            for (int i = 0; i < 16; ++i) { const u32x4 dv = *(const u32x4*)(dl + (th * 16 + i) * 256 + gi * 64 + 8 * j8);
                acc[i] = dot2bf(dv.w, w67, dot2bf(dv.z, w45, dot2bf(dv.y, w23, dot2bf(dv.x, w01, acc[i])))); }
        }
#pragma unroll
        for (int i = 0; i < 16; ++i) YC[(size_t)(row0 + i) * D + c] = (bf16)f2bf(acc[i] * scale);
        __syncthreads();
    }
}

__device__ __forceinline__ size_t rec_index(int row, int h) {
    if (row < MP) { const int b = row >> 12, t = row & 4095; return ((size_t)b * T) * 4 + (size_t)h * T + t; }
    const int rr = row - MP, b = rr >> 4, t = rr & 15; return ((size_t)MP + (size_t)b * TS) * 4 + (size_t)h * TS + t;
}
__device__ __forceinline__ void rwkv_prep_part(const Args& a, int l, unsigned char* lds) {
    const int tid = ltid();
    KArgP ap = kargs(); unsigned char* ws_l = ap->ws; float* out_l = ap->out;
    const float* in_I_A0 = ap->in[I_A0]; const float* in_I_A2 = ap->in[I_A2]; const float* in_I_G2 = ap->in[I_G2]; const float* in_I_KA = ap->in[I_KA]; const float* in_I_KK = ap->in[I_KK];
    const float* in_I_MU = ap->in[I_MU]; const float* in_I_RK = ap->in[I_RK]; const float* in_I_SSHIFT = ap->in[I_SSHIFT]; const float* in_I_W0 = ap->in[I_W0]; const float* in_I_W2 = ap->in[I_W2];
    const bf16* U = (const bf16*)(ws_l + WS_U);
    unsigned char* SIN = ws_l + WS_SIN; bf16* Gb = (bf16*)(ws_l + WS_G); float* RKb = (float*)(ws_l + WS_RK);
    bf16* lrb = (bf16*)lds;
    const int lane = tid & 63, c = tid & 255, half = tid >> 8, h = c >> 6, cc = c & 63;
    const float* mu = in_I_MU + (size_t)l * RW;
    const float mur = mu[c], muk = mu[256 + c], muv = mu[512 + c];
    const float w0c = in_I_W0[l * 256 + c], a0c = in_I_A0[l * 256 + c], kkc = in_I_KK[l * 256 + c], kac = in_I_KA[l * 256 + c], rkc = in_I_RK[l * 256 + c];
    unsigned w2p[16], a2p[16], g2p[32];
#pragma unroll
    for (int i = 0; i < 16; ++i) { w2p[i] = pk2(in_I_W2[(size_t)(l * 32 + 2 * i) * 256 + c], in_I_W2[(size_t)(l * 32 + 2 * i + 1) * 256 + c]);
                                   a2p[i] = pk2(in_I_A2[(size_t)(l * 32 + 2 * i) * 256 + c], in_I_A2[(size_t)(l * 32 + 2 * i + 1) * 256 + c]); }
#pragma unroll
    for (int i = 0; i < 32; ++i) g2p[i] = pk2(in_I_G2[(size_t)(l * 64 + 2 * i) * 256 + c], in_I_G2[(size_t)(l * 64 + 2 * i + 1) * 256 + c]);
    constexpr int TPI = 16, TPH = 8;
    for (int item = blockIdx.x; item < MR / TPI; item += gridDim.x) {
        const int row0 = item * TPI;
#pragma unroll
        for (int k = 0; k < TPI / 4; ++k) {
            const int idx = tid + NTHR * k, tok = idx >> 7, col = idx & 127, row = row0 + tok;
            int t, Tn; const float* shift; float* sout;
            if (row < MP) { t = row & 4095; Tn = T; shift = nullptr; sout = out_l + O_PSHIFT + (size_t)(l * NB + (row >> 12)) * RW; }
            else { const int rr = row - MP; t = rr & 15; Tn = TS; shift = in_I_SSHIFT + (size_t)(l * NB + (rr >> 4)) * RW; sout = out_l + O_SSHIFT + (size_t)(l * NB + (rr >> 4)) * RW; }
            const float cur = ldbf(U + (size_t)row * NU + URW + 768 + col);
            const float prev = (t > 0) ? ldbf(U + (size_t)(row - 1) * NU + URW + 768 + col) : (shift ? shift[768 + col] : 0.f);
            const float xs = cur + (prev - cur) * mu[768 + col];
            lrb[tok * 128 + col] = (bf16)f2bf(col < 32 ? tanh_f(xs) : (col < 64 ? xs : sigmoid_f(xs)));
            if (t == Tn - 1) sout[768 + col] = cur;
        }
        __syncthreads();
        const int rowh = row0 + half * TPH;
        int t0, Tn; const float* shift; float* sout;
        if (rowh < MP) { t0 = rowh & 4095; Tn = T; shift = nullptr; sout = out_l + O_PSHIFT + (size_t)(l * NB + (rowh >> 12)) * RW; }
        else { const int rr = rowh - MP; t0 = rr & 15; Tn = TS; shift = in_I_SSHIFT + (size_t)(l * NB + (rr >> 4)) * RW; sout = out_l + O_SSHIFT + (size_t)(l * NB + (rr >> 4)) * RW; }
        const bf16* ur = U + (size_t)rowh * NU + URW;
        float rp, kp, vp;
        if (t0 > 0) { rp = ldbf(ur - NU + c); kp = ldbf(ur - NU + 256 + c); vp = ldbf(ur - NU + 512 + c); }
        else if (shift) { rp = shift[c]; kp = shift[256 + c]; vp = shift[512 + c]; }
        else { rp = 0.f; kp = 0.f; vp = 0.f; }
        float rua[TPH], kua[TPH], vua[TPH];
#pragma unroll
        for (int i = 0; i < TPH; ++i) { rua[i] = ldbf(ur + (size_t)i * NU + c); kua[i] = ldbf(ur + (size_t)i * NU + 256 + c); vua[i] = ldbf(ur + (size_t)i * NU + 512 + c); }
#pragma unroll
        for (int i = 0; i < TPH; ++i) {
            const int tok = half * TPH + i, row = rowh + i, t = t0 + i;
            const float ru = rua[i], ku = kua[i], vu = vua[i];
            const float r = ru + (rp - ru) * mur, k = ku + (kp - ku) * muk, v = vu + (vp - vu) * muv;
            rp = ru; kp = ku; vp = vu;
            if (t == Tn - 1) { sout[c] = ru; sout[256 + c] = ku; sout[512 + c] = vu; }
            const u32x4* lt = (const u32x4*)(lrb + tok * 128);
            float wp = w0c, ap2 = a0c, gg = 0.f;
#pragma unroll
            for (int j = 0; j < 4; ++j) { const u32x4 x = lt[j]; wp = dot2bf(x.x, w2p[4 * j], wp); wp = dot2bf(x.y, w2p[4 * j + 1], wp); wp = dot2bf(x.z, w2p[4 * j + 2], wp); wp = dot2bf(x.w, w2p[4 * j + 3], wp); }
#pragma unroll
            for (int j = 0; j < 4; ++j) { const u32x4 x = lt[4 + j]; ap2 = dot2bf(x.x, a2p[4 * j], ap2); ap2 = dot2bf(x.y, a2p[4 * j + 1], ap2); ap2 = dot2bf(x.z, a2p[4 * j + 2], ap2); ap2 = dot2bf(x.w, a2p[4 * j + 3], ap2); }
#pragma unroll
            for (int j = 0; j < 8; ++j) { const u32x4 x = lt[8 + j]; gg = dot2bf(x.x, g2p[4 * j], gg); gg = dot2bf(x.y, g2p[4 * j + 1], gg); gg = dot2bf(x.z, g2p[4 * j + 2], gg); gg = dot2bf(x.w, g2p[4 * j + 3], gg); }
            const float w = -softplus_f(-wp) - 0.5f;
            const float decay = __expf(-__expf(w));
            const float aa = sigmoid_f(ap2);
            const float kkr = k * kkc;
            const float nrm = sqrtf(wave_sum(kkr * kkr));
            const float kk = kkr / fmaxf(nrm, 1e-12f);
            const float kh = k * (1.0f + (aa - 1.0f) * kac);
            const float rks = wave_sum(r * kh * rkc);
            unsigned char* rec = SIN + rec_index(row, h) * REC;
            ((bf16*)rec)[cc] = (bf16)f2bf(r); ((bf16*)rec)[64 + cc] = (bf16)f2bf(kh); ((bf16*)rec)[128 + cc] = (bf16)f2bf(v); ((bf16*)rec)[192 + cc] = (bf16)f2bf(kk); ((bf16*)rec)[256 + cc] = (bf16)f2bf(aa);
            ((float*)(rec + 640))[cc] = decay;
            Gb[(size_t)row * 256 + c] = (bf16)f2bf(gg);
            if (lane == 0) RKb[(size_t)row * 4 + h] = rks;
        }
        __syncthreads();
    }
}
__device__ __forceinline__ void skv_part(const Args& a, int l) {
    const int tid = ltid();
    KArgP ap = kargs(); unsigned char* ws_l = ap->ws;
    const float* in_I_CK = ap->in[I_CK];
    const bf16* U = (const bf16*)(ws_l + WS_U); bf16* SK = (bf16*)(ws_l + WS_SKV);
    const int gt = blockIdx.x * NTHR + tid, NGT = gridDim.x * NTHR;
    for (int it = gt; it < NB * SKEYS * 32; it += NGT) {
        const int c8 = (it & 31) * 8, kr = it >> 5, b = kr / SKEYS, key = kr % SKEYS;
        bf16* dst = SK + ((size_t)b * SKEYS + key) * 256 + c8;
        if (key < PAST) {
            const float* src = in_I_CK + (((size_t)(l * NB + b) * PAST + key) * 256 + c8);
            const f32x4 x0 = *(const f32x4*)src, x1 = *(const f32x4*)(src + 4);
            u32x4 o; o.x = pk2(x0.x, x0.y); o.y = pk2(x0.z, x0.w); o.z = pk2(x1.x, x1.y); o.w = pk2(x1.z, x1.w);
            *(u32x4*)dst = o;
        } else {
            *(u32x4*)dst = *(const u32x4*)(U + (size_t)(MP + b * TS + (key - PAST)) * NU + UK + c8);
        }
    }
}
__device__ __forceinline__ void vt_part(const Args& a, int l) {
    const int tid = ltid();
    KArgP ap = kargs(); unsigned char* ws_l = ap->ws;
    const float* in_I_CV = ap->in[I_CV];
    const bf16* U = (const bf16*)(ws_l + WS_U); bf16* VT = (bf16*)(ws_l + WS_VT); bf16* SVT = (bf16*)(ws_l + WS_SVT);
    const int lane = tid & 63, gw = blockIdx.x * NWAVES + (tid >> 6), NGW = gridDim.x * NWAVES;
    constexpr int NPI = 32 * (T / 64), NSI = 32 * (SKP / 64);
    for (int it = gw; it < NPI + NSI; it += NGW) {
        float v[64];
        bf16* dst;
        int pitch;
        if (it < NPI) {
            const int bh = it / (T / 64), tb = it % (T / 64), b = bh >> 2, h = bh & 3, t = tb * 64 + lane;
            const bf16* src = U + (size_t)(b * T + t) * NU + UV + h * 64;
#pragma unroll
            for (int q = 0; q < 8; ++q) { float f[8]; ld8(src + 8 * q, f);
#pragma unroll
                for (int i = 0; i < 8; ++i) v[8 * q + i] = f[i]; }
            dst = VT + (size_t)bh * 64 * VTP + t; pitch = VTP;
        } else {
            const int r = it - NPI, bh = r / (SKP / 64), kb = r % (SKP / 64), b = bh >> 2, h = bh & 3, key = kb * 64 + lane;
            if (key < PAST) { const float* src = in_I_CV + (((size_t)(l * NB + b) * PAST + key) * 256 + h * 64);
#pragma unroll
                for (int q = 0; q < 16; ++q) { const f32x4 x = *(const f32x4*)(src + 4 * q); v[4 * q] = x.x; v[4 * q + 1] = x.y; v[4 * q + 2] = x.z; v[4 * q + 3] = x.w; } }
            else if (key < SKEYS) { const bf16* src = U + (size_t)(MP + b * TS + (key - PAST)) * NU + UV + h * 64;
#pragma unroll
                for (int q = 0; q < 8; ++q) { float f[8]; ld8(src + 8 * q, f);
#pragma unroll
                    for (int i = 0; i < 8; ++i) v[8 * q + i] = f[i]; } }
            else {
#pragma unroll
                for (int i = 0; i < 64; ++i) v[i] = 0.f; }
            dst = SVT + (size_t)bh * 64 * SKP + key; pitch = SKP;
        }
#pragma unroll
        for (int d = 0; d < 64; ++d) dst[(size_t)d * pitch] = (bf16)f2bf(v[d]);
    }
}

constexpr int STEP_B = 1344;
template <int CH>
__device__ __forceinline__ void scan_unit(const Args& a, int l, int unit, unsigned char* lds) {
    constexpr int NP = CH / 16, CHUNK_B = CH * STEP_B;
    struct LdSet { u32x2 r[NP], kh[NP], kk[NP], aa[NP], v[NP]; f32x4 w[NP]; };
    const int tid = ltid();
    KArgP ap = kargs(); unsigned char* ws_l = ap->ws; float* out_l = ap->out;
    const float* in_I_SWKV = ap->in[I_SWKV];
    const int lane = tid & 63, wave = tid >> 6;
    const bool sample = unit >= 128; const int bh = (unit & 127) >> 2, rg = unit & 3, b = bh >> 2, h = bh & 3;
    const int Tn = sample ? TS : T, rowbase = sample ? MP + b * TS : b * T, nch = Tn / CH;
    const unsigned char* rec0 = ws_l + WS_SIN + ((size_t)rowbase * 4 + (size_t)h * Tn) * REC;
    float* YS = (float*)(ws_l + WS_YS);
    const bool loader = wave >= 4;
    const int lt = tid - 256, lstep = lt >> 4, ljq = lt & 15;
    const int rowl = lane >> 4, jq = lane & 15, vrow = rg * 16 + wave * 4 + rowl;
    f32x2v S01 = {0.f, 0.f}, S23 = {0.f, 0.f};
    if (!loader && sample) { const f32x4 s = *(const f32x4*)(in_I_SWKV + ((size_t)((l * NB + b) * 4 + h) * 64 + vrow) * 64 + 4 * jq); S01 = s.lo; S23 = s.hi; }
#define SC_LD(set, chunk) do { if ((chunk) < nch) { _Pragma("unroll") for (int q = 0; q < NP; ++q) { const unsigned char* rp = rec0 + (size_t)((chunk) * CH + 16 * q + lstep) * REC; \
        set.r[q] = *(const u32x2*)(rp + 8 * ljq); set.kh[q] = *(const u32x2*)(rp + 128 + 8 * ljq); set.kk[q] = *(const u32x2*)(rp + 384 + 8 * ljq); set.aa[q] = *(const u32x2*)(rp + 512 + 8 * ljq); \
        set.w[q] = *(const f32x4*)(rp + 640 + 16 * ljq); set.v[q] = *(const u32x2*)(rp + 256 + 2 * (rg * 16) + 8 * (ljq & 3)); } } } while (0)
#define SC_ST(set, bufi) do { _Pragma("unroll") for (int q = 0; q < NP; ++q) { unsigned char* sp = lds + (bufi) * CHUNK_B + (16 * q + lstep) * STEP_B; \
        const f32x4 kkf = {bflo(set.kk[q].x), bfhi(set.kk[q].x), bflo(set.kk[q].y), bfhi(set.kk[q].y)}; const f32x4 af = {bflo(set.aa[q].x), bfhi(set.aa[q].x), bflo(set.aa[q].y), bfhi(set.aa[q].y)}; \
        *(f32x4*)(sp + 16 * ljq) = (f32x4){bflo(set.r[q].x), bfhi(set.r[q].x), bflo(set.r[q].y), bfhi(set.r[q].y)}; \
        *(f32x4*)(sp + 256 + 16 * ljq) = set.w[q]; \
        *(f32x4*)(sp + 512 + 16 * ljq) = (f32x4){bflo(set.kh[q].x), bfhi(set.kh[q].x), bflo(set.kh[q].y), bfhi(set.kh[q].y)}; \
        *(f32x4*)(sp + 768 + 16 * ljq) = kkf; *(f32x4*)(sp + 1024 + 16 * ljq) = kkf * af; \
        if (ljq < 4) *(f32x4*)(sp + 1280 + 16 * ljq) = (f32x4){bflo(set.v[q].x), bfhi(set.v[q].x), bflo(set.v[q].y), bfhi(set.v[q].y)}; } } while (0)
#define SC_RD(slot, s_) do { const unsigned char* sp = cp + (s_) * STEP_B; rr[slot] = *(const f32x4*)(sp + 16 * jq); ww[slot] = *(const f32x4*)(sp + 256 + 16 * jq); kh[slot] = *(const f32x4*)(sp + 512 + 16 * jq); \
        kk[slot] = *(const f32x4*)(sp + 768 + 16 * jq); ka[slot] = *(const f32x4*)(sp + 1024 + 16 * jq); vv[slot] = *(const float*)(sp + 1280 + 4 * (wave * 4 + rowl)); } while (0)
#define SC_SCAN(bufi, chunk) do { const unsigned char* cp = lds + (bufi) * CHUNK_B; float* yp = YS + (size_t)(rowbase + (chunk) * CH + jq) * 256 + h * 64 + vrow; \
        f32x4 rr[3], ww[3], kh[3], kk[3], ka[3]; float vv[3]; float ysel = 0.f; f32x4 rprev = {0.f, 0.f, 0.f, 0.f}; \
        SC_RD(0, 0); SC_RD(1, 1); \
        _Pragma("unroll") for (int s = 0; s < CH; ++s) { const int c_ = s % 3; if (s > 0) rprev = rr[(s + 2) % 3]; if (s + 2 < CH) SC_RD((s + 2) % 3, s + 2); \
            const f32x2v p2 = S01 * kk[c_].lo + S23 * kk[c_].hi; float sa = p2.x + p2.y; \
            if (s > 0) { const f32x2v q2 = S01 * rprev.lo + S23 * rprev.hi; float yq = q2.x + q2.y; red16_2(sa, yq); ysel = (((s - 1) & 15) == jq) ? yq : ysel; if (((s - 1) & 15) == 15) yp[(size_t)(s - 16) * 256] = ysel; } \
            else sa = red16(sa); \
            const f32x2v vk01 = vv[c_] * kh[c_].lo, vk23 = vv[c_] * kh[c_].hi; \
            S01 = S01 * ww[c_].lo + (vk01 - sa * ka[c_].lo); S23 = S23 * ww[c_].hi + (vk23 - sa * ka[c_].hi); } \
        { const int p_ = (CH - 1) % 3; const f32x2v q2 = S01 * rr[p_].lo + S23 * rr[p_].hi; const float yq = red16(q2.x + q2.y); ysel = (15 == jq) ? yq : ysel; yp[(size_t)(CH - 16) * 256] = ysel; } } while (0)
    if (loader) {
        __builtin_amdgcn_s_setprio(2);
        LdSet A, B;
        SC_LD(A, 0); SC_ST(A, 0); SC_LD(A, 1); SC_LD(B, 2);
        __syncthreads();
        for (int ch = 0; ch < nch; ch += 2) {
            if (ch + 1 < nch) SC_ST(A, 1);
            SC_LD(A, ch + 3);
            __syncthreads();
            if (ch + 1 < nch) { if (ch + 2 < nch) SC_ST(B, 0); SC_LD(B, ch + 4); __syncthreads(); }
        }
        __builtin_amdgcn_s_setprio(0);
    } else {
        __syncthreads();
        for (int ch = 0; ch < nch; ch += 2) {
            SC_SCAN(0, ch);
            __syncthreads();
            if (ch + 1 < nch) { SC_SCAN(1, ch + 1); __syncthreads(); }
        }
    }
#undef SC_LD
#undef SC_ST
#undef SC_RD
#undef SC_SCAN
    if (!loader) {
        float* so = out_l + (sample ? O_SWKV : O_PWKV) + ((size_t)((l * NB + b) * 4 + h) * 64 + vrow) * 64 + 4 * jq;
        *(f32x4*)so = (f32x4){S01.x, S01.y, S23.x, S23.y};
    }
}

__device__ __forceinline__ f32x4 mfma16(bf16x8 A, bf16x8 B, f32x4 C) { return __builtin_amdgcn_mfma_f32_16x16x32_bf16(A, B, C, 0, 0, 0); }
__device__ __forceinline__ bf16x8 pack8(const f32x4 lo, const f32x4 hi) {
    u32x4 w; w.x = pk2(lo.x, lo.y); w.y = pk2(lo.z, lo.w); w.z = pk2(hi.x, hi.y); w.w = pk2(hi.z, hi.w); return __builtin_bit_cast(bf16x8, w);
}
__device__ __forceinline__ void attn_unit(const bf16* Q, int qp, const bf16* K, int kp, const bf16* VT, int vp, int qpos0, int kmax, bf16* O, int op, int lane) {
    const int fr = lane & 15, g = lane >> 4;
    bf16x8 qf[2];
#pragma unroll
    for (int ds = 0; ds < 2; ++ds) qf[ds] = *(const bf16x8*)(Q + (size_t)fr * qp + 32 * ds + 8 * g);
    f32x4 o[4];
#pragma unroll
    for (int i = 0; i < 4; ++i) o[i] = (f32x4){0.f, 0.f, 0.f, 0.f};
    float R = 0.f;
    const int qpos = qpos0 + fr;
    u32x4 onesw = {0x3F803F80u, 0x3F803F80u, 0x3F803F80u, 0x3F803F80u};
    const bf16x8 ones = __builtin_bit_cast(bf16x8, onesw);
    bf16x8 kf[4][2];
#define AT_LDK(kt_) do { _Pragma("unroll") for (int kb = 0; kb < 4; ++kb) { int kr = (kt_) * 64 + 16 * kb + fr; kr = kr > kmax ? kmax : kr; const bf16* krow = K + (size_t)kr * kp + 8 * g; \
        kf[kb][0] = *(const bf16x8*)krow; kf[kb][1] = *(const bf16x8*)(krow + 32); } } while (0)
    AT_LDK((qpos0 + 14) >> 6);
    for (int kt = (qpos0 + 14) >> 6; kt >= 0; --kt) {
        const int key0 = kt * 64;
        u32x2 vf[2][4][2];
#pragma unroll
        for (int ks = 0; ks < 2; ++ks)
#pragma unroll
            for (int db = 0; db < 4; ++db) { const bf16* vrow = VT + (size_t)(16 * db + fr) * vp + key0 + 32 * ks + 4 * g; vf[ks][db][0] = *(const u32x2*)vrow; vf[ks][db][1] = *(const u32x2*)(vrow + 16); }
        f32x4 z[4];
#pragma unroll
        for (int kb = 0; kb < 4; ++kb) {
            f32x4 acc = {0.f, 0.f, 0.f, 0.f};
            acc = mfma16(kf[kb][0], qf[0], acc);
            acc = mfma16(kf[kb][1], qf[1], acc);
            z[kb] = acc;
        }
        if (kt > 0) AT_LDK(kt - 1);
        f32x4 lk[4], ls[4]; bool vis[4][4];
#pragma unroll
        for (int kb = 0; kb < 4; ++kb)
#pragma unroll
            for (int r = 0; r < 4; ++r) {
                const int key = key0 + 16 * kb + 4 * g + r;
                const float zz = z[kb][r] * 0.125f, sp = softplus_f(zz);
                vis[kb][r] = key < qpos;
                lk[kb][r] = vis[kb][r] ? -sp : 0.f;
                ls[kb][r] = zz - sp;
            }
        bf16x8 Bhi[2], Blo[2];
#pragma unroll
        for (int ks = 0; ks < 2; ++ks) {
            u32x4 hw, lw;
            { const f32x4 x = lk[2 * ks]; const unsigned h01 = pk2(x.x, x.y), h23 = pk2(x.z, x.w); hw.x = h01; hw.y = h23; lw.x = pk2(x.x - bflo(h01), x.y - bfhi(h01)); lw.y = pk2(x.z - bflo(h23), x.w - bfhi(h23)); }
            { const f32x4 x = lk[2 * ks + 1]; const unsigned h01 = pk2(x.x, x.y), h23 = pk2(x.z, x.w); hw.z = h01; hw.w = h23; lw.z = pk2(x.x - bflo(h01), x.y - bfhi(h01)); lw.w = pk2(x.z - bflo(h23), x.w - bfhi(h23)); }
            Bhi[ks] = __builtin_bit_cast(bf16x8, hw); Blo[ks] = __builtin_bit_cast(bf16x8, lw);
        }
        f32x4 tot = {0.f, 0.f, 0.f, 0.f};
#pragma unroll
        for (int ks = 0; ks < 2; ++ks) { tot = mfma16(ones, Bhi[ks], tot); tot = mfma16(ones, Blo[ks], tot); }
        f32x4 p[4];
#pragma unroll
        for (int kb = 0; kb < 4; ++kb) {
            f32x4 la = {0.f, 0.f, 0.f, 0.f};
            const int s = 16 * kb + fr;
#pragma unroll
            for (int ks = 0; ks < 2; ++ks) {
                if (32 * ks + 31 > 16 * kb) {
                    u32x4 tw;
                    unsigned e[8];
#pragma unroll
                    for (int j = 0; j < 8; ++j) { const int jp = 32 * ks + 16 * (j >> 2) + 4 * g + (j & 3); e[j] = jp > s ? 0x3F80u : 0u; }
                    tw.x = e[0] | (e[1] << 16); tw.y = e[2] | (e[3] << 16); tw.z = e[4] | (e[5] << 16); tw.w = e[6] | (e[7] << 16);
                    const bf16x8 tri = __builtin_bit_cast(bf16x8, tw);
                    la = mfma16(tri, Bhi[ks], la); la = mfma16(tri, Blo[ks], la);
                }
            }
#pragma unroll
            for (int r = 0; r < 4; ++r) p[kb][r] = vis[kb][r] ? __expf(ls[kb][r] + la[r] + R) : 0.f;
        }
        R += tot[0];
#pragma unroll
        for (int ks = 0; ks < 2; ++ks) {
            const bf16x8 pf = pack8(p[2 * ks], p[2 * ks + 1]);
#pragma unroll
            for (int db = 0; db < 4; ++db) {
                u32x4 vw; vw.x = vf[ks][db][0].x; vw.y = vf[ks][db][0].y; vw.z = vf[ks][db][1].x; vw.w = vf[ks][db][1].y;
                o[db] = mfma16(__builtin_bit_cast(bf16x8, vw), pf, o[db]);
            }
        }
        if (__all(R < -110.f)) break;
    }
#undef AT_LDK
#pragma unroll
    for (int db = 0; db < 4; ++db) { u32x2 w; w.x = pk2(o[db][0], o[db][1]); w.y = pk2(o[db][2], o[db][3]); *(u32x2*)(O + (size_t)fr * op + 16 * db + 4 * g) = w; }
}
__device__ __forceinline__ void attn_part(const Args& a, int l, int aw, int naw) {
    const int tid = ltid();
    KArgP ap = kargs(); unsigned char* ws_l = ap->ws; float* out_l = ap->out; (void)ws_l; (void)out_l;
    const bf16* U = (const bf16*)(ws_l + WS_U); bf16* YC = (bf16*)(ws_l + WS_H);
    const bf16* SK = (const bf16*)(ws_l + WS_SKV); const bf16* VT = (const bf16*)(ws_l + WS_VT); const bf16* SVT = (const bf16*)(ws_l + WS_SVT);
    const int lane = tid & 63;
    constexpr int NPU = NB * 4 * (T / 16);
#define AT_PROMPT(bh_, qb_) do { const int b_ = (bh_) >> 2, h_ = (bh_) & 3; const int row0_ = b_ * T + (qb_) * 16; \
        attn_unit(U + (size_t)row0_ * NU + UQ + h_ * 64, NU, U + (size_t)(b_ * T) * NU + UK + h_ * 64, NU, VT + (size_t)(bh_) * 64 * VTP, VTP, (qb_) * 16, T - 1, YC + (size_t)row0_ * D + 768 + h_ * 64, D, lane); } while (0)
#define AT_SAMPLE(u_) do { const int b_ = (u_) >> 2, h_ = (u_) & 3; const int row0_ = MP + b_ * TS; \
        attn_unit(U + (size_t)row0_ * NU + UQ + h_ * 64, NU, SK + (size_t)b_ * SKEYS * 256 + h_ * 64, 256, SVT + (size_t)(u_) * 64 * SKP, SKP, PAST, SKEYS - 1, YC + (size_t)row0_ * D + 768 + h_ * 64, D, lane); } while (0)
    if (naw == 1024) {
        const int cb = aw >> 3, wv = aw & 7, xcd = cb & 7, wx = (cb >> 3) * 8 + wv;
        if (wx < 4) AT_SAMPLE(wx * 8 + xcd);
        for (int k = 0; k < 8; ++k) { const int i = wx + 128 * k; AT_PROMPT(xcd + 8 * (i >> 8), i & 255); }
    } else {
        for (int v = aw; v < NPU; v += naw) AT_PROMPT(v >> 8, v & 255);
        for (int u = aw; u < 32; u += naw) AT_SAMPLE(u);
    }
#undef AT_PROMPT
#undef AT_SAMPLE
}

__device__ __forceinline__ void rwkv_post(const Args& a, int l) {
    const int tid = ltid();
    KArgP ap = kargs(); unsigned char* ws_l = ap->ws;
    const float* in_I_LNB = ap->in[I_LNB]; const float* in_I_LNW = ap->in[I_LNW];
    const float* YS = (const float*)(ws_l + WS_YS); const bf16* Gb = (const bf16*)(ws_l + WS_G); const float* RKb = (const float*)(ws_l + WS_RK);
    bf16* YC = (bf16*)(ws_l + WS_H);
    const int lane = tid & 63, wave = tid >> 6, h = lane >> 4, c4 = 4 * lane, cc = 4 * (lane & 15);
    const f32x4 lnw = *(const f32x4*)(in_I_LNW + l * 256 + c4), lnb = *(const f32x4*)(in_I_LNB + l * 256 + c4);
    const int gw = blockIdx.x * NWAVES + wave, NGW = gridDim.x * NWAVES;
#define PO_BODY(row_, y_, gq_, vq_, rk_) do { \
        const float mean = red16((y_.x + y_.y) + (y_.z + y_.w)) * (1.f / 64.f); const f32x4 dv = y_ - mean; \
        const float var = red16((dv.x * dv.x + dv.y * dv.y) + (dv.z * dv.z + dv.w * dv.w)) * (1.f / 64.f); const float rs = rsqrtf(var + GN_EPS); \
        const float o0 = (dv.x * rs * lnw.x + lnb.x + rk_ * bflo(vq_.x)) * bflo(gq_.x), o1 = (dv.y * rs * lnw.y + lnb.y + rk_ * bfhi(vq_.x)) * bfhi(gq_.x); \
        const float o2 = (dv.z * rs * lnw.z + lnb.z + rk_ * bflo(vq_.y)) * bflo(gq_.y), o3 = (dv.w * rs * lnw.w + lnb.w + rk_ * bfhi(vq_.y)) * bfhi(gq_.y); \
        u32x2 o; o.x = pk2(o0, o1); o.y = pk2(o2, o3); *(u32x2*)(YC + (size_t)(row_) * D + 256 + c4) = o; } while (0)
#define PO_LOAD(r_, y_, g_, v_, k_) do { y_ = *(const f32x4*)(YS + (size_t)(r_) * 256 + c4); g_ = *(const u32x2*)(Gb + (size_t)(r_) * 256 + c4); \
        v_ = *(const u32x2*)(ws_l + WS_SIN + rec_index((r_), h) * REC + 256 + 2 * cc); k_ = RKb[(size_t)(r_) * 4 + h]; } while (0)
    for (int row = gw; row < MR; row += 4 * NGW) {
        f32x4 y0, y1, y2, y3; u32x2 g0, g1, g2, g3, v0, v1, v2, v3; float k0, k1, k2, k3;
        const int r1 = row + NGW, r2 = row + 2 * NGW, r3 = row + 3 * NGW;
        PO_LOAD(row, y0, g0, v0, k0);
        if (r1 < MR) PO_LOAD(r1, y1, g1, v1, k1);
        if (r2 < MR) PO_LOAD(r2, y2, g2, v2, k2);
        if (r3 < MR) PO_LOAD(r3, y3, g3, v3, k3);
        PO_BODY(row, y0, g0, v0, k0);
        if (r1 < MR) PO_BODY(r1, y1, g1, v1, k1);
        if (r2 < MR) PO_BODY(r2, y2, g2, v2, k2);
        if (r3 < MR) PO_BODY(r3, y3, g3, v3, k3);
    }
#undef PO_BODY
#undef PO_LOAD
}

template <int MODE, int K>
__device__ __forceinline__ void small_gemm(const bf16* A, const bf16* Bt, int ncol16, bf16* Ob, float* Of, int ldc, float* sk, float* sv, unsigned char* lds, int bid, int G) {
    constexpr int KW = K / 8, NKS = KW / 32, NB_ = (MODE == 1) ? 4 : 2;
    static_assert(KW % 32 == 0, "K split");
    const int tid = ltid(), lane = tid & 63, wave = tid >> 6, fr = lane & 15, g = lane >> 4;
    float* part = (float*)lds;
    const int ntile = 8 * (ncol16 / 2);
    bf16x8 af[NKS], b0[NKS], b1[NKS], b2[NKS], b3[NKS];
    int tile = bid;
#define SG_ROW(c_) ((MODE == 1) ? (256 * ((c_) >> 7) + ((c_) & 127)) : (c_))
#define SG_LOAD(tl) do { const int mt_ = (tl) & 7, c0_ = ((tl) >> 3) * 32; \
        const bf16* ap_ = A + (size_t)(mt_ * 16 + fr) * K + wave * KW + 8 * g; const bf16* bp_ = Bt + (size_t)(SG_ROW(c0_) + fr) * K + wave * KW + 8 * g; const bf16* bq_ = bp_ + (size_t)16 * K; \
        _Pragma("unroll") for (int q = 0; q < NKS; ++q) { af[q] = *(const bf16x8*)(ap_ + 32 * q); b0[q] = *(const bf16x8*)(bp_ + 32 * q); b1[q] = *(const bf16x8*)(bq_ + 32 * q); \
            if (MODE == 1) { b2[q] = *(const bf16x8*)(bp_ + (size_t)128 * K + 32 * q); b3[q] = *(const bf16x8*)(bq_ + (size_t)128 * K + 32 * q); } } } while (0)
    if (tile < ntile) SG_LOAD(tile);
    for (int it = 0; tile < ntile; ++it, tile += G) {
        f32x4 acc0 = {0.f, 0.f, 0.f, 0.f}, acc1 = acc0, acc2 = acc0, acc3 = acc0;
#pragma unroll
        for (int q = 0; q < NKS; ++q) { acc0 = mfma16(b0[q], af[q], acc0); acc1 = mfma16(b1[q], af[q], acc1); if (MODE == 1) { acc2 = mfma16(b2[q], af[q], acc2); acc3 = mfma16(b3[q], af[q], acc3); } }
        if (tile + G < ntile) SG_LOAD(tile + G);
        float* pb = part + (it & 1) * (8 * NB_ * 256);
        *(f32x4*)(pb + (wave * NB_ + 0) * 256 + lane * 4) = acc0; *(f32x4*)(pb + (wave * NB_ + 1) * 256 + lane * 4) = acc1;
        if (MODE == 1) { *(f32x4*)(pb + (wave * NB_ + 2) * 256 + lane * 4) = acc2; *(f32x4*)(pb + (wave * NB_ + 3) * 256 + lane * 4) = acc3; }
        __syncthreads();
        {
            const int sub = tid >> 8, e = tid & 255;
            float s0 = 0.f, s1 = 0.f;
#pragma unroll
            for (int w = 0; w < 8; ++w) { s0 += pb[(w * NB_ + sub) * 256 + e]; if (MODE == 1) s1 += pb[(w * NB_ + 2 + sub) * 256 + e]; }
            const int ln = e >> 2, r = e & 3, mt = tile & 7, c0 = (tile >> 3) * 32 + 16 * sub;
            const int m = mt * 16 + (ln & 15), n = c0 + 4 * (ln >> 4) + r;
            if (MODE == 0) Ob[(size_t)m * ldc + n] = (bf16)f2bf(s0);
            else if (MODE == 1) Ob[(size_t)m * ldc + n] = (bf16)f2bf(pg8::silu_f(s0) * s1);
            else { Ob[(size_t)m * ldc + n] = (bf16)f2bf(s0); if (n >= UK && n < UK + 512) ((n < UV ? sk : sv) + (size_t)m * 256)[n & 255] = s0; }
        }
    }
#undef SG_LOAD
#undef SG_ROW
    __syncthreads();
}

#define XB_TMO      128
#define XB_XCNT(j)  (256  + 64 * (j))
#define XB_XSUB(j)  (1280 + 64 * (j))
#define XB_XGEN(j)  (2304 + 64 * (j))
#define XB_TOP      3328
#define XB_TOPGEN   3392
#define XCD_BAR_WORDS 3456
#define XB_SPIN_CAP (1u << 18)

__device__ __forceinline__ unsigned xb_ld(unsigned* p)              { return __hip_atomic_load(p, __ATOMIC_RELAXED, __HIP_MEMORY_SCOPE_AGENT); }
__device__ __forceinline__ unsigned xb_add(unsigned* p, unsigned v) { return __hip_atomic_fetch_add(p, v, __ATOMIC_RELAXED, __HIP_MEMORY_SCOPE_AGENT); }
__device__ __forceinline__ unsigned xb_xcc_id() { return (unsigned)__builtin_amdgcn_s_getreg((3 << 11) | 20) & 0xFu; }
#define XB_SPIN(cond, bar) do { unsigned _sp = 0; while (cond) { __builtin_amdgcn_s_sleep(1); \
    if ((++_sp & 255u) == 0u) { if (xb_ld(&(bar)[XB_TMO])) break; if (_sp > XB_SPIN_CAP) { atomicAdd(&(bar)[XB_TMO], 1u); break; } } } } while (0)

struct XcdBarrier {
    unsigned* bar; unsigned x;
    volatile LAS unsigned* st;
};

__device__ __forceinline__ XcdBarrier xcd_barrier_post(unsigned* bar, volatile LAS unsigned* st) {
    XcdBarrier b; b.bar = bar; b.x = xb_xcc_id(); b.st = st;
    if (threadIdx.x == 0) (void)xb_add(&bar[XB_XCNT(b.x)], 1u);
    return b;
}
__device__ __forceinline__ void xcd_barrier_complete(unsigned* bar, unsigned x, unsigned& nloc, unsigned& nx) {
    const unsigned G = gridDim.x * gridDim.y * gridDim.z;
    unsigned sum, cnt, mine, sp = 0u;
    for (;;) {
        sum = 0u; cnt = 0u; mine = 0u;
#pragma unroll
        for (unsigned j = 0; j < 16; ++j) { const unsigned c = xb_ld(&bar[XB_XCNT(j)]); sum += c; cnt += (c > 0u) ? 1u : 0u; mine = (j == x) ? c : mine; }
        if (sum == G) break;
        __builtin_amdgcn_s_sleep(1);
        if ((++sp & 255u) == 0u) { if (xb_ld(&bar[XB_TMO])) break; if (sp > XB_SPIN_CAP) { atomicAdd(&bar[XB_TMO], 1u); break; } }
    }
    nloc = mine > 0u ? mine : 1u; nx = cnt > 0u ? cnt : 1u;
}

__device__ __forceinline__ void xcd_barrier(const XcdBarrier& b) {
    asm volatile("s_waitcnt vmcnt(0)" ::: "memory");
    __syncthreads();
    if (threadIdx.x == 0) {
        unsigned* bar = b.bar;
        __builtin_amdgcn_s_waitcnt(0);
        unsigned nloc = b.st[0], nx = b.st[1];
        if (nloc == 0u) { xcd_barrier_complete(bar, b.x, nloc, nx); b.st[0] = nloc; b.st[1] = nx; }
        const unsigned old = xb_add(&bar[XB_XSUB(b.x)], 1u);
        const unsigned gen = old / nloc;
        if (old + 1u == (gen + 1u) * nloc) {
            __builtin_amdgcn_fence(__ATOMIC_RELEASE, "agent");
            asm volatile("s_waitcnt vmcnt(0)" ::: "memory");
            const unsigned og = xb_add(&bar[XB_TOP], 1u);
            const unsigned tg = og / nx;
            if (og + 1u == (tg + 1u) * nx) xb_add(&bar[XB_TOPGEN], 1u);
            else XB_SPIN(xb_ld(&bar[XB_TOPGEN]) == tg, bar);
            __builtin_amdgcn_fence(__ATOMIC_ACQUIRE, "agent");
            xb_add(&bar[XB_XGEN(b.x)], 1u);
            asm volatile("s_waitcnt vmcnt(0)" ::: "memory");
        } else {
            XB_SPIN(xb_ld(&bar[XB_XGEN(b.x)]) == gen, bar);
            __builtin_amdgcn_fence(__ATOMIC_ACQUIRE, "agent");
            asm volatile("s_waitcnt vmcnt(0)" ::: "memory");
        }
    }
    __syncthreads();
}

__global__ void __launch_bounds__(NTHR, 2) mk_fwd(Args a) {
    extern __shared__ __attribute__((aligned(16))) unsigned char lds[];
    cg::grid_group grid = cg::this_grid();
    const int lo = MK_PER_PHASE ? a.ph_lo : 0, hi = MK_PER_PHASE ? a.ph_hi : NPH, G = gridDim.x;
#define IN(k) (lo <= (k) && (k) < hi)
    for (int u_ = ltid(); u_ < 64; u_ += NTHR) ((LAS unsigned*)((LAS unsigned char*)lds + 131072))[u_] = 0u;
    __syncthreads();
    (void)xcd_barrier_post((unsigned*)(a.ws + WS_CTL), (volatile LAS unsigned*)((LAS unsigned char*)lds + 131072 + 64));
#define XBAR_NOW() do { XcdBarrier xb_; xb_.bar = (unsigned*)(kargs()->ws + WS_CTL); xb_.x = xb_xcc_id(); xb_.st = (volatile LAS unsigned*)((LAS unsigned char*)lds + 131072 + 64); xcd_barrier(xb_); } while (0)
#define SEAM(k) do { if (IN(k) && IN((k) + 1)) { if ((k) == PH_PRE) grid.sync(); else XBAR_NOW(); } } while (0)
    PG8_LAS unsigned char* ring = (PG8_LAS unsigned char*)lds;
#define PHASE_PTRS KArgP ap = kargs(); unsigned char* ws_ = ap->ws; float* out_ = ap->out; \
    bf16* Wb = (bf16*)(ws_ + WS_W); bf16* H = (bf16*)(ws_ + WS_H); bf16* ACT = (bf16*)(ws_ + WS_U); bf16* Y = (bf16*)(ws_ + WS_Y); float* X = out_ + O_X; bf16* XB = (bf16*)(out_ + O_X); bf16* XALT = (bf16*)(ws_ + WS_Y + (size_t)M * D * 2); \
    const bf16* WL = Wb + (size_t)l * LW; const float* ng = ap->in[I_NG] + (size_t)l * 6 * D; (void)H; (void)ACT; (void)Y; (void)X; (void)XB; (void)XALT; (void)WL; (void)ng;

#define REPEAT(bit) _Pragma("nounroll") for (int rep_ = 0; rep_ < ((REP & (bit)) ? 2 : 1); ++rep_)
#define RSYNC if (rep_) XBAR_NOW();
#define GEMM_MAIN(EPI, Aptr, Wptr, NN, KK, EOBJ) { pg8::Gemm g{Aptr, Wptr, MP, NN, KK}; pg8::StaticOrder S; S.init(MP, NN, G, (int)blockIdx.x); pg8::gemm_phase<EPI, pg8::StaticOrder, true, true>(ring, g, S, EOBJ); }
#define SMALL_IDS const int tid_ = ltid(); const int gw_ = (int)blockIdx.x * NWAVES + (tid_ >> 6), ngw_ = G * NWAVES, lane_ = tid_ & 63;
    if (REP & 16384) { for (int i = 0; i < 20; ++i) XBAR_NOW(); }
    if (IN(PH_PRE)) REPEAT(128) { RSYNC phase_pre(a, lds); }
    SEAM(PH_PRE);
    for (int l = 0; l < 2; ++l) {
        const int p0 = 1 + l * PH_PER_LAYER;
        if (IN(p0 + P_A1)) REPEAT(1) { RSYNC PHASE_PTRS
            { pg8::EpiSwiglu E{ACT, FF}; GEMM_MAIN(pg8::EpiSwiglu, H, WL + W_GUA, 2 * FF, D, E) }
            small_gemm<1, D>(H + (size_t)MP * D, WL + W_GUA, FF / 16, ACT + (size_t)MP * FF, nullptr, FF, nullptr, nullptr, lds, (int)blockIdx.x, G); }
        SEAM(p0 + P_A1);
        if (IN(p0 + P_A2)) REPEAT(2) { RSYNC PHASE_PTRS
            { pg8::EpiBf E{Y, D}; GEMM_MAIN(pg8::EpiBf, ACT, WL + W_DA, D, FF, E) }
            small_gemm<0, FF>(ACT + (size_t)MP * FF, WL + W_DA, D / 16, Y + (size_t)MP * D, nullptr, D, nullptr, nullptr, lds, (int)blockIdx.x, G); }
        SEAM(p0 + P_A2);
        if (IN(p0 + P_A3)) { PHASE_PTRS
            if (l == 0) phase_rowpass<true, false, true>(ap->in[I_XP], ap->in[I_XS], Y, 0.5f, ng + 1 * D, ng + 2 * D, XB, H);
            else        phase_rowpass<false, false, true>(XB, XB, Y, 0.5f, ng + 1 * D, ng + 2 * D, XB, H);
        }
        SEAM(p0 + P_A3);
        if (IN(p0 + P_B1)) REPEAT(4) { RSYNC PHASE_PTRS
            { pg8::EpiU E{ACT, NU, out_ + O_PK + (size_t)l * MP * 256, out_ + O_PV + (size_t)l * MP * 256, out_ + O_SK + (size_t)l * MS * 256, out_ + O_SV + (size_t)l * MS * 256, MP, MR};
              GEMM_MAIN(pg8::EpiU, H, WL + W_IN, NU, D, E) }
            if (G == 256) { if ((int)blockIdx.x >= 128) small_gemm<2, D>(H + (size_t)MP * D, WL + W_IN, NU / 16, ACT + (size_t)MP * NU, nullptr, NU, out_ + O_SK + (size_t)l * MS * 256, out_ + O_SV + (size_t)l * MS * 256, lds, (int)blockIdx.x - 128, 128); }
              else small_gemm<2, D>(H + (size_t)MP * D, WL + W_IN, NU / 16, ACT + (size_t)MP * NU, nullptr, NU, out_ + O_SK + (size_t)l * MS * 256, out_ + O_SV + (size_t)l * MS * 256, lds, (int)blockIdx.x, G); }
        SEAM(p0 + P_B1);
        if (IN(p0 + P_C1)) REPEAT(16) { RSYNC
            skv_part(a, l); vt_part(a, l);
            for (int r4_ = 0; r4_ < ((REP & 4096) ? 2 : 1); ++r4_) rwkv_prep_part(a, l, lds);
        }
        SEAM(p0 + P_C1);
        if (IN(p0 + P_C2)) REPEAT(32) { RSYNC
            _Pragma("nounroll") for (int r2_ = 0; r2_ < ((REP & 256) ? 2 : 1); ++r2_)
            for (int ub = blockIdx.x; ub < 256; ub += G) {
                const int c_ = ub & 127, xcd_ = c_ & 7, idx_ = c_ >> 3, u = (ub & 128) | (((xcd_ * 4 + (idx_ >> 2)) << 2) | (idx_ & 3));
                if (u < 128) scan_unit<32>(a, l, u, lds); else scan_unit<16>(a, l, u, lds); }
            const int ab0 = G / 2;
            if ((int)blockIdx.x >= ab0) { _Pragma("nounroll") for (int r3_ = 0; r3_ < ((REP & 512) ? 2 : 1); ++r3_) attn_part(a, l, ((int)blockIdx.x - ab0) * NWAVES + (int)(ltid() >> 6), (G - ab0) * NWAVES);
                for (int r4_ = 0; r4_ < ((REP & 1024) ? 2 : 1); ++r4_) conv_part(a, l, (int)blockIdx.x - ab0, G - ab0);
                for (int r4_ = 0; r4_ < ((REP & 2048) ? 2 : 1); ++r4_) pool_part(a, l, lds, (int)blockIdx.x - ab0, G - ab0); }
        }
        SEAM(p0 + P_C2);
        if (IN(p0 + P_C3)) REPEAT(64) { RSYNC rwkv_post(a, l); }
        SEAM(p0 + P_C3);
        if (IN(p0 + P_D1)) REPEAT(8) { RSYNC PHASE_PTRS
            { pg8::EpiBf E{Y, D}; GEMM_MAIN(pg8::EpiBf, H, WL + W_OUT, D, D, E) }
            small_gemm<0, D>(H + (size_t)MP * D, WL + W_OUT, D / 16, Y + (size_t)MP * D, nullptr, D, nullptr, nullptr, lds, (int)blockIdx.x, G); }
        SEAM(p0 + P_D1);
        if (IN(p0 + P_D2)) { PHASE_PTRS if (l == 0) phase_rowpass<false, false, true>(XB, XB, Y, 1.0f, ng + 3 * D, ng + 4 * D, XB, H);
            else        phase_rowpass<false, false, true>(XB, XB, Y, 1.0f, ng + 3 * D, ng + 4 * D, XALT, H); }
        SEAM(p0 + P_D2);
        if (IN(p0 + P_E1)) REPEAT(1) { RSYNC PHASE_PTRS
            { pg8::EpiSwiglu E{ACT, FF}; GEMM_MAIN(pg8::EpiSwiglu, H, WL + W_GUB, 2 * FF, D, E) }
            small_gemm<1, D>(H + (size_t)MP * D, WL + W_GUB, FF / 16, ACT + (size_t)MP * FF, nullptr, FF, nullptr, nullptr, lds, (int)blockIdx.x, G); }
        SEAM(p0 + P_E1);
        if (IN(p0 + P_E2)) REPEAT(2) { RSYNC PHASE_PTRS
            { pg8::EpiBf E{Y, D}; GEMM_MAIN(pg8::EpiBf, ACT, WL + W_DB, D, FF, E) }
            small_gemm<0, FF>(ACT + (size_t)MP * FF, WL + W_DB, D / 16, Y + (size_t)MP * D, nullptr, D, nullptr, nullptr, lds, (int)blockIdx.x, G); }
        SEAM(p0 + P_E2);
        if (IN(p0 + P_E3)) { PHASE_PTRS
            if (l == 0) phase_rowpass<false, false, true>(XB, XB, Y, 0.5f, ng + 5 * D, ng + 6 * D, XB, H);
            else        phase_rowpass<false, true, false>(XALT, XALT, Y, 0.5f, ng + 5 * D, ng, X, H);
        }
        SEAM(p0 + P_E3);
    }
#undef IN
#undef SEAM
}

extern "C" void kernel_launch(void* const* d_in, const int* in_sizes, int n_in, void* d_out, int out_size, void* d_ws, size_t ws_size, hipStream_t stream) {
    static int grid = 0;
    if (grid == 0) {
        if (n_in != 28 || (size_t)out_size != O_END || ws_size < WS_END) { fprintf(stderr, "kernel_launch: unexpected shapes: n_in %d out %d ws %zu (need %zu)\n", n_in, out_size, ws_size, (size_t)WS_END); grid = -1; return; }
        int dev = 0, cus = 0, per_cu = 0;
        if (hipGetDevice(&dev) != hipSuccess || hipDeviceGetAttribute(&cus, hipDeviceAttributeMultiprocessorCount, dev) != hipSuccess) { grid = -1; return; }
        if (hipFuncSetAttribute((const void*)mk_fwd, hipFuncAttributeMaxDynamicSharedMemorySize, LDS_BYTES) != hipSuccess) { fprintf(stderr, "kernel_launch: hipFuncSetAttribute failed\n"); grid = -1; return; }
        if (hipOccupancyMaxActiveBlocksPerMultiprocessor(&per_cu, (const void*)mk_fwd, NTHR, LDS_BYTES) != hipSuccess || per_cu < 1) { fprintf(stderr, "kernel_launch: occupancy query says %d\n", per_cu); per_cu = 1; }
        (void)hipGetLastError();
        grid = cus * 1;
    }
    if (grid < 0) return;
    if (hipMemsetAsync((char*)d_ws + WS_CTL, 0, 16384, stream) != hipSuccess) { fprintf(stderr, "kernel_launch: hipMemsetAsync failed\n"); return; }
    Args a{};
    for (int i = 0; i < 28; ++i) a.in[i] = (const float*)d_in[i];
    a.out = (float*)d_out; a.ws = (unsigned char*)d_ws;
#if MK_PER_PHASE
    for (int ph = 0; ph < NPH; ++ph) { a.ph_lo = ph; a.ph_hi = ph + 1; hipLaunchKernelGGL(mk_fwd, dim3(grid), dim3(NTHR), LDS_BYTES, stream, a); }
#else
    a.ph_lo = 0; a.ph_hi = NPH;
    void* args[] = {&a};
    hipError_t e = hipLaunchCooperativeKernel((const void*)mk_fwd, dim3(grid), dim3(NTHR), args, LDS_BYTES, stream);
    if (e != hipSuccess) fprintf(stderr, "kernel_launch: cooperative launch failed: %s (grid %d)\n", hipGetErrorString(e), grid);
#endif
}
```

```cpp
#include <hip/hip_runtime.h>
#include <hip/hip_cooperative_groups.h>
#include <cstdio>
#include <cstdint>
namespace cg = cooperative_groups;
#ifndef MK_PER_PHASE
#define MK_PER_PHASE 0
#endif
#ifndef DIS
#define DIS 0
#endif
__device__ __forceinline__ int ltid() { int t = threadIdx.x; asm volatile("" : "+v"(t)); return t; }
#ifndef REP
#define REP 0
#endif
namespace pg8 {
#define PG8_LAS __attribute__((address_space(3)))
typedef unsigned short bf16_t;
typedef short bf16x8 __attribute__((ext_vector_type(8)));
typedef float f32x4 __attribute__((ext_vector_type(4)));
typedef unsigned u32x4 __attribute__((ext_vector_type(4)));
constexpr int BM = 256, BK = 64, HALF = 128, HTB = HALF * BK * 2  , STAGE_BYTES = 8 * HTB, NXCD = 8, WGM = 8;

__host__ __device__ __forceinline__ int lds_byte(int r, int c) { const int st = (r >> 4) * 2 + (c >> 5), rr = r & 15, cc = c & 31, ob = rr * 64 + cc * 2; return st * 1024 + (ob ^ (((ob >> 9) & 1) << 5)); }
__host__ __device__ __forceinline__ void stage_rc(int b, int& R, int& C) { const int st = b / 1024, sb = b % 1024, swz = sb ^ (((sb >> 9) & 1) << 5); R = (st >> 1) * 16 + swz / 64; C = (st & 1) * 32 + (swz % 64) / 2; }
__host__ __device__ __forceinline__ int perm32(int rho) { const int n = rho >> 4, i = rho & 15; return 8 * (i >> 2) + 4 * n + (i & 3); }

struct Unit { int pm, pn; };
struct Gemm { const bf16_t* A; const bf16_t* Bt; int M, N, K; };

struct StaticOrder {
    int nM, nN, nwg, G, c;
    __host__ __device__ void init(int M, int N, int G_, int c_) { nM = M / BM; nN = N / BM; nwg = nM * nN; G = G_; c = c_; }
    __host__ __device__ bool next(int i, Unit& u) const {
        const long L = (long)i * G + c; if (L >= nwg) return false;
        int wgid = (int)L; { const int q = nwg / NXCD, r = nwg % NXCD, xcd = wgid % NXCD, off = wgid / NXCD; wgid = (xcd < r ? xcd * (q + 1) : r * (q + 1) + (xcd - r) * q) + off; }
        const int nig = WGM * nN, gid = wgid / nig, fm = gid * WGM, gsz = (nM - fm) < WGM ? (nM - fm) : WGM;
        u.pm = fm + ((wgid % nig) % gsz); u.pn = (wgid % nig) / gsz; return true;
    }
    __device__ __forceinline__ void a_ready(const Unit&) const {}
    __device__ __forceinline__ void done(const Unit&) const {}
};

__device__ __forceinline__ unsigned cvt_pk_bf16(float lo, float hi) { unsigned r; asm volatile("v_cvt_pk_bf16_f32 %0, %1, %2" : "=v"(r) : "v"(lo), "v"(hi)); return r; }

__device__ __forceinline__ float silu_f(float x) { return x * __builtin_amdgcn_rcpf(1.0f + __builtin_amdgcn_exp2f(-1.44269504089f * x)); }
struct EpiSwiglu {
    static constexpr bool PERM = true, AFTER_DRAIN = false;
    bf16_t* O; int ldc;
    __device__ __forceinline__ void operator()(const f32x4 (&acc)[2][2][4][2], const Unit& u, int wr, int wc, int fr, int fq) const {
        const int row0 = u.pm * BM + wr * 64 + fr, col0 = u.pn * HALF + wc * 32 + 8 * fq;
#pragma unroll
        for (int ai = 0; ai < 2; ++ai)
#pragma unroll
            for (int m = 0; m < 4; ++m) {
                bf16_t* rowp = O + (size_t)(row0 + ai * HALF + m * 16) * ldc + col0;
                const f32x4 g0 = acc[ai][0][m][0], g1 = acc[ai][0][m][1], u0 = acc[ai][1][m][0], u1 = acc[ai][1][m][1];
                u32x4 w;
                w.x = cvt_pk_bf16(silu_f(g0[0]) * u0[0], silu_f(g0[1]) * u0[1]); w.y = cvt_pk_bf16(silu_f(g0[2]) * u0[2], silu_f(g0[3]) * u0[3]);
                w.z = cvt_pk_bf16(silu_f(g1[0]) * u1[0], silu_f(g1[1]) * u1[1]); w.w = cvt_pk_bf16(silu_f(g1[2]) * u1[2], silu_f(g1[3]) * u1[3]);
                *(u32x4*)rowp = w;
            }
    }
};
struct EpiF32 {
    static constexpr bool PERM = false, AFTER_DRAIN = false;
    float* O; int ldc;
    __device__ __forceinline__ void operator()(const f32x4 (&acc)[2][2][4][2], const Unit& u, int wr, int wc, int fr, int fq) const {
        const int row0 = u.pm * BM + wr * 64 + fr, col0 = u.pn * BM + wc * 32 + 4 * fq;
#pragma unroll
        for (int ai = 0; ai < 2; ++ai)
#pragma unroll
            for (int m = 0; m < 4; ++m) {
                float* rowp = O + (size_t)(row0 + ai * HALF + m * 16) * ldc + col0;
#pragma unroll
                for (int bj = 0; bj < 2; ++bj)
#pragma unroll
                    for (int n = 0; n < 2; ++n) *(f32x4*)(rowp + bj * HALF + n * 16) = acc[ai][bj][m][n];
            }
    }
};
struct EpiU {
    static constexpr bool PERM = true, AFTER_DRAIN = false;
    bf16_t* O; int ldc; float* pk; float* pv; float* sk; float* sv; int mp, mr;
    __device__ __forceinline__ void operator()(const f32x4 (&acc)[2][2][4][2], const Unit& u, int wr, int wc, int fr, int fq) const {
        const int row0 = u.pm * BM + wr * 64 + fr, colt = wc * 32 + 8 * fq;
        const bool kv = (u.pn == 1) || (u.pn == 2);
#pragma unroll
        for (int ai = 0; ai < 2; ++ai)
#pragma unroll
            for (int m = 0; m < 4; ++m) {
                const int row = row0 + ai * HALF + m * 16;
                bf16_t* rowp = O + (size_t)row * ldc + u.pn * BM + colt;
#pragma unroll
                for (int bj = 0; bj < 2; ++bj) {
                    const f32x4 v0 = acc[ai][bj][m][0], v1 = acc[ai][bj][m][1];
                    u32x4 w; w.x = cvt_pk_bf16(v0[0], v0[1]); w.y = cvt_pk_bf16(v0[2], v0[3]); w.z = cvt_pk_bf16(v1[0], v1[1]); w.w = cvt_pk_bf16(v1[2], v1[3]);
                    *(u32x4*)(rowp + bj * HALF) = w;
                    if (kv && row < mr) {
                        float* dst = (row < mp) ? ((u.pn == 1 ? pk : pv) + (size_t)row * 256) : ((u.pn == 1 ? sk : sv) + (size_t)(row - mp) * 256);
                        dst += bj * HALF + colt;
                        *(f32x4*)dst = v0; *(f32x4*)(dst + 4) = v1;
                    }
                }
            }
    }
};
struct EpiBf {
    static constexpr bool PERM = true, AFTER_DRAIN = false;
    bf16_t* O; int ldc;
    __device__ __forceinline__ void operator()(const f32x4 (&acc)[2][2][4][2], const Unit& u, int wr, int wc, int fr, int fq) const {
        const int row0 = u.pm * BM + wr * 64 + fr, col0 = u.pn * BM + wc * 32 + 8 * fq;
#pragma unroll
        for (int ai = 0; ai < 2; ++ai)
#pragma unroll
            for (int m = 0; m < 4; ++m) {
                bf16_t* rowp = O + (size_t)(row0 + ai * HALF + m * 16) * ldc + col0;
#pragma unroll
                for (int bj = 0; bj < 2; ++bj) {
                    const f32x4 v0 = acc[ai][bj][m][0], v1 = acc[ai][bj][m][1];
                    u32x4 w; w.x = cvt_pk_bf16(v0[0], v0[1]); w.y = cvt_pk_bf16(v0[2], v0[3]); w.z = cvt_pk_bf16(v1[0], v1[1]); w.w = cvt_pk_bf16(v1[2], v1[3]);
                    *(u32x4*)(rowp + bj * HALF) = w;
                }
            }
    }
};

template <class Epi, class Sched, bool ALIGN_EPI = false, bool SP2 = false>
__device__ __forceinline__ void gemm_phase(PG8_LAS unsigned char* lds, const Gemm g, const Sched& S, const Epi& E) {
    const int tid = ltid(), wid = __builtin_amdgcn_readfirstlane(tid >> 6), lane = tid & 63, wr = wid >> 2, wc = wid & 3, fr = lane & 15, fq = lane >> 4;
    const int K = g.K, nt = K / BK;
    unsigned voffA[2], voffB[2];
#pragma unroll
    for (int i = 0; i < 2; ++i) { int R, C; stage_rc(tid * 16 + i * 8192, R, C); const int Rb = Epi::PERM ? ((R & ~31) + perm32(R & 31)) : R;
        voffA[i] = (unsigned)(R * K + C) * 2u; voffB[i] = (unsigned)(Rb * K + C) * 2u; }
    const size_t kstep = (size_t)(BK * 2);
    const size_t hstep = (size_t)HALF * K * 2;
    const size_t tstep = 2 * hstep;
    const unsigned ldsw = (unsigned)wid * 1024u;
    const int aoff = lds_byte(wr * 64 + fr, fq * 8), boff = lds_byte(wc * 32 + fr, fq * 8);
#define PG8_SA(b, h) (((b) * 2 + (h)) * HTB)
#define PG8_SB(b, h) ((4 + (b) * 2 + (h)) * HTB)
#define PG8_STAGE(bufoff, gbase, voff) do { _Pragma("unroll") for (int _i = 0; _i < 2; ++_i) \
        __builtin_amdgcn_global_load_lds((const unsigned*)((const char*)(gbase) + (voff)[_i]), (PG8_LAS unsigned*)(lds + (bufoff) + ldsw + _i * 8192), 16, 0, 0); } while (0)
#define PG8_LDA(dst, b, h) do { _Pragma("unroll") for (int m = 0; m < 4; ++m) _Pragma("unroll") for (int k = 0; k < 2; ++k) dst[m][k] = *(const PG8_LAS bf16x8*)(lds + PG8_SA(b, h) + aoff + m * 2048 + k * 1024); } while (0)
#define PG8_LDB(dst, b, h) do { _Pragma("unroll") for (int n = 0; n < 2; ++n) _Pragma("unroll") for (int k = 0; k < 2; ++k) dst[n][k] = *(const PG8_LAS bf16x8*)(lds + PG8_SB(b, h) + boff + n * 2048 + k * 1024); } while (0)
#define PG8_MMA(ai, bj, At, Bt) do { __builtin_amdgcn_s_setprio(1); _Pragma("unroll") for (int m = 0; m < 4; ++m) _Pragma("unroll") for (int n = 0; n < 2; ++n) _Pragma("unroll") for (int k = 0; k < 2; ++k) \
        acc[ai][bj][m][n] = __builtin_amdgcn_mfma_f32_16x16x32_bf16(Bt[n][k], At[m][k], acc[ai][bj][m][n], 0, 0, 0); __builtin_amdgcn_s_setprio(0); } while (0)
#define PG8_WAIT_V(n) asm volatile("s_waitcnt vmcnt(" #n ")" ::: "memory")
#define PG8_WAIT_L(n) asm volatile("s_waitcnt lgkmcnt(" #n ")" ::: "memory")
#define PG8_BAR __builtin_amdgcn_s_barrier()
#define PG8_SCHED __builtin_amdgcn_sched_barrier(0)
    Unit cur, nxt; int ui = 0;
    if (!S.next(0, cur)) return;
    f32x4 acc[2][2][4][2];
#pragma unroll
    for (int a = 0; a < 2; ++a)
#pragma unroll
        for (int b = 0; b < 2; ++b)
#pragma unroll
            for (int m = 0; m < 4; ++m)
#pragma unroll
                for (int n = 0; n < 2; ++n) acc[a][b][m][n] = (f32x4){0.f, 0.f, 0.f, 0.f};
    bf16x8 At[4][2], B0[2][2], B1[2][2];
    const char* cA = (const char*)g.A + (size_t)cur.pm * tstep; const char* cB = (const char*)g.Bt + (size_t)cur.pn * tstep;
    S.a_ready(cur);
    if constexpr (SP2) {
        PG8_STAGE(PG8_SB(0, 0), cB, voffB); PG8_STAGE(PG8_SB(0, 1), cB + hstep, voffB); PG8_STAGE(PG8_SA(0, 0), cA, voffA); PG8_STAGE(PG8_SA(0, 1), cA + hstep, voffA);
        if (wr == 1) PG8_BAR;
        PG8_WAIT_V(2); PG8_BAR;
        PG8_STAGE(PG8_SB(1, 0), cB + kstep, voffB); PG8_STAGE(PG8_SA(1, 0), cA + kstep, voffA); PG8_STAGE(PG8_SB(1, 1), cB + hstep + kstep, voffB);
        PG8_WAIT_V(6); PG8_BAR;
    } else {
        PG8_STAGE(PG8_SB(0, 0), cB, voffB); PG8_STAGE(PG8_SA(0, 0), cA, voffA); PG8_STAGE(PG8_SB(0, 1), cB + hstep, voffB); PG8_STAGE(PG8_SA(0, 1), cA + hstep, voffA);
        if (wr == 1) PG8_BAR;
        PG8_WAIT_V(4); PG8_BAR;
        PG8_STAGE(PG8_SB(1, 0), cB + kstep, voffB); PG8_STAGE(PG8_SA(1, 0), cA + kstep, voffA); PG8_STAGE(PG8_SB(1, 1), cB + hstep + kstep, voffB);
        PG8_WAIT_V(6); PG8_BAR;
    }
    for (;;) {
        const bool has_next = S.next(ui + 1, nxt);
        const char* nA = has_next ? (const char*)g.A + (size_t)nxt.pm * tstep : cA; const char* nB = has_next ? (const char*)g.Bt + (size_t)nxt.pn * tstep : cB;
        for (int t = 0; t < nt; t += 2) {
            const bool last = (t == nt - 2);
            const char* a1 = cA + (size_t)(t + 1) * kstep;
            const char* a2 = last ? nA : cA + (size_t)(t + 2) * kstep; const char* b2 = last ? nB : cB + (size_t)(t + 2) * kstep;
            const char* a3 = a2 + kstep; const char* b3 = b2 + kstep;
            if (last && has_next) S.a_ready(nxt);
            if constexpr (SP2) {
            PG8_LDB(B0, 0, 0); PG8_LDB(B1, 0, 1); PG8_SCHED; PG8_LDA(At, 0, 0); PG8_STAGE(PG8_SA(1, 1), a1 + hstep, voffA);
            PG8_WAIT_V(8); PG8_WAIT_L(0); PG8_BAR; PG8_MMA(0, 0, At, B0); PG8_MMA(0, 1, At, B1); PG8_BAR; PG8_SCHED;
            PG8_LDA(At, 0, 1); PG8_STAGE(PG8_SB(0, 0), b2, voffB); PG8_STAGE(PG8_SB(0, 1), b2 + hstep, voffB); PG8_STAGE(PG8_SA(0, 0), a2, voffA);
            PG8_WAIT_V(8); PG8_WAIT_L(0); PG8_BAR; PG8_MMA(1, 0, At, B0); PG8_MMA(1, 1, At, B1); PG8_BAR; PG8_SCHED;
            PG8_LDB(B0, 1, 0); PG8_LDB(B1, 1, 1); PG8_SCHED; PG8_LDA(At, 1, 0); PG8_STAGE(PG8_SA(0, 1), a2 + hstep, voffA);
            PG8_WAIT_V(8); PG8_WAIT_L(0); PG8_BAR; PG8_MMA(0, 0, At, B0); PG8_MMA(0, 1, At, B1); PG8_BAR; PG8_SCHED;
            PG8_LDA(At, 1, 1); PG8_STAGE(PG8_SB(1, 0), b3, voffB); PG8_STAGE(PG8_SB(1, 1), b3 + hstep, voffB); PG8_STAGE(PG8_SA(1, 0), a3, voffA);
            PG8_WAIT_V(8); PG8_WAIT_L(0); PG8_BAR; PG8_MMA(1, 0, At, B0); PG8_MMA(1, 1, At, B1); PG8_BAR; PG8_SCHED;
            } else {
            PG8_LDB(B0, 0, 0); PG8_SCHED; PG8_LDA(At, 0, 0); PG8_STAGE(PG8_SA(1, 1), a1 + hstep, voffA);
            PG8_WAIT_L(8); PG8_BAR; PG8_WAIT_L(0); PG8_MMA(0, 0, At, B0); PG8_BAR; PG8_SCHED;
            PG8_LDB(B1, 0, 1); PG8_STAGE(PG8_SB(0, 0), b2, voffB);
            PG8_BAR; PG8_WAIT_L(0); PG8_MMA(0, 1, At, B1); PG8_BAR;
            PG8_LDA(At, 0, 1); PG8_STAGE(PG8_SA(0, 0), a2, voffA);
            PG8_BAR; PG8_WAIT_L(0); PG8_MMA(1, 0, At, B0); PG8_BAR; PG8_SCHED;
            PG8_STAGE(PG8_SB(0, 1), b2 + hstep, voffB);
            PG8_WAIT_V(6); PG8_BAR; PG8_MMA(1, 1, At, B1); PG8_BAR;
            PG8_LDB(B0, 1, 0); PG8_SCHED; PG8_LDA(At, 1, 0); PG8_STAGE(PG8_SA(0, 1), a2 + hstep, voffA);
            PG8_WAIT_L(8); PG8_BAR; PG8_WAIT_L(0); PG8_MMA(0, 0, At, B0); PG8_BAR; PG8_SCHED;
            PG8_LDB(B1, 1, 1); PG8_STAGE(PG8_SB(1, 0), b3, voffB);
            PG8_BAR; PG8_WAIT_L(0); PG8_MMA(0, 1, At, B1); PG8_BAR;
            PG8_LDA(At, 1, 1); PG8_STAGE(PG8_SA(1, 0), a3, voffA);
            PG8_BAR; PG8_WAIT_L(0); PG8_MMA(1, 0, At, B0); PG8_BAR; PG8_SCHED;
            PG8_STAGE(PG8_SB(1, 1), b3 + hstep, voffB);
            PG8_WAIT_V(6); PG8_BAR; PG8_MMA(1, 1, At, B1); PG8_BAR;
            }
        }
        if constexpr (ALIGN_EPI) { if (wr == 0) PG8_BAR; }
        if constexpr (!Epi::AFTER_DRAIN) { E(acc, cur, wr, wc, fr, fq); S.done(cur); }
        if (!has_next) break;
#pragma unroll
        for (int a = 0; a < 2; ++a)
#pragma unroll
            for (int b = 0; b < 2; ++b)
#pragma unroll
                for (int m = 0; m < 4; ++m)
#pragma unroll
                    for (int n = 0; n < 2; ++n) acc[a][b][m][n] = (f32x4){0.f, 0.f, 0.f, 0.f};
        cur = nxt; cA = nA; cB = nB; ++ui;
        if constexpr (ALIGN_EPI) { if (wr == 1) PG8_BAR; }
    }
    PG8_WAIT_V(0);
    if constexpr (!ALIGN_EPI) { if (wr == 0) PG8_BAR; }
    PG8_BAR;
    if constexpr (Epi::AFTER_DRAIN) { E.fused(acc, cur, wr, wc, fr, fq, lds, wid, lane); S.done(cur); }
#undef PG8_SA
#undef PG8_SB
#undef PG8_STAGE
#undef PG8_LDA
#undef PG8_LDB
#undef PG8_MMA
#undef PG8_WAIT_V
#undef PG8_WAIT_L
#undef PG8_BAR
#undef PG8_SCHED
}
}

typedef unsigned short bf16;
typedef short bf16x8 __attribute__((ext_vector_type(8)));
typedef float f32x4 __attribute__((ext_vector_type(4)));
typedef unsigned u32x4 __attribute__((ext_vector_type(4)));
typedef unsigned u32x2 __attribute__((ext_vector_type(2)));
#define LAS __attribute__((address_space(3)))
#define LAUNDER(p) asm volatile("" : "+s"(p))

constexpr int D = 1024, T = 4096, NB = 8, TS = 16, PAST = 1024, FF = 2816, RW = 896;
constexpr int MP = NB * T, MS = NB * TS, MR = MP + MS, M = 33024;
constexpr int NU = 2816;
constexpr int UQ = 0, UK = 256, UV = 512, UPOOL = 768, UCB = 1024, UCC = 1280, UCX = 1536, URW = 1792;
constexpr float RMS_EPS = 1e-6f, GN_EPS = 64e-5f;
constexpr int VTP = T + 64;
constexpr int SKEYS = PAST + TS, SKP = 1088;

constexpr size_t O_X = 0, O_PK = 33685504, O_PV = 50462720, O_PWKV = 67239936, O_PSHIFT = 67502080, O_PCONV = 67516416, O_PPOOL = 67524608,
                 O_SK = 67586048, O_SV = 67651584, O_SWKV = 67717120, O_SSHIFT = 67979264, O_SCONV = 67993600, O_SPOOL = 68001792, O_END = 68063232;
constexpr size_t LW = 21233664;
constexpr size_t W_GUA = 0, W_DA = 5767168, W_IN = 8650752, W_OUT = 11534336, W_GUB = 12582912, W_DB = 18350080;
constexpr size_t WS_W = 0, WS_H = 84934656, WS_U = 152567808, WS_Y = 338558976;
constexpr size_t WS_SIN = WS_Y, WS_G = 456458240, WS_RK = 473300992, WS_YS = 473827328, WS_SKV = 507512832, WS_VT = 511772672, WS_SVT = 528812032, WS_CTL = 533268480, WS_END = 533268480 + 16384;
constexpr size_t SKV_ELEMS = (size_t)NB * SKEYS * 256;
constexpr int REC = 896;
static_assert(WS_Y + (size_t)M * D * 4 <= WS_END && WS_SIN + (size_t)MR * 4 * REC == WS_G && WS_G + (size_t)MR * 512 == WS_RK && WS_RK + (size_t)MR * 16 == WS_YS && WS_YS + (size_t)MR * 1024 == WS_SKV && WS_SKV + SKV_ELEMS * 2 == WS_VT && WS_VT + (size_t)32 * 64 * VTP * 2 == WS_SVT && WS_SVT + (size_t)32 * 64 * SKP * 2 == WS_CTL && WS_END <= 536870912, "ws map");
static_assert(WS_U + (size_t)M * NU * 2 == WS_Y && WS_H + (size_t)M * D * 2 == WS_U && 2 * LW * 2 == WS_H, "ws map 2");

constexpr int LDS_BYTES = 147456;
constexpr int NTHR = 512, NWAVES = 8;

constexpr int PH_PRE = 0, PH_PER_LAYER = 12, NPH = 1 + 2 * PH_PER_LAYER;
enum { P_A1 = 0, P_A2, P_A3, P_B1, P_C1, P_C2, P_C3, P_D1, P_D2, P_E1, P_E2, P_E3 };

struct Args { const float* in[28]; float* out; unsigned char* ws; int ph_lo, ph_hi; };
enum { I_XP = 0, I_XS, I_CK, I_CV, I_SWKV, I_SSHIFT, I_SCONV, I_SPOOL, I_NG, I_WG, I_WU, I_WD, I_WIN, I_WOUT, I_POOLW, I_POOLS, I_MU, I_W0, I_W2, I_A0, I_A2, I_G2, I_KK, I_KA, I_RK, I_LNW, I_LNB, I_CONVW };
typedef const __attribute__((address_space(4))) Args* KArgP;
__device__ __forceinline__ KArgP kargs() { KArgP p = (KArgP)__builtin_amdgcn_kernarg_segment_ptr(); asm volatile("" : "+s"(p)); return p; }

__device__ __forceinline__ unsigned f2bf(float f) { return (unsigned)__builtin_bit_cast(unsigned short, (__bf16)f); }
typedef float f32x2_t __attribute__((ext_vector_type(2))); typedef __bf16 bf16x2_t __attribute__((ext_vector_type(2)));
__device__ __forceinline__ unsigned pk2(float lo, float hi) { f32x2_t v = {lo, hi}; bf16x2_t b = __builtin_convertvector(v, bf16x2_t); return __builtin_bit_cast(unsigned, b); }
__device__ __forceinline__ float bf2f(unsigned h) { return __builtin_bit_cast(float, h << 16); }
__device__ __forceinline__ float bflo(unsigned w) { return __builtin_bit_cast(float, w << 16); }
__device__ __forceinline__ float bfhi(unsigned w) { return __builtin_bit_cast(float, w & 0xffff0000u); }
__device__ __forceinline__ float ldbf(const bf16* p) { return bf2f((unsigned)*p); }
template <int CTRL> __device__ __forceinline__ float dppf(float x) { return __builtin_bit_cast(float, __builtin_amdgcn_update_dpp(0, __builtin_bit_cast(int, x), CTRL, 0xF, 0xF, true)); }
__device__ __forceinline__ float red16(float x) {
    x += dppf<0xB1>(x);
    x += dppf<0x4E>(x);
    x += dppf<0x141>(x);
    x += dppf<0x140>(x);
    return x;
}
__device__ __forceinline__ float wave_sum(float v) {
    v = red16(v);
    const int iv = __builtin_bit_cast(int, v);
    return (__builtin_bit_cast(float, __builtin_amdgcn_readlane(iv, 0)) + __builtin_bit_cast(float, __builtin_amdgcn_readlane(iv, 16))) +
           (__builtin_bit_cast(float, __builtin_amdgcn_readlane(iv, 32)) + __builtin_bit_cast(float, __builtin_amdgcn_readlane(iv, 48)));
}
__device__ __forceinline__ void red16_2(float& a, float& b) {
    a += dppf<0xB1>(a); b += dppf<0xB1>(b);
    a += dppf<0x4E>(a); b += dppf<0x4E>(b);
    a += dppf<0x141>(a); b += dppf<0x141>(b);
    a += dppf<0x140>(a); b += dppf<0x140>(b);
}
typedef float f32x2v __attribute__((ext_vector_type(2)));
typedef __bf16 bf2_t __attribute__((ext_vector_type(2)));
__device__ __forceinline__ float dot2bf(unsigned a, unsigned b, float c) { return __builtin_amdgcn_fdot2_f32_bf16(__builtin_bit_cast(bf2_t, a), __builtin_bit_cast(bf2_t, b), c, false); }
__device__ __forceinline__ float sigmoid_f(float x) { return __builtin_amdgcn_rcpf(1.0f + __expf(-x)); }
__device__ __forceinline__ float tanh_f(float x) { return 2.0f * sigmoid_f(2.0f * x) - 1.0f; }
__device__ __forceinline__ float softplus_f(float x) { return fmaxf(x, 0.f) + __logf(1.0f + __expf(-fabsf(x))); }

__device__ __forceinline__ void transpose_item(const float* __restrict__ W, int K, int N, bf16* WT, int dst_row0, float* scr, int kb, int n0, int lane) {
    const int k0 = 64 * kb;
    float wv[32];
#pragma unroll
    for (int i = 0; i < 32; ++i) wv[i] = W[(size_t)(k0 + 2 * i + (lane >> 5)) * N + n0 + (lane & 31)];
#pragma unroll
    for (int i = 0; i < 32; ++i) scr[(2 * i + (lane >> 5)) * 33 + (lane & 31)] = wv[i];
    asm volatile("s_waitcnt lgkmcnt(0)" ::: "memory");
    const int c = lane & 7;
#pragma unroll
    for (int j = 0; j < 4; ++j) { const int n = (lane >> 3) + 8 * j; const float* s = scr + (8 * c) * 33 + n;
        u32x4 o; o.x = pk2(s[0 * 33], s[1 * 33]); o.y = pk2(s[2 * 33], s[3 * 33]); o.z = pk2(s[4 * 33], s[5 * 33]); o.w = pk2(s[6 * 33], s[7 * 33]);
        *(u32x4*)(WT + (size_t)(dst_row0 + n) * K + k0 + 8 * c) = o; }
    asm volatile("s_waitcnt lgkmcnt(0)" ::: "memory");
}
__device__ __forceinline__ int win_rowmap(int n0) { return n0 < 256 ? UPOOL + n0 : (n0 < 1152 ? URW + (n0 - 256) : (n0 < 1920 ? UCB + (n0 - 1152) : n0 - 1920)); }

__device__ __forceinline__ void norm_row_to_bf16(const float* xrow, const float* g, bf16* hrow, int lane) {
    f32x4 v[4]; float s = 0.f;
#pragma unroll
    for (int j = 0; j < 4; ++j) { v[j] = *((const f32x4*)xrow + lane + 64 * j); s += (v[j].x * v[j].x + v[j].y * v[j].y) + (v[j].z * v[j].z + v[j].w * v[j].w); }
    const float rstd = rsqrtf(wave_sum(s) * (1.f / D) + RMS_EPS);
#pragma unroll
    for (int j = 0; j < 4; ++j) { const f32x4 gg = *((const f32x4*)g + lane + 64 * j); u32x2 o; o.x = pk2(v[j].x * rstd * gg.x, v[j].y * rstd * gg.y); o.y = pk2(v[j].z * rstd * gg.z, v[j].w * rstd * gg.w);
        *((u32x2*)hrow + lane + 64 * j) = o; }
}

__device__ __forceinline__ void phase_pre(const Args& a, unsigned char* lds) {
    KArgP ap = kargs(); unsigned char* ws_l = ap->ws; float* out_l = ap->out; (void)ws_l; (void)out_l;
    const float* in_I_NG = ap->in[I_NG];
    const float* in_I_WD = ap->in[I_WD];
    const float* in_I_WG = ap->in[I_WG];
    const float* in_I_WIN = ap->in[I_WIN];
    const float* in_I_WOUT = ap->in[I_WOUT];
    const float* in_I_WU = ap->in[I_WU];
    const float* in_I_XP = ap->in[I_XP];
    const float* in_I_XS = ap->in[I_XS];
    const int tid = ltid(), lane = tid & 63, wave = tid >> 6, G = gridDim.x;
    const int gw = blockIdx.x * NWAVES + wave, NGW = G * NWAVES;
    float* scr = (float*)(lds + wave * 16384);
    bf16* Wb = (bf16*)(ws_l + WS_W);
    constexpr int IT_L = 10304;
    for (int it = gw; it < 2 * IT_L; it += NGW) {
        const int l = it / IT_L; int r = it % IT_L; bf16* WL = Wb + (size_t)l * LW;
        const float* src; int K, N; bf16* dst; int mode;
        if (r < 1408)      { src = in_I_WG + (size_t)(l * 2 + 0) * D * FF; K = D; N = FF; dst = WL + W_GUA; mode = 1; }
        else if ((r -= 1408) < 1408) { src = in_I_WU + (size_t)(l * 2 + 0) * D * FF; K = D; N = FF; dst = WL + W_GUA; mode = 2; }
        else if ((r -= 1408) < 1408) { src = in_I_WD + (size_t)(l * 2 + 0) * FF * D; K = FF; N = D; dst = WL + W_DA; mode = 0; }
        else if ((r -= 1408) < 1344) { src = in_I_WIN + (size_t)l * D * 2688; K = D; N = 2688; dst = WL + W_IN; mode = 3; }
        else if ((r -= 1344) < 512)  { src = in_I_WOUT + (size_t)l * D * D; K = D; N = D; dst = WL + W_OUT; mode = 0; }
        else if ((r -= 512) < 1408)  { src = in_I_WG + (size_t)(l * 2 + 1) * D * FF; K = D; N = FF; dst = WL + W_GUB; mode = 1; }
        else if ((r -= 1408) < 1408) { src = in_I_WU + (size_t)(l * 2 + 1) * D * FF; K = D; N = FF; dst = WL + W_GUB; mode = 2; }
        else { r -= 1408;            src = in_I_WD + (size_t)(l * 2 + 1) * FF * D; K = FF; N = D; dst = WL + W_DB; mode = 0; }
        const int nblk = N / 32, kb = r / nblk, n0 = 32 * (r % nblk);
        int dr = n0;
        if (mode == 1) dr = 256 * (n0 >> 7) + (n0 & 127); else if (mode == 2) dr = 256 * (n0 >> 7) + 128 + (n0 & 127); else if (mode == 3) dr = win_rowmap(n0);
        transpose_item(src, K, N, dst, dr, scr, kb, n0, lane);
    }
    const int gt = blockIdx.x * NTHR + tid, NGT = G * NTHR;
    for (int i = gt; i < 2 * 16384 + 16384; i += NGT) {
        u32x4 z = {0u, 0u, 0u, 0u};
        if (i < 32768) { const int l = i >> 14, o = i & 16383; *((u32x4*)(Wb + (size_t)l * LW + W_IN + (size_t)2688 * D) + o) = z; }
        else { *((u32x4*)((bf16*)(ws_l + WS_H) + (size_t)MR * D) + (i - 32768)) = z; }
    }
    bf16* H = (bf16*)(ws_l + WS_H);
    for (int m = gw; m < MR; m += NGW) {
        const float* xr = m < MP ? in_I_XP + (size_t)m * D : in_I_XS + (size_t)(m - MP) * D;
        norm_row_to_bf16(xr, in_I_NG, H + (size_t)m * D, lane);
    }
}

template <bool SRC_F32, bool DST_F32, bool HAS_H>
__device__ __forceinline__ void phase_rowpass(const void* xp, const void* xs, const bf16* Y, float coef, const float* gpost, const float* gpre, void* xdst, bf16* H) {
    const int tid = ltid(), lane = tid & 63, wave = tid >> 6;
    const int gw = blockIdx.x * NWAVES + wave, NGW = gridDim.x * NWAVES;
    f32x4 y[4], x[4], nxf[4]; u32x2 ny[4], nxb[4];
#define RP_LOAD(m_) do { const bf16* yr_ = Y + (size_t)(m_) * D; \
        _Pragma("unroll") for (int j = 0; j < 4; ++j) ny[j] = *((const u32x2*)yr_ + lane + 64 * j); \
        if (SRC_F32) { const float* xr_ = (m_) < MP ? (const float*)xp + (size_t)(m_) * D : (const float*)xs + (size_t)((m_) - MP) * D; \
            _Pragma("unroll") for (int j = 0; j < 4; ++j) nxf[j] = *((const f32x4*)xr_ + lane + 64 * j); } \
        else { const bf16* xr_ = (const bf16*)xp + (size_t)(m_) * D; \
            _Pragma("unroll") for (int j = 0; j < 4; ++j) nxb[j] = *((const u32x2*)xr_ + lane + 64 * j); } } while (0)
    if (gw < MR) RP_LOAD(gw);
    for (int m = gw; m < MR; m += NGW) {
#pragma unroll
        for (int j = 0; j < 4; ++j) { y[j] = (f32x4){bflo(ny[j].x), bfhi(ny[j].x), bflo(ny[j].y), bfhi(ny[j].y)};
            x[j] = SRC_F32 ? nxf[j] : (f32x4){bflo(nxb[j].x), bfhi(nxb[j].x), bflo(nxb[j].y), bfhi(nxb[j].y)}; }
        if (m + NGW < MR) RP_LOAD(m + NGW);
        float s = 0.f;
#pragma unroll
        for (int j = 0; j < 4; ++j) s += (y[j].x * y[j].x + y[j].y * y[j].y) + (y[j].z * y[j].z + y[j].w * y[j].w);
        const float rstd = rsqrtf(wave_sum(s) * (1.f / D) + RMS_EPS) * coef;
        float s2 = 0.f;
#pragma unroll
        for (int j = 0; j < 4; ++j) { const f32x4 gg = *((const f32x4*)gpost + lane + 64 * j);
            x[j].x += y[j].x * rstd * gg.x; x[j].y += y[j].y * rstd * gg.y; x[j].z += y[j].z * rstd * gg.z; x[j].w += y[j].w * rstd * gg.w;
            s2 += (x[j].x * x[j].x + x[j].y * x[j].y) + (x[j].z * x[j].z + x[j].w * x[j].w);
            if (DST_F32) *((f32x4*)((float*)xdst + (size_t)m * D) + lane + 64 * j) = x[j];
            else { u32x2 o; o.x = pk2(x[j].x, x[j].y); o.y = pk2(x[j].z, x[j].w); *((u32x2*)((bf16*)xdst + (size_t)m * D) + lane + 64 * j) = o; } }
        if (HAS_H) {
            const float r2 = rsqrtf(wave_sum(s2) * (1.f / D) + RMS_EPS);
#pragma unroll
            for (int j = 0; j < 4; ++j) { const f32x4 gg = *((const f32x4*)gpre + lane + 64 * j); u32x2 o; o.x = pk2(x[j].x * r2 * gg.x, x[j].y * r2 * gg.y); o.y = pk2(x[j].z * r2 * gg.z, x[j].w * r2 * gg.w);
                *((u32x2*)(H + (size_t)m * D) + lane + 64 * j) = o; }
        }
    }
#undef RP_LOAD
}

__device__ __forceinline__ void ld8(const bf16* p, float (&f)[8]) {
    const u32x4 w = *(const u32x4*)p;
    f[0] = bflo(w.x); f[1] = bfhi(w.x); f[2] = bflo(w.y); f[3] = bfhi(w.y); f[4] = bflo(w.z); f[5] = bfhi(w.z); f[6] = bflo(w.w); f[7] = bfhi(w.w);
}
__device__ __forceinline__ void conv_part(const Args& a, int l, int bid, int nblk) {
    const int tid = ltid();
    KArgP ap = kargs(); unsigned char* ws_l = ap->ws; float* out_l = ap->out; (void)ws_l; (void)out_l;
    const float* in_I_CONVW = ap->in[I_CONVW];
    const float* in_I_SCONV = ap->in[I_SCONV];
    const bf16* U = (const bf16*)(ws_l + WS_U); bf16* YC = (bf16*)(ws_l + WS_H);
    const float* cw = in_I_CONVW + (size_t)l * 3 * 256;
    const int gt = bid * NTHR + tid, NGT = nblk * NTHR;
    for (int it = gt; it < MR * 32; it += NGT) {
        const int row = it >> 5, c8 = (it & 31) * 8;
        int b, t, Tn; const float* prefix; float* sout;
        if (row < MP) { b = row >> 12; t = row & 4095; Tn = T; prefix = nullptr; sout = out_l + O_PCONV + (size_t)(l * NB + b) * 2 * 256; }
        else { const int rr = row - MP; b = rr >> 4; t = rr & 15; Tn = TS; prefix = in_I_SCONV + (size_t)(l * NB + b) * 2 * 256; sout = out_l + O_SCONV + (size_t)(l * NB + b) * 2 * 256; }
        const bf16* ur = U + (size_t)row * NU;
        float bg[8], z0[8], z1[8], z2[8], cc[8], xx[8];
        ld8(ur + UCB + c8, bg); ld8(ur + UCC + c8, cc); ld8(ur + UCX + c8, xx);
#pragma unroll
        for (int i = 0; i < 8; ++i) z2[i] = cc[i] * xx[i];
        if (t >= 1) { ld8(ur - NU + UCC + c8, cc); ld8(ur - NU + UCX + c8, xx);
#pragma unroll
            for (int i = 0; i < 8; ++i) z1[i] = cc[i] * xx[i]; }
        else {
#pragma unroll
            for (int i = 0; i < 8; ++i) z1[i] = prefix ? prefix[256 + c8 + i] : 0.f; }
        if (t >= 2) { ld8(ur - 2 * NU + UCC + c8, cc); ld8(ur - 2 * NU + UCX + c8, xx);
#pragma unroll
            for (int i = 0; i < 8; ++i) z0[i] = cc[i] * xx[i]; }
        else {
#pragma unroll
            for (int i = 0; i < 8; ++i) z0[i] = prefix ? prefix[(t + 0) * 256 + c8 + i] : 0.f; }
        float y[8];
#pragma unroll
        for (int i = 0; i < 8; ++i) y[i] = bg[i] * (z0[i] * cw[c8 + i] + z1[i] * cw[256 + c8 + i] + z2[i] * cw[512 + c8 + i]);
        u32x4 o; o.x = pk2(y[0], y[1]); o.y = pk2(y[2], y[3]); o.z = pk2(y[4], y[5]); o.w = pk2(y[6], y[7]);
        *(u32x4*)(YC + (size_t)row * D + 512 + c8) = o;
        if (t >= Tn - 2) { float* so = sout + (size_t)(t - (Tn - 2)) * 256 + c8;
            *(f32x4*)so = (f32x4){z2[0], z2[1], z2[2], z2[3]}; *(f32x4*)(so + 4) = (f32x4){z2[4], z2[5], z2[6], z2[7]}; }
    }
}

template <int W>
__device__ __forceinline__ void pool_window(const float (&vals)[31], int pos0, float (&d)[16]) {
#pragma unroll
    for (int i = 0; i < 16; ++i) {
        float s = 0.f;
#pragma unroll
        for (int k = 0; k < W; ++k) s += vals[15 + i - k];
        const int cnt = (pos0 + i + 1) < W ? (pos0 + i + 1) : W;
        d[i] = s / (float)cnt - vals[15 + i];
    }
}
__device__ __forceinline__ void pool_part(const Args& a, int l, unsigned char* lds, int bid, int nblk) {
    KArgP ap = kargs(); unsigned char* ws_l = ap->ws; float* out_l = ap->out; (void)ws_l; (void)out_l;
    const float* in_I_POOLS = ap->in[I_POOLS];
    const float* in_I_POOLW = ap->in[I_POOLW];
    const float* in_I_SPOOL = ap->in[I_SPOOL];
    const bf16* U = (const bf16*)(ws_l + WS_U); bf16* YC = (bf16*)(ws_l + WS_H);
    bf16* dl = (bf16*)lds;
    const int tid = ltid(), c = tid & 255, th = tid >> 8, gi = c >> 6;
    const float* pw = in_I_POOLW + (size_t)(l * 4 + gi) * 64 * 64 + (c & 63);
    const float scale = in_I_POOLS[l * 256 + c];
    for (int item = bid; item < MR / 32; item += nblk) {
        const int row0 = item * 32 + th * 16;
        int b, t0, pos0, Tn; const float* prefix; float* sout;
        if (row0 < MP) { b = row0 >> 12; t0 = row0 & 4095; pos0 = t0; Tn = T; prefix = nullptr; sout = out_l + O_PPOOL + (size_t)(l * NB + b) * 15 * 256; }
        else { const int rr = row0 - MP; b = rr >> 4; t0 = 0; pos0 = PAST; Tn = TS; prefix = in_I_SPOOL + (size_t)(l * NB + b) * 15 * 256; sout = out_l + O_SPOOL + (size_t)(l * NB + b) * 15 * 256; }
        float vals[31];
#pragma unroll
        for (int i = 0; i < 31; ++i) {
            const int tt = t0 - 15 + i;
            vals[i] = (tt >= 0) ? ldbf(U + (size_t)(row0 - 15 + i) * NU + UPOOL + c) : (prefix ? prefix[(size_t)(i + t0) * 256 + c] : 0.f);
        }
        float d[16];
        if (gi == 0) pool_window<2>(vals, pos0, d); else if (gi == 1) pool_window<4>(vals, pos0, d); else if (gi == 2) pool_window<8>(vals, pos0, d); else pool_window<16>(vals, pos0, d);
#pragma unroll
        for (int i = 0; i < 16; ++i) {
            dl[(th * 16 + i) * 256 + c] = (bf16)f2bf(d[i]);
            const int t = t0 + i; if (t >= Tn - 15) sout[(size_t)(t - (Tn - 15)) * 256 + c] = vals[15 + i];
        }
        __syncthreads();
        float acc[16];
#pragma unroll
        for (int i = 0; i < 16; ++i) acc[i] = 0.f;
        for (int j8 = 0; j8 < 8; ++j8) {
            const unsigned w01 = pk2(pw[(8 * j8 + 0) * 64], pw[(8 * j8 + 1) * 64]), w23 = pk2(pw[(8 * j8 + 2) * 64], pw[(8 * j8 + 3) * 64]);
            const unsigned w45 = pk2(pw[(8 * j8 + 4) * 64], pw[(8 * j8 + 5) * 64]), w67 = pk2(pw[(8 * j8 + 6) * 64], pw[(8 * j8 + 7) * 64]);
#pragma unroll
            for (int i = 0; i < 16; ++i) { const u32x4 dv = *(const u32x4*)(dl + (th * 16 + i) * 256 + gi * 64 + 8 * j8);
                acc[i] = dot2bf(dv.w, w67, dot2bf(dv.z, w45, dot2bf(dv.y, w23, dot2bf(dv.x, w01, acc[i])))); }
        }
#pragma unroll
        for (int i = 0; i < 16; ++i) YC[(size_t)(row0 + i) * D + c] = (bf16)f2bf(acc[i] * scale);
        __syncthreads();
    }
}

__device__ __forceinline__ size_t rec_index(int row, int h) {
    if (row < MP) { const int b = row >> 12, t = row & 4095; return ((size_t)b * T) * 4 + (size_t)h * T + t; }
    const int rr = row - MP, b = rr >> 4, t = rr & 15; return ((size_t)MP + (size_t)b * TS) * 4 + (size_t)h * TS + t;
}
__device__ __forceinline__ void rwkv_prep_part(const Args& a, int l, unsigned char* lds) {
    const int tid = ltid();
    KArgP ap = kargs(); unsigned char* ws_l = ap->ws; float* out_l = ap->out;
    const float* in_I_A0 = ap->in[I_A0]; const float* in_I_A2 = ap->in[I_A2]; const float* in_I_G2 = ap->in[I_G2]; const float* in_I_KA = ap->in[I_KA]; const float* in_I_KK = ap->in[I_KK];
    const float* in_I_MU = ap->in[I_MU]; const float* in_I_RK = ap->in[I_RK]; const float* in_I_SSHIFT = ap->in[I_SSHIFT]; const float* in_I_W0 = ap->in[I_W0]; const float* in_I_W2 = ap->in[I_W2];
    const bf16* U = (const bf16*)(ws_l + WS_U);
    unsigned char* SIN = ws_l + WS_SIN; bf16* Gb = (bf16*)(ws_l + WS_G); float* RKb = (float*)(ws_l + WS_RK);
    bf16* lrb = (bf16*)lds;
    const int lane = tid & 63, c = tid & 255, half = tid >> 8, h = c >> 6, cc = c & 63;
    const float* mu = in_I_MU + (size_t)l * RW;
    const float mur = mu[c], muk = mu[256 + c], muv = mu[512 + c];
    const float w0c = in_I_W0[l * 256 + c], a0c = in_I_A0[l * 256 + c], kkc = in_I_KK[l * 256 + c], kac = in_I_KA[l * 256 + c], rkc = in_I_RK[l * 256 + c];
    unsigned w2p[16], a2p[16], g2p[32];
#pragma unroll
    for (int i = 0; i < 16; ++i) { w2p[i] = pk2(in_I_W2[(size_t)(l * 32 + 2 * i) * 256 + c], in_I_W2[(size_t)(l * 32 + 2 * i + 1) * 256 + c]);
                                   a2p[i] = pk2(in_I_A2[(size_t)(l * 32 + 2 * i) * 256 + c], in_I_A2[(size_t)(l * 32 + 2 * i + 1) * 256 + c]); }
#pragma unroll
    for (int i = 0; i < 32; ++i) g2p[i] = pk2(in_I_G2[(size_t)(l * 64 + 2 * i) * 256 + c], in_I_G2[(size_t)(l * 64 + 2 * i + 1) * 256 + c]);
    constexpr int TPI = 16, TPH = 8;
    for (int item = blockIdx.x; item < MR / TPI; item += gridDim.x) {
        const int row0 = item * TPI;
#pragma unroll
        for (int k = 0; k < TPI / 4; ++k) {
            const int idx = tid + NTHR * k, tok = idx >> 7, col = idx & 127, row = row0 + tok;
            int t, Tn; const float* shift; float* sout;
            if (row < MP) { t = row & 4095; Tn = T; shift = nullptr; sout = out_l + O_PSHIFT + (size_t)(l * NB + (row >> 12)) * RW; }
            else { const int rr = row - MP; t = rr & 15; Tn = TS; shift = in_I_SSHIFT + (size_t)(l * NB + (rr >> 4)) * RW; sout = out_l + O_SSHIFT + (size_t)(l * NB + (rr >> 4)) * RW; }
            const float cur = ldbf(U + (size_t)row * NU + URW + 768 + col);
            const float prev = (t > 0) ? ldbf(U + (size_t)(row - 1) * NU + URW + 768 + col) : (shift ? shift[768 + col] : 0.f);
            const float xs = cur + (prev - cur) * mu[768 + col];
            lrb[tok * 128 + col] = (bf16)f2bf(col < 32 ? tanh_f(xs) : (col < 64 ? xs : sigmoid_f(xs)));
            if (t == Tn - 1) sout[768 + col] = cur;
        }
        __syncthreads();
        const int rowh = row0 + half * TPH;
        int t0, Tn; const float* shift; float* sout;
        if (rowh < MP) { t0 = rowh & 4095; Tn = T; shift = nullptr; sout = out_l + O_PSHIFT + (size_t)(l * NB + (rowh >> 12)) * RW; }
        else { const int rr = rowh - MP; t0 = rr & 15; Tn = TS; shift = in_I_SSHIFT + (size_t)(l * NB + (rr >> 4)) * RW; sout = out_l + O_SSHIFT + (size_t)(l * NB + (rr >> 4)) * RW; }
        const bf16* ur = U + (size_t)rowh * NU + URW;
        float rp, kp, vp;
        if (t0 > 0) { rp = ldbf(ur - NU + c); kp = ldbf(ur - NU + 256 + c); vp = ldbf(ur - NU + 512 + c); }
        else if (shift) { rp = shift[c]; kp = shift[256 + c]; vp = shift[512 + c]; }
        else { rp = 0.f; kp = 0.f; vp = 0.f; }
        float rua[TPH], kua[TPH], vua[TPH];
#pragma unroll
        for (int i = 0; i < TPH; ++i) { rua[i] = ldbf(ur + (size_t)i * NU + c); kua[i] = ldbf(ur + (size_t)i * NU + 256 + c); vua[i] = ldbf(ur + (size_t)i * NU + 512 + c); }
#pragma unroll
        for (int i = 0; i < TPH; ++i) {
            const int tok = half * TPH + i, row = rowh + i, t = t0 + i;
            const float ru = rua[i], ku = kua[i], vu = vua[i];
            const float r = ru + (rp - ru) * mur, k = ku + (kp - ku) * muk, v = vu + (vp - vu) * muv;
            rp = ru; kp = ku; vp = vu;
            if (t == Tn - 1) { sout[c] = ru; sout[256 + c] = ku; sout[512 + c] = vu; }
            const u32x4* lt = (const u32x4*)(lrb + tok * 128);
            float wp = w0c, ap2 = a0c, gg = 0.f;
#pragma unroll
            for (int j = 0; j < 4; ++j) { const u32x4 x = lt[j]; wp = dot2bf(x.x, w2p[4 * j], wp); wp = dot2bf(x.y, w2p[4 * j + 1], wp); wp = dot2bf(x.z, w2p[4 * j + 2], wp); wp = dot2bf(x.w, w2p[4 * j + 3], wp); }
#pragma unroll
            for (int j = 0; j < 4; ++j) { const u32x4 x = lt[4 + j]; ap2 = dot2bf(x.x, a2p[4 * j], ap2); ap2 = dot2bf(x.y, a2p[4 * j + 1], ap2); ap2 = dot2bf(x.z, a2p[4 * j + 2], ap2); ap2 = dot2bf(x.w, a2p[4 * j + 3], ap2); }
#pragma unroll
            for (int j = 0; j < 8; ++j) { const u32x4 x = lt[8 + j]; gg = dot2bf(x.x, g2p[4 * j], gg); gg = dot2bf(x.y, g2p[4 * j + 1], gg); gg = dot2bf(x.z, g2p[4 * j + 2], gg); gg = dot2bf(x.w, g2p[4 * j + 3], gg); }
            const float w = -softplus_f(-wp) - 0.5f;
            const float decay = __expf(-__expf(w));
            const float aa = sigmoid_f(ap2);
            const float kkr = k * kkc;
            const float nrm = sqrtf(wave_sum(kkr * kkr));
            const float kk = kkr / fmaxf(nrm, 1e-12f);
            const float kh = k * (1.0f + (aa - 1.0f) * kac);
            const float rks = wave_sum(r * kh * rkc);
            unsigned char* rec = SIN + rec_index(row, h) * REC;
            ((bf16*)rec)[cc] = (bf16)f2bf(r); ((bf16*)rec)[64 + cc] = (bf16)f2bf(kh); ((bf16*)rec)[128 + cc] = (bf16)f2bf(v); ((bf16*)rec)[192 + cc] = (bf16)f2bf(kk); ((bf16*)rec)[256 + cc] = (bf16)f2bf(aa);
            ((float*)(rec + 640))[cc] = decay;
            Gb[(size_t)row * 256 + c] = (bf16)f2bf(gg);
            if (lane == 0) RKb[(size_t)row * 4 + h] = rks;
        }
        __syncthreads();
    }
}
__device__ __forceinline__ void skv_part(const Args& a, int l) {
    const int tid = ltid();
    KArgP ap = kargs(); unsigned char* ws_l = ap->ws;
    const float* in_I_CK = ap->in[I_CK];
    const bf16* U = (const bf16*)(ws_l + WS_U); bf16* SK = (bf16*)(ws_l + WS_SKV);
    const int gt = blockIdx.x * NTHR + tid, NGT = gridDim.x * NTHR;
    for (int it = gt; it < NB * SKEYS * 32; it += NGT) {
        const int c8 = (it & 31) * 8, kr = it >> 5, b = kr / SKEYS, key = kr % SKEYS;
        bf16* dst = SK + ((size_t)b * SKEYS + key) * 256 + c8;
        if (key < PAST) {
            const float* src = in_I_CK + (((size_t)(l * NB + b) * PAST + key) * 256 + c8);
            const f32x4 x0 = *(const f32x4*)src, x1 = *(const f32x4*)(src + 4);
            u32x4 o; o.x = pk2(x0.x, x0.y); o.y = pk2(x0.z, x0.w); o.z = pk2(x1.x, x1.y); o.w = pk2(x1.z, x1.w);
            *(u32x4*)dst = o;
        } else {
            *(u32x4*)dst = *(const u32x4*)(U + (size_t)(MP + b * TS + (key - PAST)) * NU + UK + c8);
        }
    }
}
__device__ __forceinline__ void vt_part(const Args& a, int l) {
    const int tid = ltid();
    KArgP ap = kargs(); unsigned char* ws_l = ap->ws;
    const float* in_I_CV = ap->in[I_CV];
    const bf16* U = (const bf16*)(ws_l + WS_U); bf16* VT = (bf16*)(ws_l + WS_VT); bf16* SVT = (bf16*)(ws_l + WS_SVT);
    const int lane = tid & 63, gw = blockIdx.x * NWAVES + (tid >> 6), NGW = gridDim.x * NWAVES;
    constexpr int NPI = 32 * (T / 64), NSI = 32 * (SKP / 64);
    for (int it = gw; it < NPI + NSI; it += NGW) {
        float v[64];
        bf16* dst;
        int pitch;
        if (it < NPI) {
            const int bh = it / (T / 64), tb = it % (T / 64), b = bh >> 2, h = bh & 3, t = tb * 64 + lane;
            const bf16* src = U + (size_t)(b * T + t) * NU + UV + h * 64;
#pragma unroll
            for (int q = 0; q < 8; ++q) { float f[8]; ld8(src + 8 * q, f);
#pragma unroll
                for (int i = 0; i < 8; ++i) v[8 * q + i] = f[i]; }
            dst = VT + (size_t)bh * 64 * VTP + t; pitch = VTP;
        } else {
            const int r = it - NPI, bh = r / (SKP / 64), kb = r % (SKP / 64), b = bh >> 2, h = bh & 3, key = kb * 64 + lane;
            if (key < PAST) { const float* src = in_I_CV + (((size_t)(l * NB + b) * PAST + key) * 256 + h * 64);
#pragma unroll
                for (int q = 0; q < 16; ++q) { const f32x4 x = *(const f32x4*)(src + 4 * q); v[4 * q] = x.x; v[4 * q + 1] = x.y; v[4 * q + 2] = x.z; v[4 * q + 3] = x.w; } }
            else if (key < SKEYS) { const bf16* src = U + (size_t)(MP + b * TS + (key - PAST)) * NU + UV + h * 64;
#pragma unroll
                for (int q = 0; q < 8; ++q) { float f[8]; ld8(src + 8 * q, f);
#pragma unroll
                    for (int i = 0; i < 8; ++i) v[8 * q + i] = f[i]; } }
            else {
#pragma unroll
                for (int i = 0; i < 64; ++i) v[i] = 0.f; }
            dst = SVT + (size_t)bh * 64 * SKP + key; pitch = SKP;
        }
#pragma unroll
        for (int d = 0; d < 64; ++d) dst[(size_t)d * pitch] = (bf16)f2bf(v[d]);
    }
}

constexpr int STEP_B = 1344;
template <int CH>
__device__ __forceinline__ void scan_unit(const Args& a, int l, int unit, unsigned char* lds) {
    constexpr int NP = CH / 16, CHUNK_B = CH * STEP_B;
    struct LdSet { u32x2 r[NP], kh[NP], kk[NP], aa[NP], v[NP]; f32x4 w[NP]; };
    const int tid = ltid();
    KArgP ap = kargs(); unsigned char* ws_l = ap->ws; float* out_l = ap->out;
    const float* in_I_SWKV = ap->in[I_SWKV];
    const int lane = tid & 63, wave = tid >> 6;
    const bool sample = unit >= 128; const int bh = (unit & 127) >> 2, rg = unit & 3, b = bh >> 2, h = bh & 3;
    const int Tn = sample ? TS : T, rowbase = sample ? MP + b * TS : b * T, nch = Tn / CH;
    const unsigned char* rec0 = ws_l + WS_SIN + ((size_t)rowbase * 4 + (size_t)h * Tn) * REC;
    float* YS = (float*)(ws_l + WS_YS);
    const bool loader = wave >= 4;
    const int lt = tid - 256, lstep = lt >> 4, ljq = lt & 15;
    const int rowl = lane >> 4, jq = lane & 15, vrow = rg * 16 + wave * 4 + rowl;
    f32x2v S01 = {0.f, 0.f}, S23 = {0.f, 0.f};
    if (!loader && sample) { const f32x4 s = *(const f32x4*)(in_I_SWKV + ((size_t)((l * NB + b) * 4 + h) * 64 + vrow) * 64 + 4 * jq); S01 = s.lo; S23 = s.hi; }
#define SC_LD(set, chunk) do { if ((chunk) < nch) { _Pragma("unroll") for (int q = 0; q < NP; ++q) { const unsigned char* rp = rec0 + (size_t)((chunk) * CH + 16 * q + lstep) * REC; \
        set.r[q] = *(const u32x2*)(rp + 8 * ljq); set.kh[q] = *(const u32x2*)(rp + 128 + 8 * ljq); set.kk[q] = *(const u32x2*)(rp + 384 + 8 * ljq); set.aa[q] = *(const u32x2*)(rp + 512 + 8 * ljq); \
        set.w[q] = *(const f32x4*)(rp + 640 + 16 * ljq); set.v[q] = *(const u32x2*)(rp + 256 + 2 * (rg * 16) + 8 * (ljq & 3)); } } } while (0)
#define SC_ST(set, bufi) do { _Pragma("unroll") for (int q = 0; q < NP; ++q) { unsigned char* sp = lds + (bufi) * CHUNK_B + (16 * q + lstep) * STEP_B; \
        const f32x4 kkf = {bflo(set.kk[q].x), bfhi(set.kk[q].x), bflo(set.kk[q].y), bfhi(set.kk[q].y)}; const f32x4 af = {bflo(set.aa[q].x), bfhi(set.aa[q].x), bflo(set.aa[q].y), bfhi(set.aa[q].y)}; \
        *(f32x4*)(sp + 16 * ljq) = (f32x4){bflo(set.r[q].x), bfhi(set.r[q].x), bflo(set.r[q].y), bfhi(set.r[q].y)}; \
        *(f32x4*)(sp + 256 + 16 * ljq) = set.w[q]; \
        *(f32x4*)(sp + 512 + 16 * ljq) = (f32x4){bflo(set.kh[q].x), bfhi(set.kh[q].x), bflo(set.kh[q].y), bfhi(set.kh[q].y)}; \
        *(f32x4*)(sp + 768 + 16 * ljq) = kkf; *(f32x4*)(sp + 1024 + 16 * ljq) = kkf * af; \
        if (ljq < 4) *(f32x4*)(sp + 1280 + 16 * ljq) = (f32x4){bflo(set.v[q].x), bfhi(set.v[q].x), bflo(set.v[q].y), bfhi(set.v[q].y)}; } } while (0)
#define SC_RD(slot, s_) do { const unsigned char* sp = cp + (s_) * STEP_B; rr[slot] = *(const f32x4*)(sp + 16 * jq); ww[slot] = *(const f32x4*)(sp + 256 + 16 * jq); kh[slot] = *(const f32x4*)(sp + 512 + 16 * jq); \
        kk[slot] = *(const f32x4*)(sp + 768 + 16 * jq); ka[slot] = *(const f32x4*)(sp + 1024 + 16 * jq); vv[slot] = *(const float*)(sp + 1280 + 4 * (wave * 4 + rowl)); } while (0)
#define SC_SCAN(bufi, chunk) do { const unsigned char* cp = lds + (bufi) * CHUNK_B; float* yp = YS + (size_t)(rowbase + (chunk) * CH + jq) * 256 + h * 64 + vrow; \
        f32x4 rr[3], ww[3], kh[3], kk[3], ka[3]; float vv[3]; float ysel = 0.f; f32x4 rprev = {0.f, 0.f, 0.f, 0.f}; \
        SC_RD(0, 0); SC_RD(1, 1); \
        _Pragma("unroll") for (int s = 0; s < CH; ++s) { const int c_ = s % 3; if (s > 0) rprev = rr[(s + 2) % 3]; if (s + 2 < CH) SC_RD((s + 2) % 3, s + 2); \
            const f32x2v p2 = S01 * kk[c_].lo + S23 * kk[c_].hi; float sa = p2.x + p2.y; \
            if (s > 0) { const f32x2v q2 = S01 * rprev.lo + S23 * rprev.hi; float yq = q2.x + q2.y; red16_2(sa, yq); ysel = (((s - 1) & 15) == jq) ? yq : ysel; if (((s - 1) & 15) == 15) yp[(size_t)(s - 16) * 256] = ysel; } \
            else sa = red16(sa); \
            const f32x2v vk01 = vv[c_] * kh[c_].lo, vk23 = vv[c_] * kh[c_].hi; \
            S01 = S01 * ww[c_].lo + (vk01 - sa * ka[c_].lo); S23 = S23 * ww[c_].hi + (vk23 - sa * ka[c_].hi); } \
        { const int p_ = (CH - 1) % 3; const f32x2v q2 = S01 * rr[p_].lo + S23 * rr[p_].hi; const float yq = red16(q2.x + q2.y); ysel = (15 == jq) ? yq : ysel; yp[(size_t)(CH - 16) * 256] = ysel; } } while (0)
    if (loader) {
        __builtin_amdgcn_s_setprio(2);
        LdSet A, B;
        SC_LD(A, 0); SC_ST(A, 0); SC_LD(A, 1); SC_LD(B, 2);
        __syncthreads();
        for (int ch = 0; ch < nch; ch += 2) {
            if (ch + 1 < nch) SC_ST(A, 1);
            SC_LD(A, ch + 3);
            __syncthreads();
            if (ch + 1 < nch) { if (ch + 2 < nch) SC_ST(B, 0); SC_LD(B, ch + 4); __syncthreads(); }
        }
        __builtin_amdgcn_s_setprio(0);
    } else {
        __syncthreads();
        for (int ch = 0; ch < nch; ch += 2) {
            SC_SCAN(0, ch);
            __syncthreads();
            if (ch + 1 < nch) { SC_SCAN(1, ch + 1); __syncthreads(); }
        }
    }
#undef SC_LD
#undef SC_ST
#undef SC_RD
#undef SC_SCAN
    if (!loader) {
        float* so = out_l + (sample ? O_SWKV : O_PWKV) + ((size_t)((l * NB + b) * 4 + h) * 64 + vrow) * 64 + 4 * jq;
        *(f32x4*)so = (f32x4){S01.x, S01.y, S23.x, S23.y};
    }
}

__device__ __forceinline__ f32x4 mfma16(bf16x8 A, bf16x8 B, f32x4 C) { return __builtin_amdgcn_mfma_f32_16x16x32_bf16(A, B, C, 0, 0, 0); }
__device__ __forceinline__ bf16x8 pack8(const f32x4 lo, const f32x4 hi) {
    u32x4 w; w.x = pk2(lo.x, lo.y); w.y = pk2(lo.z, lo.w); w.z = pk2(hi.x, hi.y); w.w = pk2(hi.z, hi.w); return __builtin_bit_cast(bf16x8, w);
}
__device__ __forceinline__ void attn_unit(const bf16* Q, int qp, const bf16* K, int kp, const bf16* VT, int vp, int qpos0, int kmax, bf16* O, int op, int lane) {
    const int fr = lane & 15, g = lane >> 4;
    bf16x8 qf[2];
#pragma unroll
    for (int ds = 0; ds < 2; ++ds) qf[ds] = *(const bf16x8*)(Q + (size_t)fr * qp + 32 * ds + 8 * g);
    f32x4 o[4];
#pragma unroll
    for (int i = 0; i < 4; ++i) o[i] = (f32x4){0.f, 0.f, 0.f, 0.f};
    float R = 0.f;
    const int qpos = qpos0 + fr;
    u32x4 onesw = {0x3F803F80u, 0x3F803F80u, 0x3F803F80u, 0x3F803F80u};
    const bf16x8 ones = __builtin_bit_cast(bf16x8, onesw);
    bf16x8 kf[4][2];
#define AT_LDK(kt_) do { _Pragma("unroll") for (int kb = 0; kb < 4; ++kb) { int kr = (kt_) * 64 + 16 * kb + fr; kr = kr > kmax ? kmax : kr; const bf16* krow = K + (size_t)kr * kp + 8 * g; \
        kf[kb][0] = *(const bf16x8*)krow; kf[kb][1] = *(const bf16x8*)(krow + 32); } } while (0)
    AT_LDK((qpos0 + 14) >> 6);
    for (int kt = (qpos0 + 14) >> 6; kt >= 0; --kt) {
        const int key0 = kt * 64;
        u32x2 vf[2][4][2];
#pragma unroll
        for (int ks = 0; ks < 2; ++ks)
#pragma unroll
            for (int db = 0; db < 4; ++db) { const bf16* vrow = VT + (size_t)(16 * db + fr) * vp + key0 + 32 * ks + 4 * g; vf[ks][db][0] = *(const u32x2*)vrow; vf[ks][db][1] = *(const u32x2*)(vrow + 16); }
        f32x4 z[4];
#pragma unroll
        for (int kb = 0; kb < 4; ++kb) {
            f32x4 acc = {0.f, 0.f, 0.f, 0.f};
            acc = mfma16(kf[kb][0], qf[0], acc);
            acc = mfma16(kf[kb][1], qf[1], acc);
            z[kb] = acc;
        }
        if (kt > 0) AT_LDK(kt - 1);
        f32x4 lk[4], ls[4]; bool vis[4][4];
#pragma unroll
        for (int kb = 0; kb < 4; ++kb)
#pragma unroll
            for (int r = 0; r < 4; ++r) {
                const int key = key0 + 16 * kb + 4 * g + r;
                const float zz = z[kb][r] * 0.125f, sp = softplus_f(zz);
                vis[kb][r] = key < qpos;
                lk[kb][r] = vis[kb][r] ? -sp : 0.f;
                ls[kb][r] = zz - sp;
            }
        bf16x8 Bhi[2], Blo[2];
#pragma unroll
        for (int ks = 0; ks < 2; ++ks) {
            u32x4 hw, lw;
            { const f32x4 x = lk[2 * ks]; const unsigned h01 = pk2(x.x, x.y), h23 = pk2(x.z, x.w); hw.x = h01; hw.y = h23; lw.x = pk2(x.x - bflo(h01), x.y - bfhi(h01)); lw.y = pk2(x.z - bflo(h23), x.w - bfhi(h23)); }
            { const f32x4 x = lk[2 * ks + 1]; const unsigned h01 = pk2(x.x, x.y), h23 = pk2(x.z, x.w); hw.z = h01; hw.w = h23; lw.z = pk2(x.x - bflo(h01), x.y - bfhi(h01)); lw.w = pk2(x.z - bflo(h23), x.w - bfhi(h23)); }
            Bhi[ks] = __builtin_bit_cast(bf16x8, hw); Blo[ks] = __builtin_bit_cast(bf16x8, lw);
        }
        f32x4 tot = {0.f, 0.f, 0.f, 0.f};
#pragma unroll
        for (int ks = 0; ks < 2; ++ks) { tot = mfma16(ones, Bhi[ks], tot); tot = mfma16(ones, Blo[ks], tot); }
        f32x4 p[4];
#pragma unroll
        for (int kb = 0; kb < 4; ++kb) {
            f32x4 la = {0.f, 0.f, 0.f, 0.f};
            const int s = 16 * kb + fr;
#pragma unroll
            for (int ks = 0; ks < 2; ++ks) {
                if (32 * ks + 31 > 16 * kb) {
                    u32x4 tw;
                    unsigned e[8];
#pragma unroll
                    for (int j = 0; j < 8; ++j) { const int jp = 32 * ks + 16 * (j >> 2) + 4 * g + (j & 3); e[j] = jp > s ? 0x3F80u : 0u; }
                    tw.x = e[0] | (e[1] << 16); tw.y = e[2] | (e[3] << 16); tw.z = e[4] | (e[5] << 16); tw.w = e[6] | (e[7] << 16);
                    const bf16x8 tri = __builtin_bit_cast(bf16x8, tw);
                    la = mfma16(tri, Bhi[ks], la); la = mfma16(tri, Blo[ks], la);
                }
            }
#pragma unroll
            for (int r = 0; r < 4; ++r) p[kb][r] = vis[kb][r] ? __expf(ls[kb][r] + la[r] + R) : 0.f;
        }
        R += tot[0];
#pragma unroll
        for (int ks = 0; ks < 2; ++ks) {
            const bf16x8 pf = pack8(p[2 * ks], p[2 * ks + 1]);
#pragma unroll
            for (int db = 0; db < 4; ++db) {
                u32x4 vw; vw.x = vf[ks][db][0].x; vw.y = vf[ks][db][0].y; vw.z = vf[ks][db][1].x; vw.w = vf[ks][db][1].y;
                o[db] = mfma16(__builtin_bit_cast(bf16x8, vw), pf, o[db]);
            }
        }
        if (__all(R < -110.f)) break;
    }
#undef AT_LDK
#pragma unroll
    for (int db = 0; db < 4; ++db) { u32x2 w; w.x = pk2(o[db][0], o[db][1]); w.y = pk2(o[db][2], o[db][3]); *(u32x2*)(O + (size_t)fr * op + 16 * db + 4 * g) = w; }
}
__device__ __forceinline__ void attn_part(const Args& a, int l, int aw, int naw) {
    const int tid = ltid();
    KArgP ap = kargs(); unsigned char* ws_l = ap->ws; float* out_l = ap->out; (void)ws_l; (void)out_l;
    const bf16* U = (const bf16*)(ws_l + WS_U); bf16* YC = (bf16*)(ws_l + WS_H);
    const bf16* SK = (const bf16*)(ws_l + WS_SKV); const bf16* VT = (const bf16*)(ws_l + WS_VT); const bf16* SVT = (const bf16*)(ws_l + WS_SVT);
    const int lane = tid & 63;
    constexpr int NPU = NB * 4 * (T / 16);
#define AT_PROMPT(bh_, qb_) do { const int b_ = (bh_) >> 2, h_ = (bh_) & 3; const int row0_ = b_ * T + (qb_) * 16; \
        attn_unit(U + (size_t)row0_ * NU + UQ + h_ * 64, NU, U + (size_t)(b_ * T) * NU + UK + h_ * 64, NU, VT + (size_t)(bh_) * 64 * VTP, VTP, (qb_) * 16, T - 1, YC + (size_t)row0_ * D + 768 + h_ * 64, D, lane); } while (0)
#define AT_SAMPLE(u_) do { const int b_ = (u_) >> 2, h_ = (u_) & 3; const int row0_ = MP + b_ * TS; \
        attn_unit(U + (size_t)row0_ * NU + UQ + h_ * 64, NU, SK + (size_t)b_ * SKEYS * 256 + h_ * 64, 256, SVT + (size_t)(u_) * 64 * SKP, SKP, PAST, SKEYS - 1, YC + (size_t)row0_ * D + 768 + h_ * 64, D, lane); } while (0)
    if (naw == 1024) {
        const int cb = aw >> 3, wv = aw & 7, xcd = cb & 7, wx = (cb >> 3) * 8 + wv;
        if (wx < 4) AT_SAMPLE(wx * 8 + xcd);
        for (int k = 0; k < 8; ++k) { const int i = wx + 128 * k; AT_PROMPT(xcd + 8 * (i >> 8), i & 255); }
    } else {
        for (int v = aw; v < NPU; v += naw) AT_PROMPT(v >> 8, v & 255);
        for (int u = aw; u < 32; u += naw) AT_SAMPLE(u);
    }
#undef AT_PROMPT
#undef AT_SAMPLE
}

__device__ __forceinline__ void rwkv_post(const Args& a, int l) {
    const int tid = ltid();
    KArgP ap = kargs(); unsigned char* ws_l = ap->ws;
    const float* in_I_LNB = ap->in[I_LNB]; const float* in_I_LNW = ap->in[I_LNW];
    const float* YS = (const float*)(ws_l + WS_YS); const bf16* Gb = (const bf16*)(ws_l + WS_G); const float* RKb = (const float*)(ws_l + WS_RK);
    bf16* YC = (bf16*)(ws_l + WS_H);
    const int lane = tid & 63, wave = tid >> 6, h = lane >> 4, c4 = 4 * lane, cc = 4 * (lane & 15);
    const f32x4 lnw = *(const f32x4*)(in_I_LNW + l * 256 + c4), lnb = *(const f32x4*)(in_I_LNB + l * 256 + c4);
    const int gw = blockIdx.x * NWAVES + wave, NGW = gridDim.x * NWAVES;
#define PO_BODY(row_, y_, gq_, vq_, rk_) do { \
        const float mean = red16((y_.x + y_.y) + (y_.z + y_.w)) * (1.f / 64.f); const f32x4 dv = y_ - mean; \
        const float var = red16((dv.x * dv.x + dv.y * dv.y) + (dv.z * dv.z + dv.w * dv.w)) * (1.f / 64.f); const float rs = rsqrtf(var + GN_EPS); \
        const float o0 = (dv.x * rs * lnw.x + lnb.x + rk_ * bflo(vq_.x)) * bflo(gq_.x), o1 = (dv.y * rs * lnw.y + lnb.y + rk_ * bfhi(vq_.x)) * bfhi(gq_.x); \
        const float o2 = (dv.z * rs * lnw.z + lnb.z + rk_ * bflo(vq_.y)) * bflo(gq_.y), o3 = (dv.w * rs * lnw.w + lnb.w + rk_ * bfhi(vq_.y)) * bfhi(gq_.y); \
        u32x2 o; o.x = pk2(o0, o1); o.y = pk2(o2, o3); *(u32x2*)(YC + (size_t)(row_) * D + 256 + c4) = o; } while (0)
#define PO_LOAD(r_, y_, g_, v_, k_) do { y_ = *(const f32x4*)(YS + (size_t)(r_) * 256 + c4); g_ = *(const u32x2*)(Gb + (size_t)(r_) * 256 + c4); \
        v_ = *(const u32x2*)(ws_l + WS_SIN + rec_index((r_), h) * REC + 256 + 2 * cc); k_ = RKb[(size_t)(r_) * 4 + h]; } while (0)
    for (int row = gw; row < MR; row += 4 * NGW) {
        f32x4 y0, y1, y2, y3; u32x2 g0, g1, g2, g3, v0, v1, v2, v3; float k0, k1, k2, k3;
        const int r1 = row + NGW, r2 = row + 2 * NGW, r3 = row + 3 * NGW;
        PO_LOAD(row, y0, g0, v0, k0);
        if (r1 < MR) PO_LOAD(r1, y1, g1, v1, k1);
        if (r2 < MR) PO_LOAD(r2, y2, g2, v2, k2);
        if (r3 < MR) PO_LOAD(r3, y3, g3, v3, k3);
        PO_BODY(row, y0, g0, v0, k0);
        if (r1 < MR) PO_BODY(r1, y1, g1, v1, k1);
        if (r2 < MR) PO_BODY(r2, y2, g2, v2, k2);
        if (r3 < MR) PO_BODY(r3, y3, g3, v3, k3);
    }
#undef PO_BODY
#undef PO_LOAD
}

template <int MODE, int K>
__device__ __forceinline__ void small_gemm(const bf16* A, const bf16* Bt, int ncol16, bf16* Ob, float* Of, int ldc, float* sk, float* sv, unsigned char* lds, int bid, int G) {
    constexpr int KW = K / 8, NKS = KW / 32, NB_ = (MODE == 1) ? 4 : 2;
    static_assert(KW % 32 == 0, "K split");
    const int tid = ltid(), lane = tid & 63, wave = tid >> 6, fr = lane & 15, g = lane >> 4;
    float* part = (float*)lds;
    const int nct = ncol16 / 2;
    const bool x8 = (G & 7) == 0;
    const int xq = x8 ? (bid & 7) : 0, xs = x8 ? 8 : 1, jq = x8 ? (bid >> 3) : bid, JQ = x8 ? (G >> 3) : G;
    bf16x8 af[NKS], b0[NKS], b1[NKS], b2[NKS], b3[NKS];
    int n_ = jq;
#define SG_ROW(c_) ((MODE == 1) ? (256 * ((c_) >> 7) + ((c_) & 127)) : (c_))
#define SG_LOAD(nn) do { const int mt_ = (nn) & 7, c0_ = (xq + xs * ((nn) >> 3)) * 32; \
        const bf16* ap_ = A + (size_t)(mt_ * 16 + fr) * K + wave * KW + 8 * g; const bf16* bp_ = Bt + (size_t)(SG_ROW(c0_) + fr) * K + wave * KW + 8 * g; const bf16* bq_ = bp_ + (size_t)16 * K; \
        _Pragma("unroll") for (int q = 0; q < NKS; ++q) { af[q] = *(const bf16x8*)(ap_ + 32 * q); b0[q] = *(const bf16x8*)(bp_ + 32 * q); b1[q] = *(const bf16x8*)(bq_ + 32 * q); \
            if (MODE == 1) { b2[q] = *(const bf16x8*)(bp_ + (size_t)128 * K + 32 * q); b3[q] = *(const bf16x8*)(bq_ + (size_t)128 * K + 32 * q); } } } while (0)
#define SG_VALID(nn) ((xq + xs * ((nn) >> 3)) < nct)
    if (SG_VALID(n_)) SG_LOAD(n_);
    for (int it = 0; SG_VALID(n_); ++it, n_ += JQ) {
        f32x4 acc0 = {0.f, 0.f, 0.f, 0.f}, acc1 = acc0, acc2 = acc0, acc3 = acc0;
#pragma unroll
        for (int q = 0; q < NKS; ++q) { acc0 = mfma16(b0[q], af[q], acc0); acc1 = mfma16(b1[q], af[q], acc1); if (MODE == 1) { acc2 = mfma16(b2[q], af[q], acc2); acc3 = mfma16(b3[q], af[q], acc3); } }
        if (SG_VALID(n_ + JQ)) SG_LOAD(n_ + JQ);
        float* pb = part + (it & 1) * (8 * NB_ * 256);
        *(f32x4*)(pb + (wave * NB_ + 0) * 256 + lane * 4) = acc0; *(f32x4*)(pb + (wave * NB_ + 1) * 256 + lane * 4) = acc1;
        if (MODE == 1) { *(f32x4*)(pb + (wave * NB_ + 2) * 256 + lane * 4) = acc2; *(f32x4*)(pb + (wave * NB_ + 3) * 256 + lane * 4) = acc3; }
        __syncthreads();
        {
            const int sub = tid >> 8, e = tid & 255;
            float s0 = 0.f, s1 = 0.f;
#pragma unroll
            for (int w = 0; w < 8; ++w) { s0 += pb[(w * NB_ + sub) * 256 + e]; if (MODE == 1) s1 += pb[(w * NB_ + 2 + sub) * 256 + e]; }
            const int ln = e >> 2, r = e & 3, mt = n_ & 7, c0 = (xq + xs * (n_ >> 3)) * 32 + 16 * sub;
            const int m = mt * 16 + (ln & 15), n = c0 + 4 * (ln >> 4) + r;
            if (MODE == 0) Ob[(size_t)m * ldc + n] = (bf16)f2bf(s0);
            else if (MODE == 1) Ob[(size_t)m * ldc + n] = (bf16)f2bf(pg8::silu_f(s0) * s1);
            else { Ob[(size_t)m * ldc + n] = (bf16)f2bf(s0); if (n >= UK && n < UK + 512) ((n < UV ? sk : sv) + (size_t)m * 256)[n & 255] = s0; }
        }
    }
#undef SG_LOAD
#undef SG_VALID
#undef SG_ROW
    __syncthreads();
}

#define XB_TMO      128
#define XB_XCNT(j)  (256  + 64 * (j))
#define XB_XSUB(j)  (1280 + 64 * (j))
#define XB_XGEN(j)  (2304 + 64 * (j))
#define XB_TOP      3328
#define XB_TOPGEN   3392
#define XCD_BAR_WORDS 3456
#define XB_SPIN_CAP (1u << 18)

__device__ __forceinline__ unsigned xb_ld(unsigned* p)              { return __hip_atomic_load(p, __ATOMIC_RELAXED, __HIP_MEMORY_SCOPE_AGENT); }
__device__ __forceinline__ unsigned xb_add(unsigned* p, unsigned v) { return __hip_atomic_fetch_add(p, v, __ATOMIC_RELAXED, __HIP_MEMORY_SCOPE_AGENT); }
__device__ __forceinline__ unsigned xb_xcc_id() { return (unsigned)__builtin_amdgcn_s_getreg((3 << 11) | 20) & 0xFu; }
#define XB_SPIN(cond, bar) do { unsigned _sp = 0; while (cond) { __builtin_amdgcn_s_sleep(1); \
    if ((++_sp & 255u) == 0u) { if (xb_ld(&(bar)[XB_TMO])) break; if (_sp > XB_SPIN_CAP) { atomicAdd(&(bar)[XB_TMO], 1u); break; } } } } while (0)

struct XcdBarrier {
    unsigned* bar; unsigned x;
    volatile LAS unsigned* st;
};

__device__ __forceinline__ XcdBarrier xcd_barrier_post(unsigned* bar, volatile LAS unsigned* st) {
    XcdBarrier b; b.bar = bar; b.x = xb_xcc_id(); b.st = st;
    if (threadIdx.x == 0) (void)xb_add(&bar[XB_XCNT(b.x)], 1u);
    return b;
}
__device__ __forceinline__ void xcd_barrier_complete(unsigned* bar, unsigned x, unsigned& nloc, unsigned& nx) {
    const unsigned G = gridDim.x * gridDim.y * gridDim.z;
    unsigned sum, cnt, mine, sp = 0u;
    for (;;) {
        sum = 0u; cnt = 0u; mine = 0u;
#pragma unroll
        for (unsigned j = 0; j < 16; ++j) { const unsigned c = xb_ld(&bar[XB_XCNT(j)]); sum += c; cnt += (c > 0u) ? 1u : 0u; mine = (j == x) ? c : mine; }
        if (sum == G) break;
        __builtin_amdgcn_s_sleep(1);
        if ((++sp & 255u) == 0u) { if (xb_ld(&bar[XB_TMO])) break; if (sp > XB_SPIN_CAP) { atomicAdd(&bar[XB_TMO], 1u); break; } }
    }
    nloc = mine > 0u ? mine : 1u; nx = cnt > 0u ? cnt : 1u;
}

__device__ __forceinline__ void xcd_barrier(const XcdBarrier& b) {
    asm volatile("s_waitcnt vmcnt(0)" ::: "memory");
    __syncthreads();
    if (threadIdx.x == 0) {
        unsigned* bar = b.bar;
        __builtin_amdgcn_s_waitcnt(0);
        unsigned nloc = b.st[0], nx = b.st[1];
        if (nloc == 0u) { xcd_barrier_complete(bar, b.x, nloc, nx); b.st[0] = nloc; b.st[1] = nx; }
        const unsigned old = xb_add(&bar[XB_XSUB(b.x)], 1u);
        const unsigned gen = old / nloc;
        if (old + 1u == (gen + 1u) * nloc) {
            __builtin_amdgcn_fence(__ATOMIC_RELEASE, "agent");
            asm volatile("s_waitcnt vmcnt(0)" ::: "memory");
            const unsigned og = xb_add(&bar[XB_TOP], 1u);
            const unsigned tg = og / nx;
            if (og + 1u == (tg + 1u) * nx) xb_add(&bar[XB_TOPGEN], 1u);
            else XB_SPIN(xb_ld(&bar[XB_TOPGEN]) == tg, bar);
            __builtin_amdgcn_fence(__ATOMIC_ACQUIRE, "agent");
            xb_add(&bar[XB_XGEN(b.x)], 1u);
            asm volatile("s_waitcnt vmcnt(0)" ::: "memory");
        } else {
            XB_SPIN(xb_ld(&bar[XB_XGEN(b.x)]) == gen, bar);
            __builtin_amdgcn_fence(__ATOMIC_ACQUIRE, "agent");
            asm volatile("s_waitcnt vmcnt(0)" ::: "memory");
        }
    }
    __syncthreads();
}

__global__ void __launch_bounds__(NTHR, 2) mk_fwd(Args a) {
    extern __shared__ __attribute__((aligned(16))) unsigned char lds[];
    cg::grid_group grid = cg::this_grid();
    const int lo = MK_PER_PHASE ? a.ph_lo : 0, hi = MK_PER_PHASE ? a.ph_hi : NPH, G = gridDim.x;
#define IN(k) (lo <= (k) && (k) < hi)
    for (int u_ = ltid(); u_ < 64; u_ += NTHR) ((LAS unsigned*)((LAS unsigned char*)lds + 131072))[u_] = 0u;
    __syncthreads();
    (void)xcd_barrier_post((unsigned*)(a.ws + WS_CTL), (volatile LAS unsigned*)((LAS unsigned char*)lds + 131072 + 64));
#define XBAR_NOW() do { XcdBarrier xb_; xb_.bar = (unsigned*)(kargs()->ws + WS_CTL); xb_.x = xb_xcc_id(); xb_.st = (volatile LAS unsigned*)((LAS unsigned char*)lds + 131072 + 64); xcd_barrier(xb_); } while (0)
#define SEAM(k) do { if (IN(k) && IN((k) + 1)) { if ((k) == PH_PRE) grid.sync(); else XBAR_NOW(); } } while (0)
    PG8_LAS unsigned char* ring = (PG8_LAS unsigned char*)lds;
#define PHASE_PTRS KArgP ap = kargs(); unsigned char* ws_ = ap->ws; float* out_ = ap->out; \
    bf16* Wb = (bf16*)(ws_ + WS_W); bf16* H = (bf16*)(ws_ + WS_H); bf16* ACT = (bf16*)(ws_ + WS_U); bf16* Y = (bf16*)(ws_ + WS_Y); float* X = out_ + O_X; bf16* XB = (bf16*)(out_ + O_X); bf16* XALT = (bf16*)(ws_ + WS_Y + (size_t)M * D * 2); \
    const bf16* WL = Wb + (size_t)l * LW; const float* ng = ap->in[I_NG] + (size_t)l * 6 * D; (void)H; (void)ACT; (void)Y; (void)X; (void)XB; (void)XALT; (void)WL; (void)ng;

#define REPEAT(bit) _Pragma("nounroll") for (int rep_ = 0; rep_ < ((REP & (bit)) ? 2 : 1); ++rep_)
#define RSYNC if (rep_) XBAR_NOW();
#define GEMM_MAIN(EPI, Aptr, Wptr, NN, KK, EOBJ) { pg8::Gemm g{Aptr, Wptr, MP, NN, KK}; pg8::StaticOrder S; S.init(MP, NN, G, (int)blockIdx.x); pg8::gemm_phase<EPI, pg8::StaticOrder, true, true>(ring, g, S, EOBJ); }
#define SMALL_IDS const int tid_ = ltid(); const int gw_ = (int)blockIdx.x * NWAVES + (tid_ >> 6), ngw_ = G * NWAVES, lane_ = tid_ & 63;
    if (REP & 16384) { for (int i = 0; i < 20; ++i) XBAR_NOW(); }
    if (IN(PH_PRE)) REPEAT(128) { RSYNC phase_pre(a, lds); }
    SEAM(PH_PRE);
    for (int l = 0; l < 2; ++l) {
        const int p0 = 1 + l * PH_PER_LAYER;
        if (IN(p0 + P_A1)) REPEAT(1) { RSYNC PHASE_PTRS
            { pg8::EpiSwiglu E{ACT, FF}; GEMM_MAIN(pg8::EpiSwiglu, H, WL + W_GUA, 2 * FF, D, E) }
            small_gemm<1, D>(H + (size_t)MP * D, WL + W_GUA, FF / 16, ACT + (size_t)MP * FF, nullptr, FF, nullptr, nullptr, lds, (int)blockIdx.x, G); }
        SEAM(p0 + P_A1);
        if (IN(p0 + P_A2)) REPEAT(2) { RSYNC PHASE_PTRS
            { pg8::EpiBf E{Y, D}; GEMM_MAIN(pg8::EpiBf, ACT, WL + W_DA, D, FF, E) }
            small_gemm<0, FF>(ACT + (size_t)MP * FF, WL + W_DA, D / 16, Y + (size_t)MP * D, nullptr, D, nullptr, nullptr, lds, (int)blockIdx.x, G); }
        SEAM(p0 + P_A2);
        if (IN(p0 + P_A3)) { PHASE_PTRS
            if (l == 0) phase_rowpass<true, false, true>(ap->in[I_XP], ap->in[I_XS], Y, 0.5f, ng + 1 * D, ng + 2 * D, XB, H);
            else        phase_rowpass<false, false, true>(XB, XB, Y, 0.5f, ng + 1 * D, ng + 2 * D, XB, H);
        }
        SEAM(p0 + P_A3);
        if (IN(p0 + P_B1)) REPEAT(4) { RSYNC PHASE_PTRS
            { pg8::EpiU E{ACT, NU, out_ + O_PK + (size_t)l * MP * 256, out_ + O_PV + (size_t)l * MP * 256, out_ + O_SK + (size_t)l * MS * 256, out_ + O_SV + (size_t)l * MS * 256, MP, MR};
              GEMM_MAIN(pg8::EpiU, H, WL + W_IN, NU, D, E) }
            if (G == 256) { if ((int)blockIdx.x >= 128) small_gemm<2, D>(H + (size_t)MP * D, WL + W_IN, NU / 16, ACT + (size_t)MP * NU, nullptr, NU, out_ + O_SK + (size_t)l * MS * 256, out_ + O_SV + (size_t)l * MS * 256, lds, (int)blockIdx.x - 128, 128); }
              else small_gemm<2, D>(H + (size_t)MP * D, WL + W_IN, NU / 16, ACT + (size_t)MP * NU, nullptr, NU, out_ + O_SK + (size_t)l * MS * 256, out_ + O_SV + (size_t)l * MS * 256, lds, (int)blockIdx.x, G); }
        SEAM(p0 + P_B1);
        if (IN(p0 + P_C1)) REPEAT(16) { RSYNC
            skv_part(a, l); vt_part(a, l);
            for (int r4_ = 0; r4_ < ((REP & 4096) ? 2 : 1); ++r4_) rwkv_prep_part(a, l, lds);
        }
        SEAM(p0 + P_C1);
        if (IN(p0 + P_C2)) REPEAT(32) { RSYNC
            _Pragma("nounroll") for (int r2_ = 0; r2_ < ((REP & 256) ? 2 : 1); ++r2_)
            for (int ub = blockIdx.x; ub < 256; ub += G) {
                const int c_ = ub & 127, xcd_ = c_ & 7, idx_ = c_ >> 3, u = (ub & 128) | (((xcd_ * 4 + (idx_ >> 2)) << 2) | (idx_ & 3));
                if (u < 128) scan_unit<32>(a, l, u, lds); else scan_unit<16>(a, l, u, lds); }
            const int ab0 = G / 2;
            if ((int)blockIdx.x >= ab0) { _Pragma("nounroll") for (int r3_ = 0; r3_ < ((REP & 512) ? 2 : 1); ++r3_) attn_part(a, l, ((int)blockIdx.x - ab0) * NWAVES + (int)(ltid() >> 6), (G - ab0) * NWAVES);
                for (int r4_ = 0; r4_ < ((REP & 1024) ? 2 : 1); ++r4_) conv_part(a, l, (int)blockIdx.x - ab0, G - ab0);
                for (int r4_ = 0; r4_ < ((REP & 2048) ? 2 : 1); ++r4_) pool_part(a, l, lds, (int)blockIdx.x - ab0, G - ab0); }
        }
        SEAM(p0 + P_C2);
        if (IN(p0 + P_C3)) REPEAT(64) { RSYNC rwkv_post(a, l); }
        SEAM(p0 + P_C3);
        if (IN(p0 + P_D1)) REPEAT(8) { RSYNC PHASE_PTRS
            { pg8::EpiBf E{Y, D}; GEMM_MAIN(pg8::EpiBf, H, WL + W_OUT, D, D, E) }
            small_gemm<0, D>(H + (size_t)MP * D, WL + W_OUT, D / 16, Y + (size_t)MP * D, nullptr, D, nullptr, nullptr, lds, (int)blockIdx.x, G); }
        SEAM(p0 + P_D1);
        if (IN(p0 + P_D2)) { PHASE_PTRS if (l == 0) phase_rowpass<false, false, true>(XB, XB, Y, 1.0f, ng + 3 * D, ng + 4 * D, XB, H);
            else        phase_rowpass<false, false, true>(XB, XB, Y, 1.0f, ng + 3 * D, ng + 4 * D, XALT, H); }
        SEAM(p0 + P_D2);
        if (IN(p0 + P_E1)) REPEAT(1) { RSYNC PHASE_PTRS
            { pg8::EpiSwiglu E{ACT, FF}; GEMM_MAIN(pg8::EpiSwiglu, H, WL + W_GUB, 2 * FF, D, E) }
            small_gemm<1, D>(H + (size_t)MP * D, WL + W_GUB, FF / 16, ACT + (size_t)MP * FF, nullptr, FF, nullptr, nullptr, lds, (int)blockIdx.x, G); }
        SEAM(p0 + P_E1);
        if (IN(p0 + P_E2)) REPEAT(2) { RSYNC PHASE_PTRS
            { pg8::EpiBf E{Y, D}; GEMM_MAIN(pg8::EpiBf, ACT, WL + W_DB, D, FF, E) }
            small_gemm<0, FF>(ACT + (size_t)MP * FF, WL + W_DB, D / 16, Y + (size_t)MP * D, nullptr, D, nullptr, nullptr, lds, (int)blockIdx.x, G); }
        SEAM(p0 + P_E2);
        if (IN(p0 + P_E3)) { PHASE_PTRS
            if (l == 0) phase_rowpass<false, false, true>(XB, XB, Y, 0.5f, ng + 5 * D, ng + 6 * D, XB, H);
            else        phase_rowpass<false, true, false>(XALT, XALT, Y, 0.5f, ng + 5 * D, ng, X, H);
        }
        SEAM(p0 + P_E3);
    }
#undef IN
#undef SEAM
}

extern "C" void kernel_launch(void* const* d_in, const int* in_sizes, int n_in, void* d_out, int out_size, void* d_ws, size_t ws_size, hipStream_t stream) {
    static int grid = 0;
    if (grid == 0) {
        if (n_in != 28 || (size_t)out_size != O_END || ws_size < WS_END) { fprintf(stderr, "kernel_launch: unexpected shapes: n_in %d out %d ws %zu (need %zu)\n", n_in, out_size, ws_size, (size_t)WS_END); grid = -1; return; }
        int dev = 0, cus = 0, per_cu = 0;
        if (hipGetDevice(&dev) != hipSuccess || hipDeviceGetAttribute(&cus, hipDeviceAttributeMultiprocessorCount, dev) != hipSuccess) { grid = -1; return; }
        if (hipFuncSetAttribute((const void*)mk_fwd, hipFuncAttributeMaxDynamicSharedMemorySize, LDS_BYTES) != hipSuccess) { fprintf(stderr, "kernel_launch: hipFuncSetAttribute failed\n"); grid = -1; return; }
        if (hipOccupancyMaxActiveBlocksPerMultiprocessor(&per_cu, (const void*)mk_fwd, NTHR, LDS_BYTES) != hipSuccess || per_cu < 1) { fprintf(stderr, "kernel_launch: occupancy query says %d\n", per_cu); per_cu = 1; }
        (void)hipGetLastError();
        grid = cus * 1;
    }
    if (grid < 0) return;
    if (hipMemsetAsync((char*)d_ws + WS_CTL, 0, 16384, stream) != hipSuccess) { fprintf(stderr, "kernel_launch: hipMemsetAsync failed\n"); return; }
    Args a{};
    for (int i = 0; i < 28; ++i) a.in[i] = (const float*)d_in[i];
    a.out = (float*)d_out; a.ws = (unsigned char*)d_ws;
#if MK_PER_PHASE
    for (int ph = 0; ph < NPH; ++ph) { a.ph_lo = ph; a.ph_hi = ph + 1; hipLaunchKernelGGL(mk_fwd, dim3(grid), dim3(NTHR), LDS_BYTES, stream, a); }
#else
    a.ph_lo = 0; a.ph_hi = NPH;
    void* args[] = {&a};
    hipError_t e = hipLaunchCooperativeKernel((const void*)mk_fwd, dim3(grid), dim3(NTHR), args, LDS_BYTES, stream);
    if (e != hipSuccess) fprintf(stderr, "kernel_launch: cooperative launch failed: %s (grid %d)\n", hipGetErrorString(e), grid);
#endif
}
```

```cpp
#include <hip/hip_runtime.h>
#include <hip/hip_cooperative_groups.h>
#include <cstdio>
#include <cstdint>
namespace cg = cooperative_groups;
#ifndef MK_PER_PHASE
#define MK_PER_PHASE 0
#endif
#ifndef DIS
#define DIS 0
#endif
__device__ __forceinline__ int ltid() { int t = threadIdx.x; asm volatile("" : "+v"(t)); return t; }
#ifndef REP
#define REP 0
#endif
namespace pg8 {
#define PG8_LAS __attribute__((address_space(3)))
typedef unsigned short bf16_t;
typedef short bf16x8 __attribute__((ext_vector_type(8)));
typedef float f32x4 __attribute__((ext_vector_type(4)));
typedef unsigned u32x4 __attribute__((ext_vector_type(4)));
constexpr int BM = 256, BK = 64, HALF = 128, HTB = HALF * BK * 2  , STAGE_BYTES = 8 * HTB, NXCD = 8, WGM = 8;

__host__ __device__ __forceinline__ int lds_byte(int r, int c) { const int st = (r >> 4) * 2 + (c >> 5), rr = r & 15, cc = c & 31, ob = rr * 64 + cc * 2; return st * 1024 + (ob ^ (((ob >> 9) & 1) << 5)); }
__host__ __device__ __forceinline__ void stage_rc(int b, int& R, int& C) { const int st = b / 1024, sb = b % 1024, swz = sb ^ (((sb >> 9) & 1) << 5); R = (st >> 1) * 16 + swz / 64; C = (st & 1) * 32 + (swz % 64) / 2; }
__host__ __device__ __forceinline__ int perm32(int rho) { const int n = rho >> 4, i = rho & 15; return 8 * (i >> 2) + 4 * n + (i & 3); }

struct Unit { int pm, pn; };
struct Gemm { const bf16_t* A; const bf16_t* Bt; int M, N, K; };

struct StaticOrder {
    int nM, nN, nwg, G, c;
    __host__ __device__ void init(int M, int N, int G_, int c_) { nM = M / BM; nN = N / BM; nwg = nM * nN; G = G_; c = c_; }
    __host__ __device__ bool next(int i, Unit& u) const {
        const long L = (long)i * G + c; if (L >= nwg) return false;
        int wgid = (int)L; { const int q = nwg / NXCD, r = nwg % NXCD, xcd = wgid % NXCD, off = wgid / NXCD; wgid = (xcd < r ? xcd * (q + 1) : r * (q + 1) + (xcd - r) * q) + off; }
        const int nig = WGM * nN, gid = wgid / nig, fm = gid * WGM, gsz = (nM - fm) < WGM ? (nM - fm) : WGM;
        u.pm = fm + ((wgid % nig) % gsz); u.pn = (wgid % nig) / gsz; return true;
    }
    __device__ __forceinline__ void a_ready(const Unit&) const {}
    __device__ __forceinline__ void done(const Unit&) const {}
};

__device__ __forceinline__ unsigned cvt_pk_bf16(float lo, float hi) { unsigned r; asm volatile("v_cvt_pk_bf16_f32 %0, %1, %2" : "=v"(r) : "v"(lo), "v"(hi)); return r; }

__device__ __forceinline__ float silu_f(float x) { return x * __builtin_amdgcn_rcpf(1.0f + __builtin_amdgcn_exp2f(-1.44269504089f * x)); }
struct EpiSwiglu {
    static constexpr bool PERM = true, AFTER_DRAIN = false;
    bf16_t* O; int ldc;
    __device__ __forceinline__ void operator()(const f32x4 (&acc)[2][2][4][2], const Unit& u, int wr, int wc, int fr, int fq) const {
        const int row0 = u.pm * BM + wr * 64 + fr, col0 = u.pn * HALF + wc * 32 + 8 * fq;
#pragma unroll
        for (int ai = 0; ai < 2; ++ai)
#pragma unroll
            for (int m = 0; m < 4; ++m) {
                bf16_t* rowp = O + (size_t)(row0 + ai * HALF + m * 16) * ldc + col0;
                const f32x4 g0 = acc[ai][0][m][0], g1 = acc[ai][0][m][1], u0 = acc[ai][1][m][0], u1 = acc[ai][1][m][1];
                u32x4 w;
                w.x = cvt_pk_bf16(silu_f(g0[0]) * u0[0], silu_f(g0[1]) * u0[1]); w.y = cvt_pk_bf16(silu_f(g0[2]) * u0[2], silu_f(g0[3]) * u0[3]);
                w.z = cvt_pk_bf16(silu_f(g1[0]) * u1[0], silu_f(g1[1]) * u1[1]); w.w = cvt_pk_bf16(silu_f(g1[2]) * u1[2], silu_f(g1[3]) * u1[3]);
                *(u32x4*)rowp = w;
            }
    }
};
struct EpiF32 {
    static constexpr bool PERM = false, AFTER_DRAIN = false;
    float* O; int ldc;
    __device__ __forceinline__ void operator()(const f32x4 (&acc)[2][2][4][2], const Unit& u, int wr, int wc, int fr, int fq) const {
        const int row0 = u.pm * BM + wr * 64 + fr, col0 = u.pn * BM + wc * 32 + 4 * fq;
#pragma unroll
        for (int ai = 0; ai < 2; ++ai)
#pragma unroll
            for (int m = 0; m < 4; ++m) {
                float* rowp = O + (size_t)(row0 + ai * HALF + m * 16) * ldc + col0;
#pragma unroll
                for (int bj = 0; bj < 2; ++bj)
#pragma unroll
                    for (int n = 0; n < 2; ++n) *(f32x4*)(rowp + bj * HALF + n * 16) = acc[ai][bj][m][n];
            }
    }
};
struct EpiU {
    static constexpr bool PERM = true, AFTER_DRAIN = false;
    bf16_t* O; int ldc; float* pk; float* pv; float* sk; float* sv; int mp, mr;
    __device__ __forceinline__ void operator()(const f32x4 (&acc)[2][2][4][2], const Unit& u, int wr, int wc, int fr, int fq) const {
        const int row0 = u.pm * BM + wr * 64 + fr, colt = wc * 32 + 8 * fq;
        const bool kv = (u.pn == 1) || (u.pn == 2);
#pragma unroll
        for (int ai = 0; ai < 2; ++ai)
#pragma unroll
            for (int m = 0; m < 4; ++m) {
                const int row = row0 + ai * HALF + m * 16;
                bf16_t* rowp = O + (size_t)row * ldc + u.pn * BM + colt;
#pragma unroll
                for (int bj = 0; bj < 2; ++bj) {
                    const f32x4 v0 = acc[ai][bj][m][0], v1 = acc[ai][bj][m][1];
                    u32x4 w; w.x = cvt_pk_bf16(v0[0], v0[1]); w.y = cvt_pk_bf16(v0[2], v0[3]); w.z = cvt_pk_bf16(v1[0], v1[1]); w.w = cvt_pk_bf16(v1[2], v1[3]);
                    *(u32x4*)(rowp + bj * HALF) = w;
                    if (kv && row < mr) {
                        float* dst = (row < mp) ? ((u.pn == 1 ? pk : pv) + (size_t)row * 256) : ((u.pn == 1 ? sk : sv) + (size_t)(row - mp) * 256);
                        dst += bj * HALF + colt;
                        *(f32x4*)dst = v0; *(f32x4*)(dst + 4) = v1;
                    }
                }
            }
    }
};
struct EpiBf {
    static constexpr bool PERM = true, AFTER_DRAIN = false;
    bf16_t* O; int ldc;
    __device__ __forceinline__ void operator()(const f32x4 (&acc)[2][2][4][2], const Unit& u, int wr, int wc, int fr, int fq) const {
        const int row0 = u.pm * BM + wr * 64 + fr, col0 = u.pn * BM + wc * 32 + 8 * fq;
#pragma unroll
        for (int ai = 0; ai < 2; ++ai)
#pragma unroll
            for (int m = 0; m < 4; ++m) {
                bf16_t* rowp = O + (size_t)(row0 + ai * HALF + m * 16) * ldc + col0;
#pragma unroll
                for (int bj = 0; bj < 2; ++bj) {
                    const f32x4 v0 = acc[ai][bj][m][0], v1 = acc[ai][bj][m][1];
                    u32x4 w; w.x = cvt_pk_bf16(v0[0], v0[1]); w.y = cvt_pk_bf16(v0[2], v0[3]); w.z = cvt_pk_bf16(v1[0], v1[1]); w.w = cvt_pk_bf16(v1[2], v1[3]);
                    *(u32x4*)(rowp + bj * HALF) = w;
                }
            }
    }
};

template <class Epi, class Sched, bool ALIGN_EPI = false, bool SP2 = false>
__device__ __forceinline__ void gemm_phase(PG8_LAS unsigned char* lds, const Gemm g, const Sched& S, const Epi& E) {
    const int tid = ltid(), wid = __builtin_amdgcn_readfirstlane(tid >> 6), lane = tid & 63, wr = wid >> 2, wc = wid & 3, fr = lane & 15, fq = lane >> 4;
    const int K = g.K, nt = K / BK;
    unsigned voffA[2], voffB[2];
#pragma unroll
    for (int i = 0; i < 2; ++i) { int R, C; stage_rc(tid * 16 + i * 8192, R, C); const int Rb = Epi::PERM ? ((R & ~31) + perm32(R & 31)) : R;
        voffA[i] = (unsigned)(R * K + C) * 2u; voffB[i] = (unsigned)(Rb * K + C) * 2u; }
    const size_t kstep = (size_t)(BK * 2);
    const size_t hstep = (size_t)HALF * K * 2;
    const size_t tstep = 2 * hstep;
    const unsigned ldsw = (unsigned)wid * 1024u;
    const int aoff = lds_byte(wr * 64 + fr, fq * 8), boff = lds_byte(wc * 32 + fr, fq * 8);
#define PG8_SA(b, h) (((b) * 2 + (h)) * HTB)
#define PG8_SB(b, h) ((4 + (b) * 2 + (h)) * HTB)
#define PG8_STAGE(bufoff, gbase, voff) do { _Pragma("unroll") for (int _i = 0; _i < 2; ++_i) \
        __builtin_amdgcn_global_load_lds((const unsigned*)((const char*)(gbase) + (voff)[_i]), (PG8_LAS unsigned*)(lds + (bufoff) + ldsw + _i * 8192), 16, 0, 0); } while (0)
#define PG8_LDA(dst, b, h) do { _Pragma("unroll") for (int m = 0; m < 4; ++m) _Pragma("unroll") for (int k = 0; k < 2; ++k) dst[m][k] = *(const PG8_LAS bf16x8*)(lds + PG8_SA(b, h) + aoff + m * 2048 + k * 1024); } while (0)
#define PG8_LDB(dst, b, h) do { _Pragma("unroll") for (int n = 0; n < 2; ++n) _Pragma("unroll") for (int k = 0; k < 2; ++k) dst[n][k] = *(const PG8_LAS bf16x8*)(lds + PG8_SB(b, h) + boff + n * 2048 + k * 1024); } while (0)
#define PG8_MMA(ai, bj, At, Bt) do { __builtin_amdgcn_s_setprio(1); _Pragma("unroll") for (int m = 0; m < 4; ++m) _Pragma("unroll") for (int n = 0; n < 2; ++n) _Pragma("unroll") for (int k = 0; k < 2; ++k) \
        acc[ai][bj][m][n] = __builtin_amdgcn_mfma_f32_16x16x32_bf16(Bt[n][k], At[m][k], acc[ai][bj][m][n], 0, 0, 0); __builtin_amdgcn_s_setprio(0); } while (0)
#define PG8_WAIT_V(n) asm volatile("s_waitcnt vmcnt(" #n ")" ::: "memory")
#define PG8_WAIT_L(n) asm volatile("s_waitcnt lgkmcnt(" #n ")" ::: "memory")
#define PG8_BAR __builtin_amdgcn_s_barrier()
#define PG8_SCHED __builtin_amdgcn_sched_barrier(0)
    Unit cur, nxt; int ui = 0;
    if (!S.next(0, cur)) return;
    f32x4 acc[2][2][4][2];
#pragma unroll
    for (int a = 0; a < 2; ++a)
#pragma unroll
        for (int b = 0; b < 2; ++b)
#pragma unroll
            for (int m = 0; m < 4; ++m)
#pragma unroll
                for (int n = 0; n < 2; ++n) acc[a][b][m][n] = (f32x4){0.f, 0.f, 0.f, 0.f};
    bf16x8 At[4][2], B0[2][2], B1[2][2];
    const char* cA = (const char*)g.A + (size_t)cur.pm * tstep; const char* cB = (const char*)g.Bt + (size_t)cur.pn * tstep;
    S.a_ready(cur);
    if constexpr (SP2) {
        PG8_STAGE(PG8_SB(0, 0), cB, voffB); PG8_STAGE(PG8_SB(0, 1), cB + hstep, voffB); PG8_STAGE(PG8_SA(0, 0), cA, voffA); PG8_STAGE(PG8_SA(0, 1), cA + hstep, voffA);
        if (wr == 1) PG8_BAR;
        PG8_WAIT_V(2); PG8_BAR;
        PG8_STAGE(PG8_SB(1, 0), cB + kstep, voffB); PG8_STAGE(PG8_SA(1, 0), cA + kstep, voffA); PG8_STAGE(PG8_SB(1, 1), cB + hstep + kstep, voffB);
        PG8_WAIT_V(6); PG8_BAR;
    } else {
        PG8_STAGE(PG8_SB(0, 0), cB, voffB); PG8_STAGE(PG8_SA(0, 0), cA, voffA); PG8_STAGE(PG8_SB(0, 1), cB + hstep, voffB); PG8_STAGE(PG8_SA(0, 1), cA + hstep, voffA);
        if (wr == 1) PG8_BAR;
        PG8_WAIT_V(4); PG8_BAR;
        PG8_STAGE(PG8_SB(1, 0), cB + kstep, voffB); PG8_STAGE(PG8_SA(1, 0), cA + kstep, voffA); PG8_STAGE(PG8_SB(1, 1), cB + hstep + kstep, voffB);
        PG8_WAIT_V(6); PG8_BAR;
    }
    for (;;) {
        const bool has_next = S.next(ui + 1, nxt);
        const char* nA = has_next ? (const char*)g.A + (size_t)nxt.pm * tstep : cA; const char* nB = has_next ? (const char*)g.Bt + (size_t)nxt.pn * tstep : cB;
        for (int t = 0; t < nt; t += 2) {
            const bool last = (t == nt - 2);
            const char* a1 = cA + (size_t)(t + 1) * kstep;
            const char* a2 = last ? nA : cA + (size_t)(t + 2) * kstep; const char* b2 = last ? nB : cB + (size_t)(t + 2) * kstep;
            const char* a3 = a2 + kstep; const char* b3 = b2 + kstep;
            if (last && has_next) S.a_ready(nxt);
            if constexpr (SP2) {
            PG8_LDB(B0, 0, 0); PG8_LDB(B1, 0, 1); PG8_SCHED; PG8_LDA(At, 0, 0); PG8_STAGE(PG8_SA(1, 1), a1 + hstep, voffA);
            PG8_WAIT_V(8); PG8_WAIT_L(0); PG8_BAR; PG8_MMA(0, 0, At, B0); PG8_MMA(0, 1, At, B1); PG8_BAR; PG8_SCHED;
            PG8_LDA(At, 0, 1); PG8_STAGE(PG8_SB(0, 0), b2, voffB); PG8_STAGE(PG8_SB(0, 1), b2 + hstep, voffB); PG8_STAGE(PG8_SA(0, 0), a2, voffA);
            PG8_WAIT_V(8); PG8_WAIT_L(0); PG8_BAR; PG8_MMA(1, 0, At, B0); PG8_MMA(1, 1, At, B1); PG8_BAR; PG8_SCHED;
            PG8_LDB(B0, 1, 0); PG8_LDB(B1, 1, 1); PG8_SCHED; PG8_LDA(At, 1, 0); PG8_STAGE(PG8_SA(0, 1), a2 + hstep, voffA);
            PG8_WAIT_V(8); PG8_WAIT_L(0); PG8_BAR; PG8_MMA(0, 0, At, B0); PG8_MMA(0, 1, At, B1); PG8_BAR; PG8_SCHED;
            PG8_LDA(At, 1, 1); PG8_STAGE(PG8_SB(1, 0), b3, voffB); PG8_STAGE(PG8_SB(1, 1), b3 + hstep, voffB); PG8_STAGE(PG8_SA(1, 0), a3, voffA);
            PG8_WAIT_V(8); PG8_WAIT_L(0); PG8_BAR; PG8_MMA(1, 0, At, B0); PG8_MMA(1, 1, At, B1); PG8_BAR; PG8_SCHED;
            } else {
            PG8_LDB(B0, 0, 0); PG8_SCHED; PG8_LDA(At, 0, 0); PG8_STAGE(PG8_SA(1, 1), a1 + hstep, voffA);
            PG8_WAIT_L(8); PG8_BAR; PG8_WAIT_L(0); PG8_MMA(0, 0, At, B0); PG8_BAR; PG8_SCHED;
            PG8_LDB(B1, 0, 1); PG8_STAGE(PG8_SB(0, 0), b2, voffB);
            PG8_BAR; PG8_WAIT_L(0); PG8_MMA(0, 1, At, B1); PG8_BAR;
            PG8_LDA(At, 0, 1); PG8_STAGE(PG8_SA(0, 0), a2, voffA);
            PG8_BAR; PG8_WAIT_L(0); PG8_MMA(1, 0, At, B0); PG8_BAR; PG8_SCHED;
            PG8_STAGE(PG8_SB(0, 1), b2 + hstep, voffB);
            PG8_WAIT_V(6); PG8_BAR; PG8_MMA(1, 1, At, B1); PG8_BAR;
            PG8_LDB(B0, 1, 0); PG8_SCHED; PG8_LDA(At, 1, 0); PG8_STAGE(PG8_SA(0, 1), a2 + hstep, voffA);
            PG8_WAIT_L(8); PG8_BAR; PG8_WAIT_L(0); PG8_MMA(0, 0, At, B0); PG8_BAR; PG8_SCHED;
            PG8_LDB(B1, 1, 1); PG8_STAGE(PG8_SB(1, 0), b3, voffB);
            PG8_BAR; PG8_WAIT_L(0); PG8_MMA(0, 1, At, B1); PG8_BAR;
            PG8_LDA(At, 1, 1); PG8_STAGE(PG8_SA(1, 0), a3, voffA);
            PG8_BAR; PG8_WAIT_L(0); PG8_MMA(1, 0, At, B0); PG8_BAR; PG8_SCHED;
            PG8_STAGE(PG8_SB(1, 1), b3 + hstep, voffB);
            PG8_WAIT_V(6); PG8_BAR; PG8_MMA(1, 1, At, B1); PG8_BAR;
            }
        }
        if constexpr (ALIGN_EPI) { if (wr == 0) PG8_BAR; }
        if constexpr (!Epi::AFTER_DRAIN) { E(acc, cur, wr, wc, fr, fq); S.done(cur); }
        if (!has_next) break;
#pragma unroll
        for (int a = 0; a < 2; ++a)
#pragma unroll
            for (int b = 0; b < 2; ++b)
#pragma unroll
                for (int m = 0; m < 4; ++m)
#pragma unroll
                    for (int n = 0; n < 2; ++n) acc[a][b][m][n] = (f32x4){0.f, 0.f, 0.f, 0.f};
        cur = nxt; cA = nA; cB = nB; ++ui;
        if constexpr (ALIGN_EPI) { if (wr == 1) PG8_BAR; }
    }
    PG8_WAIT_V(0);
    if constexpr (!ALIGN_EPI) { if (wr == 0) PG8_BAR; }
    PG8_BAR;
    if constexpr (Epi::AFTER_DRAIN) { E.fused(acc, cur, wr, wc, fr, fq, lds, wid, lane); S.done(cur); }
#undef PG8_SA
#undef PG8_SB
#undef PG8_STAGE
#undef PG8_LDA
#undef PG8_LDB
#undef PG8_MMA
#undef PG8_WAIT_V
#undef PG8_WAIT_L
#undef PG8_BAR
#undef PG8_SCHED
}
}

typedef unsigned short bf16;
typedef short bf16x8 __attribute__((ext_vector_type(8)));
typedef float f32x4 __attribute__((ext_vector_type(4)));
typedef unsigned u32x4 __attribute__((ext_vector_type(4)));
typedef unsigned u32x2 __attribute__((ext_vector_type(2)));
#define LAS __attribute__((address_space(3)))
#define LAUNDER(p) asm volatile("" : "+s"(p))

constexpr int D = 1024, T = 4096, NB = 8, TS = 16, PAST = 1024, FF = 2816, RW = 896;
constexpr int MP = NB * T, MS = NB * TS, MR = MP + MS, M = 33024;
constexpr int NU = 2816;
constexpr int UQ = 0, UK = 256, UV = 512, UPOOL = 768, UCB = 1024, UCC = 1280, UCX = 1536, URW = 1792;
constexpr float RMS_EPS = 1e-6f, GN_EPS = 64e-5f;
constexpr int VTP = T + 64;
constexpr int SKEYS = PAST + TS, SKP = 1088;

constexpr size_t O_X = 0, O_PK = 33685504, O_PV = 50462720, O_PWKV = 67239936, O_PSHIFT = 67502080, O_PCONV = 67516416, O_PPOOL = 67524608,
                 O_SK = 67586048, O_SV = 67651584, O_SWKV = 67717120, O_SSHIFT = 67979264, O_SCONV = 67993600, O_SPOOL = 68001792, O_END = 68063232;
constexpr size_t LW = 21233664;
constexpr size_t W_GUA = 0, W_DA = 5767168, W_IN = 8650752, W_OUT = 11534336, W_GUB = 12582912, W_DB = 18350080;
constexpr size_t WS_W = 0, WS_H = 84934656, WS_U = 152567808, WS_Y = 338558976;
constexpr size_t WS_SIN = WS_Y, WS_G = 456458240, WS_RK = 473300992, WS_YS = 473827328, WS_SKV = 507512832, WS_VT = 511772672, WS_SVT = 528812032, WS_CTL = 533268480, WS_END = 533268480 + 16384;
constexpr size_t SKV_ELEMS = (size_t)NB * SKEYS * 256;
constexpr int REC = 896;
static_assert(WS_Y + (size_t)M * D * 4 <= WS_END && WS_SIN + (size_t)MR * 4 * REC == WS_G && WS_G + (size_t)MR * 512 == WS_RK && WS_RK + (size_t)MR * 16 == WS_YS && WS_YS + (size_t)MR * 1024 == WS_SKV && WS_SKV + SKV_ELEMS * 2 == WS_VT && WS_VT + (size_t)32 * 64 * VTP * 2 == WS_SVT && WS_SVT + (size_t)32 * 64 * SKP * 2 == WS_CTL && WS_END <= 536870912, "ws map");
static_assert(WS_U + (size_t)M * NU * 2 == WS_Y && WS_H + (size_t)M * D * 2 == WS_U && 2 * LW * 2 == WS_H, "ws map 2");

constexpr int LDS_BYTES = 147456;
constexpr int NTHR = 512, NWAVES = 8;

constexpr int PH_PRE = 0, PH_PER_LAYER = 12, NPH = 1 + 2 * PH_PER_LAYER;
enum { P_A1 = 0, P_A2, P_A3, P_B1, P_C1, P_C2, P_C3, P_D1, P_D2, P_E1, P_E2, P_E3 };

struct Args { const float* in[28]; float* out; unsigned char* ws; int ph_lo, ph_hi; };
enum { I_XP = 0, I_XS, I_CK, I_CV, I_SWKV, I_SSHIFT, I_SCONV, I_SPOOL, I_NG, I_WG, I_WU, I_WD, I_WIN, I_WOUT, I_POOLW, I_POOLS, I_MU, I_W0, I_W2, I_A0, I_A2, I_G2, I_KK, I_KA, I_RK, I_LNW, I_LNB, I_CONVW };
typedef const __attribute__((address_space(4))) Args* KArgP;
__device__ __forceinline__ KArgP kargs() { KArgP p = (KArgP)__builtin_amdgcn_kernarg_segment_ptr(); asm volatile("" : "+s"(p)); return p; }

__device__ __forceinline__ unsigned f2bf(float f) { return (unsigned)__builtin_bit_cast(unsigned short, (__bf16)f); }
typedef float f32x2_t __attribute__((ext_vector_type(2))); typedef __bf16 bf16x2_t __attribute__((ext_vector_type(2)));
__device__ __forceinline__ unsigned pk2(float lo, float hi) { f32x2_t v = {lo, hi}; bf16x2_t b = __builtin_convertvector(v, bf16x2_t); return __builtin_bit_cast(unsigned, b); }
__device__ __forceinline__ float bf2f(unsigned h) { return __builtin_bit_cast(float, h << 16); }
__device__ __forceinline__ float bflo(unsigned w) { return __builtin_bit_cast(float, w << 16); }
__device__ __forceinline__ float bfhi(unsigned w) { return __builtin_bit_cast(float, w & 0xffff0000u); }
__device__ __forceinline__ float ldbf(const bf16* p) { return bf2f((unsigned)*p); }
template <int CTRL> __device__ __forceinline__ float dppf(float x) { return __builtin_bit_cast(float, __builtin_amdgcn_update_dpp(0, __builtin_bit_cast(int, x), CTRL, 0xF, 0xF, true)); }
__device__ __forceinline__ float red16(float x) {
    x += dppf<0xB1>(x);
    x += dppf<0x4E>(x);
    x += dppf<0x141>(x);
    x += dppf<0x140>(x);
    return x;
}
__device__ __forceinline__ float wave_sum(float v) {
    v = red16(v);
    const int iv = __builtin_bit_cast(int, v);
    return (__builtin_bit_cast(float, __builtin_amdgcn_readlane(iv, 0)) + __builtin_bit_cast(float, __builtin_amdgcn_readlane(iv, 16))) +
           (__builtin_bit_cast(float, __builtin_amdgcn_readlane(iv, 32)) + __builtin_bit_cast(float, __builtin_amdgcn_readlane(iv, 48)));
}
__device__ __forceinline__ void red16_2(float& a, float& b) {
    a += dppf<0xB1>(a); b += dppf<0xB1>(b);
    a += dppf<0x4E>(a); b += dppf<0x4E>(b);
    a += dppf<0x141>(a); b += dppf<0x141>(b);
    a += dppf<0x140>(a); b += dppf<0x140>(b);
}
typedef float f32x2v __attribute__((ext_vector_type(2)));
typedef __bf16 bf2_t __attribute__((ext_vector_type(2)));
__device__ __forceinline__ float dot2bf(unsigned a, unsigned b, float c) { return __builtin_amdgcn_fdot2_f32_bf16(__builtin_bit_cast(bf2_t, a), __builtin_bit_cast(bf2_t, b), c, false); }
__device__ __forceinline__ float sigmoid_f(float x) { return __builtin_amdgcn_rcpf(1.0f + __expf(-x)); }
__device__ __forceinline__ float tanh_f(float x) { return 2.0f * sigmoid_f(2.0f * x) - 1.0f; }
__device__ __forceinline__ float softplus_f(float x) { return fmaxf(x, 0.f) + __logf(1.0f + __expf(-fabsf(x))); }

__device__ __forceinline__ void transpose_item(const float* __restrict__ W, int K, int N, bf16* WT, int dst_row0, float* scr, int kb, int n0, int lane) {
    const int k0 = 64 * kb;
    float wv[32];
#pragma unroll
    for (int i = 0; i < 32; ++i) wv[i] = W[(size_t)(k0 + 2 * i + (lane >> 5)) * N + n0 + (lane & 31)];
#pragma unroll
    for (int i = 0; i < 32; ++i) scr[(2 * i + (lane >> 5)) * 33 + (lane & 31)] = wv[i];
    asm volatile("s_waitcnt lgkmcnt(0)" ::: "memory");
    const int c = lane & 7;
#pragma unroll
    for (int j = 0; j < 4; ++j) { const int n = (lane >> 3) + 8 * j; const float* s = scr + (8 * c) * 33 + n;
        u32x4 o; o.x = pk2(s[0 * 33], s[1 * 33]); o.y = pk2(s[2 * 33], s[3 * 33]); o.z = pk2(s[4 * 33], s[5 * 33]); o.w = pk2(s[6 * 33], s[7 * 33]);
        *(u32x4*)(WT + (size_t)(dst_row0 + n) * K + k0 + 8 * c) = o; }
    asm volatile("s_waitcnt lgkmcnt(0)" ::: "memory");
}
__device__ __forceinline__ int win_rowmap(int n0) { return n0 < 256 ? UPOOL + n0 : (n0 < 1152 ? URW + (n0 - 256) : (n0 < 1920 ? UCB + (n0 - 1152) : n0 - 1920)); }

__device__ __forceinline__ void norm_row_to_bf16(const float* xrow, const float* g, bf16* hrow, int lane) {
    f32x4 v[4]; float s = 0.f;
#pragma unroll
    for (int j = 0; j < 4; ++j) { v[j] = *((const f32x4*)xrow + lane + 64 * j); s += (v[j].x * v[j].x + v[j].y * v[j].y) + (v[j].z * v[j].z + v[j].w * v[j].w); }
    const float rstd = rsqrtf(wave_sum(s) * (1.f / D) + RMS_EPS);
#pragma unroll
    for (int j = 0; j < 4; ++j) { const f32x4 gg = *((const f32x4*)g + lane + 64 * j); u32x2 o; o.x = pk2(v[j].x * rstd * gg.x, v[j].y * rstd * gg.y); o.y = pk2(v[j].z * rstd * gg.z, v[j].w * rstd * gg.w);
        *((u32x2*)hrow + lane + 64 * j) = o; }
}

__device__ __forceinline__ void phase_pre(const Args& a, unsigned char* lds) {
    KArgP ap = kargs(); unsigned char* ws_l = ap->ws; float* out_l = ap->out; (void)ws_l; (void)out_l;
    const float* in_I_NG = ap->in[I_NG];
    const float* in_I_WD = ap->in[I_WD];
    const float* in_I_WG = ap->in[I_WG];
    const float* in_I_WIN = ap->in[I_WIN];
    const float* in_I_WOUT = ap->in[I_WOUT];
    const float* in_I_WU = ap->in[I_WU];
    const float* in_I_XP = ap->in[I_XP];
    const float* in_I_XS = ap->in[I_XS];
    const int tid = ltid(), lane = tid & 63, wave = tid >> 6, G = gridDim.x;
    const int gw = blockIdx.x * NWAVES + wave, NGW = G * NWAVES;
    float* scr = (float*)(lds + wave * 16384);
    bf16* Wb = (bf16*)(ws_l + WS_W);
    constexpr int IT_L = 10304;
    for (int it = gw; it < 2 * IT_L; it += NGW) {
        const int l = it / IT_L; int r = it % IT_L; bf16* WL = Wb + (size_t)l * LW;
        const float* src; int K, N; bf16* dst; int mode;
        if (r < 1408)      { src = in_I_WG + (size_t)(l * 2 + 0) * D * FF; K = D; N = FF; dst = WL + W_GUA; mode = 1; }
        else if ((r -= 1408) < 1408) { src = in_I_WU + (size_t)(l * 2 + 0) * D * FF; K = D; N = FF; dst = WL + W_GUA; mode = 2; }
        else if ((r -= 1408) < 1408) { src = in_I_WD + (size_t)(l * 2 + 0) * FF * D; K = FF; N = D; dst = WL + W_DA; mode = 0; }
        else if ((r -= 1408) < 1344) { src = in_I_WIN + (size_t)l * D * 2688; K = D; N = 2688; dst = WL + W_IN; mode = 3; }
        else if ((r -= 1344) < 512)  { src = in_I_WOUT + (size_t)l * D * D; K = D; N = D; dst = WL + W_OUT; mode = 0; }
        else if ((r -= 512) < 1408)  { src = in_I_WG + (size_t)(l * 2 + 1) * D * FF; K = D; N = FF; dst = WL + W_GUB; mode = 1; }
        else if ((r -= 1408) < 1408) { src = in_I_WU + (size_t)(l * 2 + 1) * D * FF; K = D; N = FF; dst = WL + W_GUB; mode = 2; }
        else { r -= 1408;            src = in_I_WD + (size_t)(l * 2 + 1) * FF * D; K = FF; N = D; dst = WL + W_DB; mode = 0; }
        const int nblk = N / 32, kb = r / nblk, n0 = 32 * (r % nblk);
        int dr = n0;
        if (mode == 1) dr = 256 * (n0 >> 7) + (n0 & 127); else if (mode == 2) dr = 256 * (n0 >> 7) + 128 + (n0 & 127); else if (mode == 3) dr = win_rowmap(n0);
        transpose_item(src, K, N, dst, dr, scr, kb, n0, lane);
    }
    const int gt = blockIdx.x * NTHR + tid, NGT = G * NTHR;
    for (int i = gt; i < 2 * 16384 + 16384; i += NGT) {
        u32x4 z = {0u, 0u, 0u, 0u};
        if (i < 32768) { const int l = i >> 14, o = i & 16383; *((u32x4*)(Wb + (size_t)l * LW + W_IN + (size_t)2688 * D) + o) = z; }
        else { *((u32x4*)((bf16*)(ws_l + WS_H) + (size_t)MR * D) + (i - 32768)) = z; }
    }
    bf16* H = (bf16*)(ws_l + WS_H);
    for (int m = gw; m < MR; m += NGW) {
        const float* xr = m < MP ? in_I_XP + (size_t)m * D : in_I_XS + (size_t)(m - MP) * D;
        norm_row_to_bf16(xr, in_I_NG, H + (size_t)m * D, lane);
    }
}

template <bool SRC_F32, bool DST_F32, bool HAS_H>
__device__ __forceinline__ void phase_rowpass(const void* xp, const void* xs, const bf16* Y, float coef, const float* gpost, const float* gpre, void* xdst, bf16* H) {
    const int tid = ltid(), lane = tid & 63, wave = tid >> 6;
    const int gw = blockIdx.x * NWAVES + wave, NGW = gridDim.x * NWAVES;
    f32x4 y[4], x[4], nxf[4]; u32x2 ny[4], nxb[4];
#define RP_LOAD(m_) do { const bf16* yr_ = Y + (size_t)(m_) * D; \
        _Pragma("unroll") for (int j = 0; j < 4; ++j) ny[j] = *((const u32x2*)yr_ + lane + 64 * j); \
        if (SRC_F32) { const float* xr_ = (m_) < MP ? (const float*)xp + (size_t)(m_) * D : (const float*)xs + (size_t)((m_) - MP) * D; \
            _Pragma("unroll") for (int j = 0; j < 4; ++j) nxf[j] = *((const f32x4*)xr_ + lane + 64 * j); } \
        else { const bf16* xr_ = (const bf16*)xp + (size_t)(m_) * D; \
            _Pragma("unroll") for (int j = 0; j < 4; ++j) nxb[j] = *((const u32x2*)xr_ + lane + 64 * j); } } while (0)
    if (gw < MR) RP_LOAD(gw);
    for (int m = gw; m < MR; m += NGW) {
#pragma unroll
        for (int j = 0; j < 4; ++j) { y[j] = (f32x4){bflo(ny[j].x), bfhi(ny[j].x), bflo(ny[j].y), bfhi(ny[j].y)};
            x[j] = SRC_F32 ? nxf[j] : (f32x4){bflo(nxb[j].x), bfhi(nxb[j].x), bflo(nxb[j].y), bfhi(nxb[j].y)}; }
        if (m + NGW < MR) RP_LOAD(m + NGW);
        float s = 0.f;
#pragma unroll
        for (int j = 0; j < 4; ++j) s += (y[j].x * y[j].x + y[j].y * y[j].y) + (y[j].z * y[j].z + y[j].w * y[j].w);
        const float rstd = rsqrtf(wave_sum(s) * (1.f / D) + RMS_EPS) * coef;
        float s2 = 0.f;
#pragma unroll
        for (int j = 0; j < 4; ++j) { const f32x4 gg = *((const f32x4*)gpost + lane + 64 * j);
            x[j].x += y[j].x * rstd * gg.x; x[j].y += y[j].y * rstd * gg.y; x[j].z += y[j].z * rstd * gg.z; x[j].w += y[j].w * rstd * gg.w;
            s2 += (x[j].x * x[j].x + x[j].y * x[j].y) + (x[j].z * x[j].z + x[j].w * x[j].w);
            if (DST_F32) *((f32x4*)((float*)xdst + (size_t)m * D) + lane + 64 * j) = x[j];
            else { u32x2 o; o.x = pk2(x[j].x, x[j].y); o.y = pk2(x[j].z, x[j].w); *((u32x2*)((bf16*)xdst + (size_t)m * D) + lane + 64 * j) = o; } }
        if (HAS_H) {
            const float r2 = rsqrtf(wave_sum(s2) * (1.f / D) + RMS_EPS);
#pragma unroll
            for (int j = 0; j < 4; ++j) { const f32x4 gg = *((const f32x4*)gpre + lane + 64 * j); u32x2 o; o.x = pk2(x[j].x * r2 * gg.x, x[j].y * r2 * gg.y); o.y = pk2(x[j].z * r2 * gg.z, x[j].w * r2 * gg.w);
                *((u32x2*)(H + (size_t)m * D) + lane + 64 * j) = o; }
        }
    }
#undef RP_LOAD
}

__device__ __forceinline__ void ld8(const bf16* p, float (&f)[8]) {
    const u32x4 w = *(const u32x4*)p;
    f[0] = bflo(w.x); f[1] = bfhi(w.x); f[2] = bflo(w.y); f[3] = bfhi(w.y); f[4] = bflo(w.z); f[5] = bfhi(w.z); f[6] = bflo(w.w); f[7] = bfhi(w.w);
}
__device__ __forceinline__ void conv_part(const Args& a, int l, int bid, int nblk) {
    const int tid = ltid();
    KArgP ap = kargs(); unsigned char* ws_l = ap->ws; float* out_l = ap->out; (void)ws_l; (void)out_l;
    const float* in_I_CONVW = ap->in[I_CONVW];
    const float* in_I_SCONV = ap->in[I_SCONV];
    const bf16* U = (const bf16*)(ws_l + WS_U); bf16* YC = (bf16*)(ws_l + WS_H);
    const float* cw = in_I_CONVW + (size_t)l * 3 * 256;
    const int gt = bid * NTHR + tid, NGT = nblk * NTHR;
    for (int it = gt; it < MR * 32; it += NGT) {
        const int row = it >> 5, c8 = (it & 31) * 8;
        int b, t, Tn; const float* prefix; float* sout;
        if (row < MP) { b = row >> 12; t = row & 4095; Tn = T; prefix = nullptr; sout = out_l + O_PCONV + (size_t)(l * NB + b) * 2 * 256; }
        else { const int rr = row - MP; b = rr >> 4; t = rr & 15; Tn = TS; prefix = in_I_SCONV + (size_t)(l * NB + b) * 2 * 256; sout = out_l + O_SCONV + (size_t)(l * NB + b) * 2 * 256; }
        const bf16* ur = U + (size_t)row * NU;
        float bg[8], z0[8], z1[8], z2[8], cc[8], xx[8];
        ld8(ur + UCB + c8, bg); ld8(ur + UCC + c8, cc); ld8(ur + UCX + c8, xx);
#pragma unroll
        for (int i = 0; i < 8; ++i) z2[i] = cc[i] * xx[i];
        if (t >= 1) { ld8(ur - NU + UCC + c8, cc); ld8(ur - NU + UCX + c8, xx);
#pragma unroll
            for (int i = 0; i < 8; ++i) z1[i] = cc[i] * xx[i]; }
        else {
#pragma unroll
            for (int i = 0; i < 8; ++i) z1[i] = prefix ? prefix[256 + c8 + i] : 0.f; }
        if (t >= 2) { ld8(ur - 2 * NU + UCC + c8, cc); ld8(ur - 2 * NU + UCX + c8, xx);
#pragma unroll
            for (int i = 0; i < 8; ++i) z0[i] = cc[i] * xx[i]; }
        else {
#pragma unroll
            for (int i = 0; i < 8; ++i) z0[i] = prefix ? prefix[(t + 0) * 256 + c8 + i] : 0.f; }
        float y[8];
#pragma unroll
        for (int i = 0; i < 8; ++i) y[i] = bg[i] * (z0[i] * cw[c8 + i] + z1[i] * cw[256 + c8 + i] + z2[i] * cw[512 + c8 + i]);
        u32x4 o; o.x = pk2(y[0], y[1]); o.y = pk2(y[2], y[3]); o.z = pk2(y[4], y[5]); o.w = pk2(y[6], y[7]);
        *(u32x4*)(YC + (size_t)row * D + 512 + c8) = o;
        if (t >= Tn - 2) { float* so = sout + (size_t)(t - (Tn - 2)) * 256 + c8;
            *(f32x4*)so = (f32x4){z2[0], z2[1], z2[2], z2[3]}; *(f32x4*)(so + 4) = (f32x4){z2[4], z2[5], z2[6], z2[7]}; }
    }
}

template <int W>
__device__ __forceinline__ void pool_window(const float (&vals)[31], int pos0, float (&d)[16]) {
#pragma unroll
    for (int i = 0; i < 16; ++i) {
        float s = 0.f;
#pragma unroll
        for (int k = 0; k < W; ++k) s += vals[15 + i - k];
        const int cnt = (pos0 + i + 1) < W ? (pos0 + i + 1) : W;
        d[i] = s / (float)cnt - vals[15 + i];
    }
}
__device__ __forceinline__ void pool_part(const Args& a, int l, unsigned char* lds, int bid, int nblk) {
    KArgP ap = kargs(); unsigned char* ws_l = ap->ws; float* out_l = ap->out; (void)ws_l; (void)out_l;
    const float* in_I_POOLS = ap->in[I_POOLS];
    const float* in_I_POOLW = ap->in[I_POOLW];
    const float* in_I_SPOOL = ap->in[I_SPOOL];
    const bf16* U = (const bf16*)(ws_l + WS_U); bf16* YC = (bf16*)(ws_l + WS_H);
    bf16* dl = (bf16*)lds;
    const int tid = ltid(), c = tid & 255, th = tid >> 8, gi = c >> 6;
    const float* pw = in_I_POOLW + (size_t)(l * 4 + gi) * 64 * 64 + (c & 63);
    const float scale = in_I_POOLS[l * 256 + c];
    for (int item = bid; item < MR / 32; item += nblk) {
        const int row0 = item * 32 + th * 16;
        int b, t0, pos0, Tn; const float* prefix; float* sout;
        if (row0 < MP) { b = row0 >> 12; t0 = row0 & 4095; pos0 = t0; Tn = T; prefix = nullptr; sout = out_l + O_PPOOL + (size_t)(l * NB + b) * 15 * 256; }
        else { const int rr = row0 - MP; b = rr >> 4; t0 = 0; pos0 = PAST; Tn = TS; prefix = in_I_SPOOL + (size_t)(l * NB + b) * 15 * 256; sout = out_l + O_SPOOL + (size_t)(l * NB + b) * 15 * 256; }
        float vals[31];
#pragma unroll
        for (int i = 0; i < 31; ++i) {
            const int tt = t0 - 15 + i;
            vals[i] = (tt >= 0) ? ldbf(U + (size_t)(row0 - 15 + i) * NU + UPOOL + c) : (prefix ? prefix[(size_t)(i + t0) * 256 + c] : 0.f);
        }
        float d[16];
        if (gi == 0) pool_window<2>(vals, pos0, d); else if (gi == 1) pool_window<4>(vals, pos0, d); else if (gi == 2) pool_window<8>(vals, pos0, d); else pool_window<16>(vals, pos0, d);
#pragma unroll
        for (int i = 0; i < 16; ++i) {
            dl[(th * 16 + i) * 256 + c] = (bf16)f2bf(d[i]);
            const int t = t0 + i; if (t >= Tn - 15) sout[(size_t)(t - (Tn - 15)) * 256 + c] = vals[15 + i];
        }
        __syncthreads();
        float acc[16];
#pragma unroll
        for (int i = 0; i < 16; ++i) acc[i] = 0.f;
        for (int j8 = 0; j8 < 8; ++j8) {
            const unsigned w01 = pk2(pw[(8 * j8 + 0) * 64], pw[(8 * j8 + 1) * 64]), w23 = pk2(pw[(8 * j8 + 2) * 64], pw[(8 * j8 + 3) * 64]);
            const unsigned w45 = pk2(pw[(8 * j8 + 4) * 64], pw[(8 * j8 + 5) * 64]), w67 = pk2(pw[(8 * j8 + 6) * 64], pw[(8 * j8 + 7) * 64]);
#pragma unroll
            for (int i = 0; i < 16; ++i) { const u32x4 dv = *(const u32x4*)(dl + (th * 16 + i) * 256 + gi * 64 + 8 * j8);
                acc[i] = dot2bf(dv.w, w67, dot2bf(dv.z, w45, dot2bf(dv.y, w23, dot2bf(dv.x, w01, acc[i])))); }
        }
#pragma unroll
        for (int i = 0; i < 16; ++i) YC[(size_t)(row0 + i) * D + c] = (bf16)f2bf(acc[i] * scale);
        __syncthreads();
    }
}

__device__ __forceinline__ size_t rec_index(int row, int h) {
    if (row < MP) { const int b = row >> 12, t = row & 4095; return ((size_t)b * T) * 4 + (size_t)h * T + t; }
    const int rr = row - MP, b = rr >> 4, t = rr & 15; return ((size_t)MP + (size_t)b * TS) * 4 + (size_t)h * TS + t;
}
__device__ __forceinline__ void rwkv_prep_part(const Args& a, int l, unsigned char* lds) {
    const int tid = ltid();
    KArgP ap = kargs(); unsigned char* ws_l = ap->ws; float* out_l = ap->out;
    const float* in_I_A0 = ap->in[I_A0]; const float* in_I_A2 = ap->in[I_A2]; const float* in_I_G2 = ap->in[I_G2]; const float* in_I_KA = ap->in[I_KA]; const float* in_I_KK = ap->in[I_KK];
    const float* in_I_MU = ap->in[I_MU]; const float* in_I_RK = ap->in[I_RK]; const float* in_I_SSHIFT = ap->in[I_SSHIFT]; const float* in_I_W0 = ap->in[I_W0]; const float* in_I_W2 = ap->in[I_W2];
    const bf16* U = (const bf16*)(ws_l + WS_U);
    unsigned char* SIN = ws_l + WS_SIN; bf16* Gb = (bf16*)(ws_l + WS_G); float* RKb = (float*)(ws_l + WS_RK);
    bf16* lrb = (bf16*)lds;
    const int lane = tid & 63, c = tid & 255, half = tid >> 8, h = c >> 6, cc = c & 63;
    const float* mu = in_I_MU + (size_t)l * RW;
    const float mur = mu[c], muk = mu[256 + c], muv = mu[512 + c];
    const float w0c = in_I_W0[l * 256 + c], a0c = in_I_A0[l * 256 + c], kkc = in_I_KK[l * 256 + c], kac = in_I_KA[l * 256 + c], rkc = in_I_RK[l * 256 + c];
    unsigned w2p[16], a2p[16], g2p[32];
#pragma unroll
    for (int i = 0; i < 16; ++i) { w2p[i] = pk2(in_I_W2[(size_t)(l * 32 + 2 * i) * 256 + c], in_I_W2[(size_t)(l * 32 + 2 * i + 1) * 256 + c]);
                                   a2p[i] = pk2(in_I_A2[(size_t)(l * 32 + 2 * i) * 256 + c], in_I_A2[(size_t)(l * 32 + 2 * i + 1) * 256 + c]); }
#pragma unroll
    for (int i = 0; i < 32; ++i) g2p[i] = pk2(in_I_G2[(size_t)(l * 64 + 2 * i) * 256 + c], in_I_G2[(size_t)(l * 64 + 2 * i + 1) * 256 + c]);
    constexpr int TPI = 16, TPH = 8;
    for (int item = blockIdx.x; item < MR / TPI; item += gridDim.x) {
        const int row0 = item * TPI;
#pragma unroll
        for (int k = 0; k < TPI / 4; ++k) {
            const int idx = tid + NTHR * k, tok = idx >> 7, col = idx & 127, row = row0 + tok;
            int t, Tn; const float* shift; float* sout;
            if (row < MP) { t = row & 4095; Tn = T; shift = nullptr; sout = out_l + O_PSHIFT + (size_t)(l * NB + (row >> 12)) * RW; }
            else { const int rr = row - MP; t = rr & 15; Tn = TS; shift = in_I_SSHIFT + (size_t)(l * NB + (rr >> 4)) * RW; sout = out_l + O_SSHIFT + (size_t)(l * NB + (rr >> 4)) * RW; }
            const float cur = ldbf(U + (size_t)row * NU + URW + 768 + col);
            const float prev = (t > 0) ? ldbf(U + (size_t)(row - 1) * NU + URW + 768 + col) : (shift ? shift[768 + col] : 0.f);
            const float xs = cur + (prev - cur) * mu[768 + col];
            lrb[tok * 128 + col] = (bf16)f2bf(col < 32 ? tanh_f(xs) : (col < 64 ? xs : sigmoid_f(xs)));
            if (t == Tn - 1) sout[768 + col] = cur;
        }
        __syncthreads();
        const int rowh = row0 + half * TPH;
        int t0, Tn; const float* shift; float* sout;
        if (rowh < MP) { t0 = rowh & 4095; Tn = T; shift = nullptr; sout = out_l + O_PSHIFT + (size_t)(l * NB + (rowh >> 12)) * RW; }
        else { const int rr = rowh - MP; t0 = rr & 15; Tn = TS; shift = in_I_SSHIFT + (size_t)(l * NB + (rr >> 4)) * RW; sout = out_l + O_SSHIFT + (size_t)(l * NB + (rr >> 4)) * RW; }
        const bf16* ur = U + (size_t)rowh * NU + URW;
        float rp, kp, vp;
        if (t0 > 0) { rp = ldbf(ur - NU + c); kp = ldbf(ur - NU + 256 + c); vp = ldbf(ur - NU + 512 + c); }
        else if (shift) { rp = shift[c]; kp = shift[256 + c]; vp = shift[512 + c]; }
        else { rp = 0.f; kp = 0.f; vp = 0.f; }
        float rua[TPH], kua[TPH], vua[TPH];
#pragma unroll
        for (int i = 0; i < TPH; ++i) { rua[i] = ldbf(ur + (size_t)i * NU + c); kua[i] = ldbf(ur + (size_t)i * NU + 256 + c); vua[i] = ldbf(ur + (size_t)i * NU + 512 + c); }
#pragma unroll
        for (int i = 0; i < TPH; ++i) {
            const int tok = half * TPH + i, row = rowh + i, t = t0 + i;
            const float ru = rua[i], ku = kua[i], vu = vua[i];
            const float r = ru + (rp - ru) * mur, k = ku + (kp - ku) * muk, v = vu + (vp - vu) * muv;
            rp = ru; kp = ku; vp = vu;
            if (t == Tn - 1) { sout[c] = ru; sout[256 + c] = ku; sout[512 + c] = vu; }
            const u32x4* lt = (const u32x4*)(lrb + tok * 128);
            float wp = w0c, ap2 = a0c, gg = 0.f;
#pragma unroll
            for (int j = 0; j < 4; ++j) { const u32x4 x = lt[j]; wp = dot2bf(x.x, w2p[4 * j], wp); wp = dot2bf(x.y, w2p[4 * j + 1], wp); wp = dot2bf(x.z, w2p[4 * j + 2], wp); wp = dot2bf(x.w, w2p[4 * j + 3], wp); }
#pragma unroll
            for (int j = 0; j < 4; ++j) { const u32x4 x = lt[4 + j]; ap2 = dot2bf(x.x, a2p[4 * j], ap2); ap2 = dot2bf(x.y, a2p[4 * j + 1], ap2); ap2 = dot2bf(x.z, a2p[4 * j + 2], ap2); ap2 = dot2bf(x.w, a2p[4 * j + 3], ap2); }
#pragma unroll
            for (int j = 0; j < 8; ++j) { const u32x4 x = lt[8 + j]; gg = dot2bf(x.x, g2p[4 * j], gg); gg = dot2bf(x.y, g2p[4 * j + 1], gg); gg = dot2bf(x.z, g2p[4 * j + 2], gg); gg = dot2bf(x.w, g2p[4 * j + 3], gg); }
            const float w = -softplus_f(-wp) - 0.5f;
            const float decay = __expf(-__expf(w));
            const float aa = sigmoid_f(ap2);
            const float kkr = k * kkc;
            const float nrm = sqrtf(wave_sum(kkr * kkr));
            const float kk = kkr / fmaxf(nrm, 1e-12f);
            const float kh = k * (1.0f + (aa - 1.0f) * kac);
            const float rks = wave_sum(r * kh * rkc);
            unsigned char* rec = SIN + rec_index(row, h) * REC;
            ((bf16*)rec)[cc] = (bf16)f2bf(r); ((bf16*)rec)[64 + cc] = (bf16)f2bf(kh); ((bf16*)rec)[128 + cc] = (bf16)f2bf(v); ((bf16*)rec)[192 + cc] = (bf16)f2bf(kk); ((bf16*)rec)[256 + cc] = (bf16)f2bf(aa);
            ((float*)(rec + 640))[cc] = decay;
            Gb[(size_t)row * 256 + c] = (bf16)f2bf(gg);
            if (lane == 0) RKb[(size_t)row * 4 + h] = rks;
        }
        __syncthreads();
    }
}
__device__ __forceinline__ void skv_part(const Args& a, int l) {
    const int tid = ltid();
    KArgP ap = kargs(); unsigned char* ws_l = ap->ws;
    const float* in_I_CK = ap->in[I_CK];
    const bf16* U = (const bf16*)(ws_l + WS_U); bf16* SK = (bf16*)(ws_l + WS_SKV);
    const int gt = blockIdx.x * NTHR + tid, NGT = gridDim.x * NTHR;
    for (int it = gt; it < NB * SKEYS * 32; it += NGT) {
        const int c8 = (it & 31) * 8, kr = it >> 5, b = kr / SKEYS, key = kr % SKEYS;
        bf16* dst = SK + ((size_t)b * SKEYS + key) * 256 + c8;
        if (key < PAST) {
            const float* src = in_I_CK + (((size_t)(l * NB + b) * PAST + key) * 256 + c8);
            const f32x4 x0 = *(const f32x4*)src, x1 = *(const f32x4*)(src + 4);
            u32x4 o; o.x = pk2(x0.x, x0.y); o.y = pk2(x0.z, x0.w); o.z = pk2(x1.x, x1.y); o.w = pk2(x1.z, x1.w);
            *(u32x4*)dst = o;
        } else {
            *(u32x4*)dst = *(const u32x4*)(U + (size_t)(MP + b * TS + (key - PAST)) * NU + UK + c8);
        }
    }
}
__device__ __forceinline__ void vt_part(const Args& a, int l) {
    const int tid = ltid();
    KArgP ap = kargs(); unsigned char* ws_l = ap->ws;
    const float* in_I_CV = ap->in[I_CV];
    const bf16* U = (const bf16*)(ws_l + WS_U); bf16* VT = (bf16*)(ws_l + WS_VT); bf16* SVT = (bf16*)(ws_l + WS_SVT);
    const int lane = tid & 63, gw = blockIdx.x * NWAVES + (tid >> 6), NGW = gridDim.x * NWAVES;
    constexpr int NPI = 32 * (T / 64), NSI = 32 * (SKP / 64);
    const bool x8 = (gridDim.x & 7) == 0;
    const int xcd = (int)blockIdx.x & 7, wx = ((int)blockIdx.x >> 3) * NWAVES + (tid >> 6), nwx = ((int)gridDim.x >> 3) * NWAVES;
    constexpr int PPX = 4 * (T / 64), SPX = 4 * (SKP / 64);
    for (int i0 = x8 ? wx : gw; i0 < (x8 ? PPX + SPX : NPI + NSI); i0 += (x8 ? nwx : NGW)) {
        int it;
        if (!x8) it = i0;
        else if (i0 < PPX) it = (xcd + 8 * (i0 / (T / 64))) * (T / 64) + (i0 % (T / 64));
        else { const int r_ = i0 - PPX; it = NPI + (xcd + 8 * (r_ / (SKP / 64))) * (SKP / 64) + (r_ % (SKP / 64)); }
        float v[64];
        bf16* dst;
        int pitch;
        if (it < NPI) {
            const int bh = it / (T / 64), tb = it % (T / 64), b = bh >> 2, h = bh & 3, t = tb * 64 + lane;
            const bf16* src = U + (size_t)(b * T + t) * NU + UV + h * 64;
#pragma unroll
            for (int q = 0; q < 8; ++q) { float f[8]; ld8(src + 8 * q, f);
#pragma unroll
                for (int i = 0; i < 8; ++i) v[8 * q + i] = f[i]; }
            dst = VT + (size_t)bh * 64 * VTP + t; pitch = VTP;
        } else {
            const int r = it - NPI, bh = r / (SKP / 64), kb = r % (SKP / 64), b = bh >> 2, h = bh & 3, key = kb * 64 + lane;
            if (key < PAST) { const float* src = in_I_CV + (((size_t)(l * NB + b) * PAST + key) * 256 + h * 64);
#pragma unroll
                for (int q = 0; q < 16; ++q) { const f32x4 x = *(const f32x4*)(src + 4 * q); v[4 * q] = x.x; v[4 * q + 1] = x.y; v[4 * q + 2] = x.z; v[4 * q + 3] = x.w; } }
            else if (key < SKEYS) { const bf16* src = U + (size_t)(MP + b * TS + (key - PAST)) * NU + UV + h * 64;
#pragma unroll
                for (int q = 0; q < 8; ++q) { float f[8]; ld8(src + 8 * q, f);
#pragma unroll
                    for (int i = 0; i < 8; ++i) v[8 * q + i] = f[i]; } }
            else {
#pragma unroll
                for (int i = 0; i < 64; ++i) v[i] = 0.f; }
            dst = SVT + (size_t)bh * 64 * SKP + key; pitch = SKP;
        }
#pragma unroll
        for (int d = 0; d < 64; ++d) dst[(size_t)d * pitch] = (bf16)f2bf(v[d]);
    }
}

constexpr int STEP_B = 1344;
template <int CH>
__device__ __forceinline__ void scan_unit(const Args& a, int l, int unit, unsigned char* lds) {
    constexpr int NP = CH / 16, CHUNK_B = CH * STEP_B;
    struct LdSet { u32x2 r[NP], kh[NP], kk[NP], aa[NP], v[NP]; f32x4 w[NP]; };
    const int tid = ltid();
    KArgP ap = kargs(); unsigned char* ws_l = ap->ws; float* out_l = ap->out;
    const float* in_I_SWKV = ap->in[I_SWKV];
    const int lane = tid & 63, wave = tid >> 6;
    const bool sample = unit >= 128; const int bh = (unit & 127) >> 2, rg = unit & 3, b = bh >> 2, h = bh & 3;
    const int Tn = sample ? TS : T, rowbase = sample ? MP + b * TS : b * T, nch = Tn / CH;
    const unsigned char* rec0 = ws_l + WS_SIN + ((size_t)rowbase * 4 + (size_t)h * Tn) * REC;
    float* YS = (float*)(ws_l + WS_YS);
    const bool loader = wave >= 4;
    const int lt = tid - 256, lstep = lt >> 4, ljq = lt & 15;
    const int rowl = lane >> 4, jq = lane & 15, vrow = rg * 16 + wave * 4 + rowl;
    f32x2v S01 = {0.f, 0.f}, S23 = {0.f, 0.f};
    if (!loader && sample) { const f32x4 s = *(const f32x4*)(in_I_SWKV + ((size_t)((l * NB + b) * 4 + h) * 64 + vrow) * 64 + 4 * jq); S01 = s.lo; S23 = s.hi; }
#define SC_LD(set, chunk) do { if ((chunk) < nch) { _Pragma("unroll") for (int q = 0; q < NP; ++q) { const unsigned char* rp = rec0 + (size_t)((chunk) * CH + 16 * q + lstep) * REC; \
        set.r[q] = *(const u32x2*)(rp + 8 * ljq); set.kh[q] = *(const u32x2*)(rp + 128 + 8 * ljq); set.kk[q] = *(const u32x2*)(rp + 384 + 8 * ljq); set.aa[q] = *(const u32x2*)(rp + 512 + 8 * ljq); \
        set.w[q] = *(const f32x4*)(rp + 640 + 16 * ljq); set.v[q] = *(const u32x2*)(rp + 256 + 2 * (rg * 16) + 8 * (ljq & 3)); } } } while (0)
#define SC_ST(set, bufi) do { _Pragma("unroll") for (int q = 0; q < NP; ++q) { unsigned char* sp = lds + (bufi) * CHUNK_B + (16 * q + lstep) * STEP_B; \
        const f32x4 kkf = {bflo(set.kk[q].x), bfhi(set.kk[q].x), bflo(set.kk[q].y), bfhi(set.kk[q].y)}; const f32x4 af = {bflo(set.aa[q].x), bfhi(set.aa[q].x), bflo(set.aa[q].y), bfhi(set.aa[q].y)}; \
        *(f32x4*)(sp + 16 * ljq) = (f32x4){bflo(set.r[q].x), bfhi(set.r[q].x), bflo(set.r[q].y), bfhi(set.r[q].y)}; \
        *(f32x4*)(sp + 256 + 16 * ljq) = set.w[q]; \
        *(f32x4*)(sp + 512 + 16 * ljq) = (f32x4){bflo(set.kh[q].x), bfhi(set.kh[q].x), bflo(set.kh[q].y), bfhi(set.kh[q].y)}; \
        *(f32x4*)(sp + 768 + 16 * ljq) = kkf; *(f32x4*)(sp + 1024 + 16 * ljq) = kkf * af; \
        if (ljq < 4) *(f32x4*)(sp + 1280 + 16 * ljq) = (f32x4){bflo(set.v[q].x), bfhi(set.v[q].x), bflo(set.v[q].y), bfhi(set.v[q].y)}; } } while (0)
#define SC_RD(slot, s_) do { const unsigned char* sp = cp + (s_) * STEP_B; rr[slot] = *(const f32x4*)(sp + 16 * jq); ww[slot] = *(const f32x4*)(sp + 256 + 16 * jq); kh[slot] = *(const f32x4*)(sp + 512 + 16 * jq); \
        kk[slot] = *(const f32x4*)(sp + 768 + 16 * jq); ka[slot] = *(const f32x4*)(sp + 1024 + 16 * jq); vv[slot] = *(const float*)(sp + 1280 + 4 * (wave * 4 + rowl)); } while (0)
#define SC_SCAN(bufi, chunk) do { const unsigned char* cp = lds + (bufi) * CHUNK_B; float* yp = YS + (size_t)(rowbase + (chunk) * CH + jq) * 256 + h * 64 + vrow; \
        f32x4 rr[3], ww[3], kh[3], kk[3], ka[3]; float vv[3]; float ysel = 0.f; f32x4 rprev = {0.f, 0.f, 0.f, 0.f}; \
        SC_RD(0, 0); SC_RD(1, 1); \
        _Pragma("unroll") for (int s = 0; s < CH; ++s) { const int c_ = s % 3; if (s > 0) rprev = rr[(s + 2) % 3]; if (s + 2 < CH) SC_RD((s + 2) % 3, s + 2); \
            const f32x2v p2 = S01 * kk[c_].lo + S23 * kk[c_].hi; float sa = p2.x + p2.y; \
            if (s > 0) { const f32x2v q2 = S01 * rprev.lo + S23 * rprev.hi; float yq = q2.x + q2.y; red16_2(sa, yq); ysel = (((s - 1) & 15) == jq) ? yq : ysel; if (((s - 1) & 15) == 15) yp[(size_t)(s - 16) * 256] = ysel; } \
            else sa = red16(sa); \
            const f32x2v vk01 = vv[c_] * kh[c_].lo, vk23 = vv[c_] * kh[c_].hi; \
            S01 = S01 * ww[c_].lo + (vk01 - sa * ka[c_].lo); S23 = S23 * ww[c_].hi + (vk23 - sa * ka[c_].hi); } \
        { const int p_ = (CH - 1) % 3; const f32x2v q2 = S01 * rr[p_].lo + S23 * rr[p_].hi; const float yq = red16(q2.x + q2.y); ysel = (15 == jq) ? yq : ysel; yp[(size_t)(CH - 16) * 256] = ysel; } } while (0)
    if (loader) {
        __builtin_amdgcn_s_setprio(2);
        LdSet A, B;
        SC_LD(A, 0); SC_ST(A, 0); SC_LD(A, 1); SC_LD(B, 2);
        __syncthreads();
        for (int ch = 0; ch < nch; ch += 2) {
            if (ch + 1 < nch) SC_ST(A, 1);
            SC_LD(A, ch + 3);
            __syncthreads();
            if (ch + 1 < nch) { if (ch + 2 < nch) SC_ST(B, 0); SC_LD(B, ch + 4); __syncthreads(); }
        }
        __builtin_amdgcn_s_setprio(0);
    } else {
        __syncthreads();
        for (int ch = 0; ch < nch; ch += 2) {
            SC_SCAN(0, ch);
            __syncthreads();
            if (ch + 1 < nch) { SC_SCAN(1, ch + 1); __syncthreads(); }
        }
    }
#undef SC_LD
#undef SC_ST
#undef SC_RD
#undef SC_SCAN
    if (!loader) {
        float* so = out_l + (sample ? O_SWKV : O_PWKV) + ((size_t)((l * NB + b) * 4 + h) * 64 + vrow) * 64 + 4 * jq;
        *(f32x4*)so = (f32x4){S01.x, S01.y, S23.x, S23.y};
    }
}

__device__ __forceinline__ f32x4 mfma16(bf16x8 A, bf16x8 B, f32x4 C) { return __builtin_amdgcn_mfma_f32_16x16x32_bf16(A, B, C, 0, 0, 0); }
__device__ __forceinline__ bf16x8 pack8(const f32x4 lo, const f32x4 hi) {
    u32x4 w; w.x = pk2(lo.x, lo.y); w.y = pk2(lo.z, lo.w); w.z = pk2(hi.x, hi.y); w.w = pk2(hi.z, hi.w); return __builtin_bit_cast(bf16x8, w);
}
__device__ __forceinline__ void attn_unit(const bf16* Q, int qp, const bf16* K, int kp, const bf16* VT, int vp, int qpos0, int kmax, bf16* O, int op, int lane) {
    const int fr = lane & 15, g = lane >> 4;
    bf16x8 qf[2];
#pragma unroll
    for (int ds = 0; ds < 2; ++ds) qf[ds] = *(const bf16x8*)(Q + (size_t)fr * qp + 32 * ds + 8 * g);
    f32x4 o[4];
#pragma unroll
    for (int i = 0; i < 4; ++i) o[i] = (f32x4){0.f, 0.f, 0.f, 0.f};
    float R = 0.f;
    const int qpos = qpos0 + fr;
    u32x4 onesw = {0x3F803F80u, 0x3F803F80u, 0x3F803F80u, 0x3F803F80u};
    const bf16x8 ones = __builtin_bit_cast(bf16x8, onesw);
    bf16x8 kf[4][2];
#define AT_LDK(kt_) do { _Pragma("unroll") for (int kb = 0; kb < 4; ++kb) { int kr = (kt_) * 64 + 16 * kb + fr; kr = kr > kmax ? kmax : kr; const bf16* krow = K + (size_t)kr * kp + 8 * g; \
        kf[kb][0] = *(const bf16x8*)krow; kf[kb][1] = *(const bf16x8*)(krow + 32); } } while (0)
    AT_LDK((qpos0 + 14) >> 6);
    for (int kt = (qpos0 + 14) >> 6; kt >= 0; --kt) {
        const int key0 = kt * 64;
        u32x2 vf[2][4][2];
#pragma unroll
        for (int ks = 0; ks < 2; ++ks)
#pragma unroll
            for (int db = 0; db < 4; ++db) { const bf16* vrow = VT + (size_t)(16 * db + fr) * vp + key0 + 32 * ks + 4 * g; vf[ks][db][0] = *(const u32x2*)vrow; vf[ks][db][1] = *(const u32x2*)(vrow + 16); }
        f32x4 z[4];
#pragma unroll
        for (int kb = 0; kb < 4; ++kb) {
            f32x4 acc = {0.f, 0.f, 0.f, 0.f};
            acc = mfma16(kf[kb][0], qf[0], acc);
            acc = mfma16(kf[kb][1], qf[1], acc);
            z[kb] = acc;
        }
        if (kt > 0) AT_LDK(kt - 1);
        f32x4 lk[4], ls[4]; bool vis[4][4];
#pragma unroll
        for (int kb = 0; kb < 4; ++kb)
#pragma unroll
            for (int r = 0; r < 4; ++r) {
                const int key = key0 + 16 * kb + 4 * g + r;
                const float zz = z[kb][r] * 0.125f, sp = softplus_f(zz);
                vis[kb][r] = key < qpos;
                lk[kb][r] = vis[kb][r] ? -sp : 0.f;
                ls[kb][r] = zz - sp;
            }
        bf16x8 Bhi[2], Blo[2];
#pragma unroll
        for (int ks = 0; ks < 2; ++ks) {
            u32x4 hw, lw;
            { const f32x4 x = lk[2 * ks]; const unsigned h01 = pk2(x.x, x.y), h23 = pk2(x.z, x.w); hw.x = h01; hw.y = h23; lw.x = pk2(x.x - bflo(h01), x.y - bfhi(h01)); lw.y = pk2(x.z - bflo(h23), x.w - bfhi(h23)); }
            { const f32x4 x = lk[2 * ks + 1]; const unsigned h01 = pk2(x.x, x.y), h23 = pk2(x.z, x.w); hw.z = h01; hw.w = h23; lw.z = pk2(x.x - bflo(h01), x.y - bfhi(h01)); lw.w = pk2(x.z - bflo(h23), x.w - bfhi(h23)); }
            Bhi[ks] = __builtin_bit_cast(bf16x8, hw); Blo[ks] = __builtin_bit_cast(bf16x8, lw);
        }
        f32x4 tot = {0.f, 0.f, 0.f, 0.f};
#pragma unroll
        for (int ks = 0; ks < 2; ++ks) { tot = mfma16(ones, Bhi[ks], tot); tot = mfma16(ones, Blo[ks], tot); }
        f32x4 p[4];
#pragma unroll
        for (int kb = 0; kb < 4; ++kb) {
            f32x4 la = {0.f, 0.f, 0.f, 0.f};
            const int s = 16 * kb + fr;
#pragma unroll
            for (int ks = 0; ks < 2; ++ks) {
                if (32 * ks + 31 > 16 * kb) {
                    u32x4 tw;
                    unsigned e[8];
#pragma unroll
                    for (int j = 0; j < 8; ++j) { const int jp = 32 * ks + 16 * (j >> 2) + 4 * g + (j & 3); e[j] = jp > s ? 0x3F80u : 0u; }
                    tw.x = e[0] | (e[1] << 16); tw.y = e[2] | (e[3] << 16); tw.z = e[4] | (e[5] << 16); tw.w = e[6] | (e[7] << 16);
                    const bf16x8 tri = __builtin_bit_cast(bf16x8, tw);
                    la = mfma16(tri, Bhi[ks], la); la = mfma16(tri, Blo[ks], la);
                }
            }
#pragma unroll
            for (int r = 0; r < 4; ++r) p[kb][r] = vis[kb][r] ? __expf(ls[kb][r] + la[r] + R) : 0.f;
        }
        R += tot[0];
#pragma unroll
        for (int ks = 0; ks < 2; ++ks) {
            const bf16x8 pf = pack8(p[2 * ks], p[2 * ks + 1]);
#pragma unroll
            for (int db = 0; db < 4; ++db) {
                u32x4 vw; vw.x = vf[ks][db][0].x; vw.y = vf[ks][db][0].y; vw.z = vf[ks][db][1].x; vw.w = vf[ks][db][1].y;
                o[db] = mfma16(__builtin_bit_cast(bf16x8, vw), pf, o[db]);
            }
        }
        if (__all(R < -110.f)) break;
    }
#undef AT_LDK
#pragma unroll
    for (int db = 0; db < 4; ++db) { u32x2 w; w.x = pk2(o[db][0], o[db][1]); w.y = pk2(o[db][2], o[db][3]); *(u32x2*)(O + (size_t)fr * op + 16 * db + 4 * g) = w; }
}
__device__ __forceinline__ void attn_part(const Args& a, int l, int aw, int naw) {
    const int tid = ltid();
    KArgP ap = kargs(); unsigned char* ws_l = ap->ws; float* out_l = ap->out; (void)ws_l; (void)out_l;
    const bf16* U = (const bf16*)(ws_l + WS_U); bf16* YC = (bf16*)(ws_l + WS_H);
    const bf16* SK = (const bf16*)(ws_l + WS_SKV); const bf16* VT = (const bf16*)(ws_l + WS_VT); const bf16* SVT = (const bf16*)(ws_l + WS_SVT);
    const int lane = tid & 63;
    constexpr int NPU = NB * 4 * (T / 16);
#define AT_PROMPT(bh_, qb_) do { const int b_ = (bh_) >> 2, h_ = (bh_) & 3; const int row0_ = b_ * T + (qb_) * 16; \
        attn_unit(U + (size_t)row0_ * NU + UQ + h_ * 64, NU, U + (size_t)(b_ * T) * NU + UK + h_ * 64, NU, VT + (size_t)(bh_) * 64 * VTP, VTP, (qb_) * 16, T - 1, YC + (size_t)row0_ * D + 768 + h_ * 64, D, lane); } while (0)
#define AT_SAMPLE(u_) do { const int b_ = (u_) >> 2, h_ = (u_) & 3; const int row0_ = MP + b_ * TS; \
        attn_unit(U + (size_t)row0_ * NU + UQ + h_ * 64, NU, SK + (size_t)b_ * SKEYS * 256 + h_ * 64, 256, SVT + (size_t)(u_) * 64 * SKP, SKP, PAST, SKEYS - 1, YC + (size_t)row0_ * D + 768 + h_ * 64, D, lane); } while (0)
    if (naw == 1024) {
        const int cb = aw >> 3, wv = aw & 7, xcd = cb & 7, wx = (cb >> 3) * 8 + wv;
        if (wx < 4) AT_SAMPLE(wx * 8 + xcd);
        for (int k = 0; k < 8; ++k) { const int i = wx + 128 * k; AT_PROMPT(xcd + 8 * (i >> 8), i & 255); }
    } else {
        for (int v = aw; v < NPU; v += naw) AT_PROMPT(v >> 8, v & 255);
        for (int u = aw; u < 32; u += naw) AT_SAMPLE(u);
    }
#undef AT_PROMPT
#undef AT_SAMPLE
}

__device__ __forceinline__ void rwkv_post(const Args& a, int l) {
    const int tid = ltid();
    KArgP ap = kargs(); unsigned char* ws_l = ap->ws;
    const float* in_I_LNB = ap->in[I_LNB]; const float* in_I_LNW = ap->in[I_LNW];
    const float* YS = (const float*)(ws_l + WS_YS); const bf16* Gb = (const bf16*)(ws_l + WS_G); const float* RKb = (const float*)(ws_l + WS_RK);
    bf16* YC = (bf16*)(ws_l + WS_H);
    const int lane = tid & 63, wave = tid >> 6, h = lane >> 4, c4 = 4 * lane, cc = 4 * (lane & 15);
    const f32x4 lnw = *(const f32x4*)(in_I_LNW + l * 256 + c4), lnb = *(const f32x4*)(in_I_LNB + l * 256 + c4);
    const int gw = blockIdx.x * NWAVES + wave, NGW = gridDim.x * NWAVES;
#define PO_BODY(row_, y_, gq_, vq_, rk_) do { \
        const float mean = red16((y_.x + y_.y) + (y_.z + y_.w)) * (1.f / 64.f); const f32x4 dv = y_ - mean; \
        const float var = red16((dv.x * dv.x + dv.y * dv.y) + (dv.z * dv.z + dv.w * dv.w)) * (1.f / 64.f); const float rs = rsqrtf(var + GN_EPS); \
        const float o0 = (dv.x * rs * lnw.x + lnb.x + rk_ * bflo(vq_.x)) * bflo(gq_.x), o1 = (dv.y * rs * lnw.y + lnb.y + rk_ * bfhi(vq_.x)) * bfhi(gq_.x); \
        const float o2 = (dv.z * rs * lnw.z + lnb.z + rk_ * bflo(vq_.y)) * bflo(gq_.y), o3 = (dv.w * rs * lnw.w + lnb.w + rk_ * bfhi(vq_.y)) * bfhi(gq_.y); \
        u32x2 o; o.x = pk2(o0, o1); o.y = pk2(o2, o3); *(u32x2*)(YC + (size_t)(row_) * D + 256 + c4) = o; } while (0)
#define PO_LOAD(r_, y_, g_, v_, k_) do { y_ = *(const f32x4*)(YS + (size_t)(r_) * 256 + c4); g_ = *(const u32x2*)(Gb + (size_t)(r_) * 256 + c4); \
        v_ = *(const u32x2*)(ws_l + WS_SIN + rec_index((r_), h) * REC + 256 + 2 * cc); k_ = RKb[(size_t)(r_) * 4 + h]; } while (0)
    for (int row = gw; row < MR; row += 4 * NGW) {
        f32x4 y0, y1, y2, y3; u32x2 g0, g1, g2, g3, v0, v1, v2, v3; float k0, k1, k2, k3;
        const int r1 = row + NGW, r2 = row + 2 * NGW, r3 = row + 3 * NGW;
        PO_LOAD(row, y0, g0, v0, k0);
        if (r1 < MR) PO_LOAD(r1, y1, g1, v1, k1);
        if (r2 < MR) PO_LOAD(r2, y2, g2, v2, k2);
        if (r3 < MR) PO_LOAD(r3, y3, g3, v3, k3);
        PO_BODY(row, y0, g0, v0, k0);
        if (r1 < MR) PO_BODY(r1, y1, g1, v1, k1);
        if (r2 < MR) PO_BODY(r2, y2, g2, v2, k2);
        if (r3 < MR) PO_BODY(r3, y3, g3, v3, k3);
    }
#undef PO_BODY
#undef PO_LOAD
}

template <int MODE, int K>
__device__ __forceinline__ void small_gemm(const bf16* A, const bf16* Bt, int ncol16, bf16* Ob, float* Of, int ldc, float* sk, float* sv, unsigned char* lds, int bid, int G) {
    constexpr int KW = K / 8, NKS = KW / 32, NB_ = (MODE == 1) ? 4 : 2;
    static_assert(KW % 32 == 0, "K split");
    const int tid = ltid(), lane = tid & 63, wave = tid >> 6, fr = lane & 15, g = lane >> 4;
    float* part = (float*)lds;
    const int nct = ncol16 / 2;
    const bool x8 = (G & 7) == 0;
    const int xq = x8 ? (bid & 7) : 0, xs = x8 ? 8 : 1, jq = x8 ? (bid >> 3) : bid, JQ = x8 ? (G >> 3) : G;
    bf16x8 af[NKS], b0[NKS], b1[NKS], b2[NKS], b3[NKS];
    int n_ = jq;
#define SG_ROW(c_) ((MODE == 1) ? (256 * ((c_) >> 7) + ((c_) & 127)) : (c_))
#define SG_LOAD(nn) do { const int mt_ = (nn) & 7, c0_ = (xq + xs * ((nn) >> 3)) * 32; \
        const bf16* ap_ = A + (size_t)(mt_ * 16 + fr) * K + wave * KW + 8 * g; const bf16* bp_ = Bt + (size_t)(SG_ROW(c0_) + fr) * K + wave * KW + 8 * g; const bf16* bq_ = bp_ + (size_t)16 * K; \
        _Pragma("unroll") for (int q = 0; q < NKS; ++q) { af[q] = *(const bf16x8*)(ap_ + 32 * q); b0[q] = *(const bf16x8*)(bp_ + 32 * q); b1[q] = *(const bf16x8*)(bq_ + 32 * q); \
            if (MODE == 1) { b2[q] = *(const bf16x8*)(bp_ + (size_t)128 * K + 32 * q); b3[q] = *(const bf16x8*)(bq_ + (size_t)128 * K + 32 * q); } } } while (0)
#define SG_VALID(nn) ((xq + xs * ((nn) >> 3)) < nct)
    if (SG_VALID(n_)) SG_LOAD(n_);
    for (int it = 0; SG_VALID(n_); ++it, n_ += JQ) {
        f32x4 acc0 = {0.f, 0.f, 0.f, 0.f}, acc1 = acc0, acc2 = acc0, acc3 = acc0;
#pragma unroll
        for (int q = 0; q < NKS; ++q) { acc0 = mfma16(b0[q], af[q], acc0); acc1 = mfma16(b1[q], af[q], acc1); if (MODE == 1) { acc2 = mfma16(b2[q], af[q], acc2); acc3 = mfma16(b3[q], af[q], acc3); } }
        if (SG_VALID(n_ + JQ)) SG_LOAD(n_ + JQ);
        float* pb = part + (it & 1) * (8 * NB_ * 256);
        *(f32x4*)(pb + (wave * NB_ + 0) * 256 + lane * 4) = acc0; *(f32x4*)(pb + (wave * NB_ + 1) * 256 + lane * 4) = acc1;
        if (MODE == 1) { *(f32x4*)(pb + (wave * NB_ + 2) * 256 + lane * 4) = acc2; *(f32x4*)(pb + (wave * NB_ + 3) * 256 + lane * 4) = acc3; }
        __syncthreads();
        {
            const int sub = tid >> 8, e = tid & 255;
            float s0 = 0.f, s1 = 0.f;
#pragma unroll
            for (int w = 0; w < 8; ++w) { s0 += pb[(w * NB_ + sub) * 256 + e]; if (MODE == 1) s1 += pb[(w * NB_ + 2 + sub) * 256 + e]; }
            const int ln = e >> 2, r = e & 3, mt = n_ & 7, c0 = (xq + xs * (n_ >> 3)) * 32 + 16 * sub;
            const int m = mt * 16 + (ln & 15), n = c0 + 4 * (ln >> 4) + r;
            if (MODE == 0) Ob[(size_t)m * ldc + n] = (bf16)f2bf(s0);
            else if (MODE == 1) Ob[(size_t)m * ldc + n] = (bf16)f2bf(pg8::silu_f(s0) * s1);
            else { Ob[(size_t)m * ldc + n] = (bf16)f2bf(s0); if (n >= UK && n < UK + 512) ((n < UV ? sk : sv) + (size_t)m * 256)[n & 255] = s0; }
        }
    }
#undef SG_LOAD
#undef SG_VALID
#undef SG_ROW
    __syncthreads();
}

#define XB_TMO      128
#define XB_XCNT(j)  (256  + 64 * (j))
#define XB_XSUB(j)  (1280 + 64 * (j))
#define XB_XGEN(j)  (2304 + 64 * (j))
#define XB_TOP      3328
#define XB_TOPGEN   3392
#define XCD_BAR_WORDS 3456
#define XB_SPIN_CAP (1u << 18)

__device__ __forceinline__ unsigned xb_ld(unsigned* p)              { return __hip_atomic_load(p, __ATOMIC_RELAXED, __HIP_MEMORY_SCOPE_AGENT); }
__device__ __forceinline__ unsigned xb_add(unsigned* p, unsigned v) { return __hip_atomic_fetch_add(p, v, __ATOMIC_RELAXED, __HIP_MEMORY_SCOPE_AGENT); }
__device__ __forceinline__ unsigned xb_xcc_id() { return (unsigned)__builtin_amdgcn_s_getreg((3 << 11) | 20) & 0xFu; }
#define XB_SPIN(cond, bar) do { unsigned _sp = 0; while (cond) { __builtin_amdgcn_s_sleep(1); \
    if ((++_sp & 255u) == 0u) { if (xb_ld(&(bar)[XB_TMO])) break; if (_sp > XB_SPIN_CAP) { atomicAdd(&(bar)[XB_TMO], 1u); break; } } } } while (0)

struct XcdBarrier {
    unsigned* bar; unsigned x;
    volatile LAS unsigned* st;
};

__device__ __forceinline__ XcdBarrier xcd_barrier_post(unsigned* bar, volatile LAS unsigned* st) {
    XcdBarrier b; b.bar = bar; b.x = xb_xcc_id(); b.st = st;
    if (threadIdx.x == 0) (void)xb_add(&bar[XB_XCNT(b.x)], 1u);
    return b;
}
__device__ __forceinline__ void xcd_barrier_complete(unsigned* bar, unsigned x, unsigned& nloc, unsigned& nx) {
    const unsigned G = gridDim.x * gridDim.y * gridDim.z;
    unsigned sum, cnt, mine, sp = 0u;
    for (;;) {
        sum = 0u; cnt = 0u; mine = 0u;
#pragma unroll
        for (unsigned j = 0; j < 16; ++j) { const unsigned c = xb_ld(&bar[XB_XCNT(j)]); sum += c; cnt += (c > 0u) ? 1u : 0u; mine = (j == x) ? c : mine; }
        if (sum == G) break;
        __builtin_amdgcn_s_sleep(1);
        if ((++sp & 255u) == 0u) { if (xb_ld(&bar[XB_TMO])) break; if (sp > XB_SPIN_CAP) { atomicAdd(&bar[XB_TMO], 1u); break; } }
    }
    nloc = mine > 0u ? mine : 1u; nx = cnt > 0u ? cnt : 1u;
}

__device__ __forceinline__ void xcd_barrier(const XcdBarrier& b) {
    asm volatile("s_waitcnt vmcnt(0)" ::: "memory");
    __syncthreads();
    if (threadIdx.x == 0) {
        unsigned* bar = b.bar;
        __builtin_amdgcn_s_waitcnt(0);
        unsigned nloc = b.st[0], nx = b.st[1];
        if (nloc == 0u) { xcd_barrier_complete(bar, b.x, nloc, nx); b.st[0] = nloc; b.st[1] = nx; }
        const unsigned old = xb_add(&bar[XB_XSUB(b.x)], 1u);
        const unsigned gen = old / nloc;
        if (old + 1u == (gen + 1u) * nloc) {
            __builtin_amdgcn_fence(__ATOMIC_RELEASE, "agent");
            asm volatile("s_waitcnt vmcnt(0)" ::: "memory");
            const unsigned og = xb_add(&bar[XB_TOP], 1u);
            const unsigned tg = og / nx;
            if (og + 1u == (tg + 1u) * nx) xb_add(&bar[XB_TOPGEN], 1u);
            else XB_SPIN(xb_ld(&bar[XB_TOPGEN]) == tg, bar);
            __builtin_amdgcn_fence(__ATOMIC_ACQUIRE, "agent");
            xb_add(&bar[XB_XGEN(b.x)], 1u);
            asm volatile("s_waitcnt vmcnt(0)" ::: "memory");
        } else {
            XB_SPIN(xb_ld(&bar[XB_XGEN(b.x)]) == gen, bar);
            __builtin_amdgcn_fence(__ATOMIC_ACQUIRE, "agent");
            asm volatile("s_waitcnt vmcnt(0)" ::: "memory");
        }
    }
    __syncthreads();
}

__global__ void __launch_bounds__(NTHR, 2) mk_fwd(Args a) {
    extern __shared__ __attribute__((aligned(16))) unsigned char lds[];
    cg::grid_group grid = cg::this_grid();
    const int lo = MK_PER_PHASE ? a.ph_lo : 0, hi = MK_PER_PHASE ? a.ph_hi : NPH, G = gridDim.x;
#define IN(k) (lo <= (k) && (k) < hi)
    for (int u_ = ltid(); u_ < 64; u_ += NTHR) ((LAS unsigned*)((LAS unsigned char*)lds + 131072))[u_] = 0u;
    __syncthreads();
    (void)xcd_barrier_post((unsigned*)(a.ws + WS_CTL), (volatile LAS unsigned*)((LAS unsigned char*)lds + 131072 + 64));
#define XBAR_NOW() do { XcdBarrier xb_; xb_.bar = (unsigned*)(kargs()->ws + WS_CTL); xb_.x = xb_xcc_id(); xb_.st = (volatile LAS unsigned*)((LAS unsigned char*)lds + 131072 + 64); xcd_barrier(xb_); } while (0)
#define SEAM(k) do { if (IN(k) && IN((k) + 1)) { if ((k) == PH_PRE) grid.sync(); else XBAR_NOW(); } } while (0)
    PG8_LAS unsigned char* ring = (PG8_LAS unsigned char*)lds;
#define PHASE_PTRS KArgP ap = kargs(); unsigned char* ws_ = ap->ws; float* out_ = ap->out; \
    bf16* Wb = (bf16*)(ws_ + WS_W); bf16* H = (bf16*)(ws_ + WS_H); bf16* ACT = (bf16*)(ws_ + WS_U); bf16* Y = (bf16*)(ws_ + WS_Y); float* X = out_ + O_X; bf16* XB = (bf16*)(out_ + O_X); bf16* XALT = (bf16*)(ws_ + WS_Y + (size_t)M * D * 2); \
    const bf16* WL = Wb + (size_t)l * LW; const float* ng = ap->in[I_NG] + (size_t)l * 6 * D; (void)H; (void)ACT; (void)Y; (void)X; (void)XB; (void)XALT; (void)WL; (void)ng;

#define REPEAT(bit) _Pragma("nounroll") for (int rep_ = 0; rep_ < ((REP & (bit)) ? 2 : 1); ++rep_)
#define RSYNC if (rep_) XBAR_NOW();
#define GEMM_MAIN(EPI, Aptr, Wptr, NN, KK, EOBJ) { pg8::Gemm g{Aptr, Wptr, MP, NN, KK}; pg8::StaticOrder S; S.init(MP, NN, G, (int)blockIdx.x); pg8::gemm_phase<EPI, pg8::StaticOrder, true, true>(ring, g, S, EOBJ); }
#define SMALL_IDS const int tid_ = ltid(); const int gw_ = (int)blockIdx.x * NWAVES + (tid_ >> 6), ngw_ = G * NWAVES, lane_ = tid_ & 63;
    if (REP & 16384) { for (int i = 0; i < 20; ++i) XBAR_NOW(); }
    if (IN(PH_PRE)) REPEAT(128) { RSYNC phase_pre(a, lds); }
    SEAM(PH_PRE);
    for (int l = 0; l < 2; ++l) {
        const int p0 = 1 + l * PH_PER_LAYER;
        if (IN(p0 + P_A1)) REPEAT(1) { RSYNC PHASE_PTRS
            { pg8::EpiSwiglu E{ACT, FF}; GEMM_MAIN(pg8::EpiSwiglu, H, WL + W_GUA, 2 * FF, D, E) }
            small_gemm<1, D>(H + (size_t)MP * D, WL + W_GUA, FF / 16, ACT + (size_t)MP * FF, nullptr, FF, nullptr, nullptr, lds, (int)blockIdx.x, G); }
        SEAM(p0 + P_A1);
        if (IN(p0 + P_A2)) REPEAT(2) { RSYNC PHASE_PTRS
            { pg8::EpiBf E{Y, D}; GEMM_MAIN(pg8::EpiBf, ACT, WL + W_DA, D, FF, E) }
            small_gemm<0, FF>(ACT + (size_t)MP * FF, WL + W_DA, D / 16, Y + (size_t)MP * D, nullptr, D, nullptr, nullptr, lds, (int)blockIdx.x, G); }
        SEAM(p0 + P_A2);
        if (IN(p0 + P_A3)) { PHASE_PTRS
            if (l == 0) phase_rowpass<true, false, true>(ap->in[I_XP], ap->in[I_XS], Y, 0.5f, ng + 1 * D, ng + 2 * D, XB, H);
            else        phase_rowpass<false, false, true>(XB, XB, Y, 0.5f, ng + 1 * D, ng + 2 * D, XB, H);
        }
        SEAM(p0 + P_A3);
        if (IN(p0 + P_B1)) REPEAT(4) { RSYNC PHASE_PTRS
            { pg8::EpiU E{ACT, NU, out_ + O_PK + (size_t)l * MP * 256, out_ + O_PV + (size_t)l * MP * 256, out_ + O_SK + (size_t)l * MS * 256, out_ + O_SV + (size_t)l * MS * 256, MP, MR};
              GEMM_MAIN(pg8::EpiU, H, WL + W_IN, NU, D, E) }
            if (G == 256) { if ((int)blockIdx.x >= 128) small_gemm<2, D>(H + (size_t)MP * D, WL + W_IN, NU / 16, ACT + (size_t)MP * NU, nullptr, NU, out_ + O_SK + (size_t)l * MS * 256, out_ + O_SV + (size_t)l * MS * 256, lds, (int)blockIdx.x - 128, 128); }
              else small_gemm<2, D>(H + (size_t)MP * D, WL + W_IN, NU / 16, ACT + (size_t)MP * NU, nullptr, NU, out_ + O_SK + (size_t)l * MS * 256, out_ + O_SV + (size_t)l * MS * 256, lds, (int)blockIdx.x, G); }
        SEAM(p0 + P_B1);
        if (IN(p0 + P_C1)) REPEAT(16) { RSYNC
            skv_part(a, l);
            for (int r4_ = 0; r4_ < ((REP & 4096) ? 2 : 1); ++r4_) rwkv_prep_part(a, l, lds);
            vt_part(a, l);
        }
        SEAM(p0 + P_C1);
        if (IN(p0 + P_C2)) REPEAT(32) { RSYNC
            _Pragma("nounroll") for (int r2_ = 0; r2_ < ((REP & 256) ? 2 : 1); ++r2_)
            for (int ub = blockIdx.x; ub < 256; ub += G) {
                const int c_ = ub & 127, xcd_ = c_ & 7, idx_ = c_ >> 3, u = (ub & 128) | (((xcd_ * 4 + (idx_ >> 2)) << 2) | (idx_ & 3));
                if (u < 128) scan_unit<32>(a, l, u, lds); else scan_unit<16>(a, l, u, lds); }
            const int ab0 = G / 2;
            if ((int)blockIdx.x >= ab0) { _Pragma("nounroll") for (int r3_ = 0; r3_ < ((REP & 512) ? 2 : 1); ++r3_) attn_part(a, l, ((int)blockIdx.x - ab0) * NWAVES + (int)(ltid() >> 6), (G - ab0) * NWAVES);
                for (int r4_ = 0; r4_ < ((REP & 1024) ? 2 : 1); ++r4_) conv_part(a, l, (int)blockIdx.x - ab0, G - ab0);
                for (int r4_ = 0; r4_ < ((REP & 2048) ? 2 : 1); ++r4_) pool_part(a, l, lds, (int)blockIdx.x - ab0, G - ab0); }
        }
        SEAM(p0 + P_C2);
        if (IN(p0 + P_C3)) REPEAT(64) { RSYNC rwkv_post(a, l); }
        SEAM(p0 + P_C3);
        if (IN(p0 + P_D1)) REPEAT(8) { RSYNC PHASE_PTRS
            { pg8::EpiBf E{Y, D}; GEMM_MAIN(pg8::EpiBf, H, WL + W_OUT, D, D, E) }
            small_gemm<0, D>(H + (size_t)MP * D, WL + W_OUT, D / 16, Y + (size_t)MP * D, nullptr, D, nullptr, nullptr, lds, (int)blockIdx.x, G); }
        SEAM(p0 + P_D1);
        if (IN(p0 + P_D2)) { PHASE_PTRS if (l == 0) phase_rowpass<false, false, true>(XB, XB, Y, 1.0f, ng + 3 * D, ng + 4 * D, XB, H);
            else        phase_rowpass<false, false, true>(XB, XB, Y, 1.0f, ng + 3 * D, ng + 4 * D, XALT, H); }
        SEAM(p0 + P_D2);
        if (IN(p0 + P_E1)) REPEAT(1) { RSYNC PHASE_PTRS
            { pg8::EpiSwiglu E{ACT, FF}; GEMM_MAIN(pg8::EpiSwiglu, H, WL + W_GUB, 2 * FF, D, E) }
            small_gemm<1, D>(H + (size_t)MP * D, WL + W_GUB, FF / 16, ACT + (size_t)MP * FF, nullptr, FF, nullptr, nullptr, lds, (int)blockIdx.x, G); }
        SEAM(p0 + P_E1);
        if (IN(p0 + P_E2)) REPEAT(2) { RSYNC PHASE_PTRS
            { pg8::EpiBf E{Y, D}; GEMM_MAIN(pg8::EpiBf, ACT, WL + W_DB, D, FF, E) }
            small_gemm<0, FF>(ACT + (size_t)MP * FF, WL + W_DB, D / 16, Y + (size_t)MP * D, nullptr, D, nullptr, nullptr, lds, (int)blockIdx.x, G); }
        SEAM(p0 + P_E2);
        if (IN(p0 + P_E3)) { PHASE_PTRS
            if (l == 0) phase_rowpass<false, false, true>(XB, XB, Y, 0.5f, ng + 5 * D, ng + 6 * D, XB, H);
            else        phase_rowpass<false, true, false>(XALT, XALT, Y, 0.5f, ng + 5 * D, ng, X, H);
        }
        SEAM(p0 + P_E3);
    }
#undef IN
#undef SEAM
}

extern "C" void kernel_launch(void* const* d_in, const int* in_sizes, int n_in, void* d_out, int out_size, void* d_ws, size_t ws_size, hipStream_t stream) {
    static int grid = 0;
    if (grid == 0) {
        if (n_in != 28 || (size_t)out_size != O_END || ws_size < WS_END) { fprintf(stderr, "kernel_launch: unexpected shapes: n_in %d out %d ws %zu (need %zu)\n", n_in, out_size, ws_size, (size_t)WS_END); grid = -1; return; }
        int dev = 0, cus = 0, per_cu = 0;
        if (hipGetDevice(&dev) != hipSuccess || hipDeviceGetAttribute(&cus, hipDeviceAttributeMultiprocessorCount, dev) != hipSuccess) { grid = -1; return; }
        if (hipFuncSetAttribute((const void*)mk_fwd, hipFuncAttributeMaxDynamicSharedMemorySize, LDS_BYTES) != hipSuccess) { fprintf(stderr, "kernel_launch: hipFuncSetAttribute failed\n"); grid = -1; return; }
        if (hipOccupancyMaxActiveBlocksPerMultiprocessor(&per_cu, (const void*)mk_fwd, NTHR, LDS_BYTES) != hipSuccess || per_cu < 1) { fprintf(stderr, "kernel_launch: occupancy query says %d\n", per_cu); per_cu = 1; }
        (void)hipGetLastError();
        grid = cus * 1;
    }
    if (grid < 0) return;
    if (hipMemsetAsync((char*)d_ws + WS_CTL, 0, 16384, stream) != hipSuccess) { fprintf(stderr, "kernel_launch: hipMemsetAsync failed\n"); return; }
    Args a{};
    for (int i = 0; i < 28; ++i) a.in[i] = (const float*)d_in[i];
    a.out = (float*)d_out; a.ws = (unsigned char*)d_ws;
#if MK_PER_PHASE
    for (int ph = 0; ph < NPH; ++ph) { a.ph_lo = ph; a.ph_hi = ph + 1; hipLaunchKernelGGL(mk_fwd, dim3(grid), dim3(NTHR), LDS_BYTES, stream, a); }
#else
    a.ph_lo = 0; a.ph_hi = NPH;
    void* args[] = {&a};
    hipError_t e = hipLaunchCooperativeKernel((const void*)mk_fwd, dim3(grid), dim3(NTHR), args, LDS_BYTES, stream);
    if (e != hipSuccess) fprintf(stderr, "kernel_launch: cooperative launch failed: %s (grid %d)\n", hipGetErrorString(e), grid);
#endif
}
```
